# Optimizing an MI355X kernel written in HIP

```python
import math
import jax, jax.numpy as jnp
from jax import lax
import numpy as np

D_MODEL = 1024
BATCH = 2
SEQ = 8192
DEPTH = 1

MIX_WIDTH = D_MODEL
ATTN_WIDTH = MIX_WIDTH // 2
SSM_WIDTH = MIX_WIDTH - ATTN_WIDTH
N_ATTN_HEADS = 4
ATTN_HEAD_DIM = ATTN_WIDTH // (2 * N_ATTN_HEADS)
ATTN_VALUE_DIM = 2 * ATTN_HEAD_DIM
Q_BLOCK = 128
SSM_GROUP = 16
N_SSM_GROUPS = SSM_WIDTH // SSM_GROUP
SSM_STATE = 64
DT_MIN = 1e-3
DT_MAX = 1e-1
N_EXPERT_GROUPS = 4
EXPERTS_PER_GROUP = 8
N_EXPERTS = N_EXPERT_GROUPS * EXPERTS_PER_GROUP
TOP_K_INNER = 2
EXPERT_FF = 512
MOE_BLOCK = 128
IN_COLS = 3 * ATTN_WIDTH + SSM_WIDTH
RMS_EPS = 1e-6

kernel_name = "hymba_diffattn_s5_hiermoe_block"


def rmsnorm(x, gain):
    xf = x.astype(jnp.float32)
    y = xf * lax.rsqrt(jnp.mean(xf * xf, axis=-1, keepdims=True) + RMS_EPS) * gain.astype(jnp.float32)
    return y.astype(x.dtype)


def lambda_init_fn(layer_idx):
    return 0.8 - 0.6 * math.exp(-0.3 * layer_idx)


def alibi_slopes(n_heads):
    return jnp.asarray(2.0 ** (-8.0 * np.arange(1, n_heads + 1) / n_heads), dtype=jnp.float32)


def diff_attention(q, k, v, lam, subln_gain, lambda_init):
    b_, s_ = q.shape[:2]
    n_qblocks = s_ // Q_BLOCK
    scale = ATTN_HEAD_DIM ** -0.5
    qb = (q * scale).reshape(b_, n_qblocks, Q_BLOCK, N_ATTN_HEADS, 2, ATTN_HEAD_DIM)
    qb = qb.transpose(1, 0, 3, 4, 2, 5)
    kt = k.transpose(0, 2, 3, 1, 4)
    vt = v.transpose(0, 2, 1, 3)
    slopes = alibi_slopes(N_ATTN_HEADS)
    kpos = jnp.arange(s_)

    def block(args):
        q_blk, i = args
        qpos = i * Q_BLOCK + jnp.arange(Q_BLOCK)
        dist = (qpos[:, None] - kpos[None, :]).astype(jnp.float32)
        bias = jnp.where(dist >= 0, -slopes[:, None, None] * dist, -jnp.inf)
        scores = jnp.einsum('bhmqd,bhmkd->bhmqk', q_blk, kt).astype(jnp.float32)
        scores = scores + bias[None, :, None]
        p = jax.nn.softmax(scores, axis=-1)
        a = p[:, :, 0] - lam * p[:, :, 1]
        return jnp.einsum('bhqk,bhkv->bhqv', a.astype(vt.dtype), vt)

    o = lax.map(block, (qb, jnp.arange(n_qblocks)))
    o = o.transpose(1, 0, 3, 2, 4).reshape(b_, s_, N_ATTN_HEADS, ATTN_VALUE_DIM)
    o = rmsnorm(o, subln_gain) * (1.0 - lambda_init)
    return o.reshape(b_, s_, ATTN_WIDTH)


def s5_branch(u, lam_re, lam_im, log_dt, b_re, b_im, c_re, c_im, d_skip, w_glu, b_glu, ssm_gain):
    b_, s_ = u.shape[:2]
    f32 = jnp.float32
    uf = u.astype(f32).reshape(b_, s_, N_SSM_GROUPS, SSM_GROUP)
    lam = lax.complex(lam_re.astype(f32), lam_im.astype(f32))
    dt = jnp.exp(log_dt.astype(f32))[:, None]
    lam_bar = jnp.exp(lam * dt)
    b_c = lax.complex(b_re.astype(f32), b_im.astype(f32))
    b_bar = ((lam_bar - 1.0) / lam)[..., None] * b_c
    bu = jnp.einsum('gnc,bsgc->bsgn', b_bar, uf.astype(jnp.complex64))
    a = jnp.broadcast_to(lam_bar, bu.shape)

    def combine(left, right):
        a_l, b_l = left
        a_r, b_r = right
        return a_r * a_l, a_r * b_l + b_r

    _, states = lax.associative_scan(combine, (a, bu), axis=1)
    c_c = lax.complex(c_re.astype(f32), c_im.astype(f32))
    y = jnp.einsum('gcn,bsgn->bsgc', c_c, states).real + d_skip.astype(f32) * uf
    y = jax.nn.gelu(y.reshape(b_, s_, SSM_WIDTH))
    y = y * jax.nn.sigmoid(y @ w_glu.astype(f32) + b_glu.astype(f32))
    return rmsnorm(y, ssm_gain).astype(u.dtype)


def hier_moe(h, w_router_group, b_router_group, w_router_expert, b_router_expert, w_gate, w_up, w_down):
    n_tok = h.shape[0]
    hf = h.astype(jnp.float32)
    g_logits = hf @ w_router_group.astype(jnp.float32) + b_router_group.astype(jnp.float32)
    g_prob = jax.nn.softmax(g_logits, axis=-1)
    g_sel = jnp.argmax(g_logits, axis=-1)
    p_group = jnp.take_along_axis(g_prob, g_sel[:, None], axis=1)
    e_logits = (hf @ w_router_expert.astype(jnp.float32) + b_router_expert.astype(jnp.float32))
    e_logits = e_logits.reshape(n_tok, N_EXPERT_GROUPS, EXPERTS_PER_GROUP)
    e_in = jnp.take_along_axis(e_logits, g_sel[:, None, None], axis=1)[:, 0]
    e_prob = jax.nn.softmax(e_in, axis=-1)
    top_p, top_i = lax.top_k(e_prob, TOP_K_INNER)
    gates = p_group * top_p
    expert_id = g_sel[:, None] * EXPERTS_PER_GROUP + top_i

    n_assign = n_tok * TOP_K_INNER
    flat_e = expert_id.reshape(-1)
    flat_tok = jnp.repeat(jnp.arange(n_tok), TOP_K_INNER)
    flat_g = gates.reshape(-1)
    order = jnp.argsort(flat_e)
    se, stok, sg = flat_e[order], flat_tok[order], flat_g[order]
    counts = jnp.bincount(flat_e, length=N_EXPERTS)
    start = jnp.cumsum(counts) - counts
    padded = ((counts + MOE_BLOCK - 1) // MOE_BLOCK) * MOE_BLOCK
    pend = jnp.cumsum(padded)
    pstart = pend - padded
    dest = pstart[se] + (jnp.arange(n_assign) - start[se])
    n_rows = ((n_assign + N_EXPERTS * (MOE_BLOCK - 1) + MOE_BLOCK - 1) // MOE_BLOCK) * MOE_BLOCK
    n_blocks = n_rows // MOE_BLOCK
    rows = jnp.zeros((n_rows, h.shape[1]), h.dtype).at[dest].set(h[stok])
    block_e = jnp.minimum(jnp.searchsorted(pend, jnp.arange(n_blocks) * MOE_BLOCK, side='right'), N_EXPERTS - 1)

    def expert_block(args):
        xb, e = args
        hid = jax.nn.silu(xb @ w_gate[e]) * (xb @ w_up[e])
        return hid @ w_down[e]

    out = lax.map(expert_block, (rows.reshape(n_blocks, MOE_BLOCK, -1), block_e)).reshape(n_rows, -1)
    return jax.ops.segment_sum(out[dest] * sg[:, None].astype(out.dtype), stok, num_segments=n_tok)


def setup_inputs(seed: int = 0) -> dict:
    key = jax.random.key(seed)
    ks = jax.random.split(key, 32)
    f32 = jnp.float32
    L, D = DEPTH, D_MODEL
    nrm = lambda k, shape, s: jax.random.normal(k, shape, f32) * s
    n_idx = jnp.arange(SSM_STATE, dtype=f32)
    return {
        "x": jax.random.normal(ks[0], (BATCH, SEQ, D), f32),
        "norm_attn": 1.0 + nrm(ks[1], (L, D), 0.02),
        "w_in": nrm(ks[2], (L, D, IN_COLS), D ** -0.5),
        "lambda_q1": nrm(ks[3], (L, ATTN_HEAD_DIM), 0.1),
        "lambda_k1": nrm(ks[4], (L, ATTN_HEAD_DIM), 0.1),
        "lambda_q2": nrm(ks[5], (L, ATTN_HEAD_DIM), 0.1),
        "lambda_k2": nrm(ks[6], (L, ATTN_HEAD_DIM), 0.1),
        "attn_subln": 1.0 + nrm(ks[7], (L, ATTN_VALUE_DIM), 0.02),
        "ssm_lam_re": -0.5 + nrm(ks[8], (L, N_SSM_GROUPS, SSM_STATE), 0.01),
        "ssm_lam_im": math.pi * n_idx + nrm(ks[9], (L, N_SSM_GROUPS, SSM_STATE), 0.01),
        "ssm_log_dt": jax.random.uniform(ks[10], (L, N_SSM_GROUPS), f32, math.log(DT_MIN), math.log(DT_MAX)),
        "ssm_b_re": nrm(ks[11], (L, N_SSM_GROUPS, SSM_STATE, SSM_GROUP), (2 * SSM_GROUP) ** -0.5),
        "ssm_b_im": nrm(ks[12], (L, N_SSM_GROUPS, SSM_STATE, SSM_GROUP), (2 * SSM_GROUP) ** -0.5),
        "ssm_c_re": nrm(ks[13], (L, N_SSM_GROUPS, SSM_GROUP, SSM_STATE), (2 * SSM_STATE) ** -0.5),
        "ssm_c_im": nrm(ks[14], (L, N_SSM_GROUPS, SSM_GROUP, SSM_STATE), (2 * SSM_STATE) ** -0.5),
        "ssm_d": nrm(ks[15], (L, N_SSM_GROUPS, SSM_GROUP), 1.0),
        "w_glu": nrm(ks[16], (L, SSM_WIDTH, SSM_WIDTH), SSM_WIDTH ** -0.5),
        "b_glu": nrm(ks[17], (L, SSM_WIDTH), 0.01),
        "ssm_norm": 1.0 + nrm(ks[18], (L, SSM_WIDTH), 0.02),
        "w_out": nrm(ks[19], (L, MIX_WIDTH, D), MIX_WIDTH ** -0.5),
        "norm_moe": 1.0 + nrm(ks[20], (L, D), 0.02),
        "w_router_group": nrm(ks[21], (L, D, N_EXPERT_GROUPS), D ** -0.5),
        "b_router_group": nrm(ks[22], (L, N_EXPERT_GROUPS), 0.01),
        "w_router_expert": nrm(ks[23], (L, D, N_EXPERTS), D ** -0.5),
        "b_router_expert": nrm(ks[24], (L, N_EXPERTS), 0.01),
        "w_gate": nrm(ks[25], (L, N_EXPERTS, D, EXPERT_FF), D ** -0.5),
        "w_up": nrm(ks[26], (L, N_EXPERTS, D, EXPERT_FF), D ** -0.5),
        "w_down": nrm(ks[27], (L, N_EXPERTS, EXPERT_FF, D), EXPERT_FF ** -0.5),
        "norm_final": 1.0 + nrm(ks[28], (D,), 0.02),
    }


def reference(x, norm_attn, w_in, lambda_q1, lambda_k1, lambda_q2, lambda_k2, attn_subln,
              ssm_lam_re, ssm_lam_im, ssm_log_dt, ssm_b_re, ssm_b_im, ssm_c_re, ssm_c_im, ssm_d,
              w_glu, b_glu, ssm_norm, w_out, norm_moe, w_router_group, b_router_group,
              w_router_expert, b_router_expert, w_gate, w_up, w_down, norm_final):
    b_, s_, d_ = x.shape
    for l in range(DEPTH):
        h = rmsnorm(x, norm_attn[l])
        proj = h @ w_in[l]
        q = proj[..., :ATTN_WIDTH].reshape(b_, s_, N_ATTN_HEADS, 2, ATTN_HEAD_DIM)
        k = proj[..., ATTN_WIDTH:2 * ATTN_WIDTH].reshape(b_, s_, N_ATTN_HEADS, 2, ATTN_HEAD_DIM)
        v = proj[..., 2 * ATTN_WIDTH:3 * ATTN_WIDTH].reshape(b_, s_, N_ATTN_HEADS, ATTN_VALUE_DIM)
        u = proj[..., 3 * ATTN_WIDTH:]
        lam_init = lambda_init_fn(l)
        lam = (jnp.exp(jnp.sum(lambda_q1[l].astype(jnp.float32) * lambda_k1[l].astype(jnp.float32)))
               - jnp.exp(jnp.sum(lambda_q2[l].astype(jnp.float32) * lambda_k2[l].astype(jnp.float32)))
               + lam_init)
        attn_out = diff_attention(q, k, v, lam, attn_subln[l], lam_init)
        ssm_out = s5_branch(u, ssm_lam_re[l], ssm_lam_im[l], ssm_log_dt[l], ssm_b_re[l], ssm_b_im[l],
                            ssm_c_re[l], ssm_c_im[l], ssm_d[l], w_glu[l], b_glu[l], ssm_norm[l])
        x = x + jnp.concatenate([attn_out, ssm_out], axis=-1) @ w_out[l]
        h = rmsnorm(x, norm_moe[l]).reshape(b_ * s_, d_)
        x = x + hier_moe(h, w_router_group[l], b_router_group[l], w_router_expert[l], b_router_expert[l],
                         w_gate[l], w_up[l], w_down[l]).reshape(b_, s_, d_)
    return rmsnorm(x, norm_final)
```

```cpp
#include <hip/hip_runtime.h>
#include <cstdio>
#include <cstdint>
#include <cmath>

constexpr int D_MODEL = 1024, BATCH = 2, SEQ = 8192, T_TOK = BATCH * SEQ;
constexpr int IN_COLS = 2048, ATTN_W = 512, SSM_W = 512, NH = 4, DH = 64, DV = 128;
constexpr int NG = 32, GC = 16, NS = 64;
constexpr int NEG = 4, EPG = 8, NE = 32, FF = 512;
constexpr float RMS_EPS = 1e-6f;
constexpr float LAM_INIT = 0.2f;
constexpr float C2 = 0.125f * 1.4426950408889634f;
constexpr float LOG2E = 1.4426950408889634f;
constexpr int MAXROWS = 2 * T_TOK + NE * 256;

namespace pg8 {
#define PG8_LAS __attribute__((address_space(3)))
typedef unsigned short bf16_t;
typedef short bf16x8 __attribute__((ext_vector_type(8)));
typedef float f32x4 __attribute__((ext_vector_type(4)));
typedef unsigned u32x4 __attribute__((ext_vector_type(4)));
constexpr int BM = 256, BK = 64, HALF = 128, HTB = HALF * BK * 2  , STAGE_BYTES = 8 * HTB, NXCD = 8, WGM = 8;

__host__ __device__ __forceinline__ int lds_byte(int r, int c) { const int st = (r >> 4) * 2 + (c >> 5), rr = r & 15, cc = c & 31, ob = rr * 64 + cc * 2; return st * 1024 + (ob ^ (((ob >> 9) & 1) << 5)); }
__host__ __device__ __forceinline__ void stage_rc(int b, int& R, int& C) { const int st = b / 1024, sb = b % 1024, swz = sb ^ (((sb >> 9) & 1) << 5); R = (st >> 1) * 16 + swz / 64; C = (st & 1) * 32 + (swz % 64) / 2; }
__host__ __device__ __forceinline__ int perm32(int rho) { const int n = rho >> 4, i = rho & 15; return 8 * (i >> 2) + 4 * n + (i & 3); }

struct Unit { int pm, pn; };
struct Gemm { const bf16_t* A; const bf16_t* Bt; int M, N, K; };

struct StaticOrder {
    int nM, nN, nwg, G, c;
    __host__ __device__ void init(int M, int N, int G_, int c_) { nM = M / BM; nN = N / BM; nwg = nM * nN; G = G_; c = c_; }
    __host__ __device__ bool next(int i, Unit& u) const {
        const long L = (long)i * G + c; if (L >= nwg) return false;
        int wgid = (int)L; { const int q = nwg / NXCD, r = nwg % NXCD, xcd = wgid % NXCD, off = wgid / NXCD; wgid = (xcd < r ? xcd * (q + 1) : r * (q + 1) + (xcd - r) * q) + off; }
        const int nig = WGM * nN, gid = wgid / nig, fm = gid * WGM, gsz = (nM - fm) < WGM ? (nM - fm) : WGM;
        u.pm = fm + ((wgid % nig) % gsz); u.pn = (wgid % nig) / gsz; return true;
    }
    __device__ __forceinline__ void a_ready(const Unit&) const {}
    __device__ __forceinline__ void done(const Unit&) const {}
};

typedef unsigned u32x4 __attribute__((ext_vector_type(4)));
__device__ __forceinline__ unsigned cvt_pk_bf16(float lo, float hi) { unsigned r; asm volatile("v_cvt_pk_bf16_f32 %0, %1, %2" : "=v"(r) : "v"(lo), "v"(hi)); return r; }
__device__ __forceinline__ float bf_lo(unsigned w) { return __uint_as_float(w << 16); }
__device__ __forceinline__ float bf_hi(unsigned w) { return __uint_as_float(w & 0xffff0000u); }
__device__ __forceinline__ float sigmoid_f(float v) { return __builtin_amdgcn_rcpf(1.0f + __builtin_amdgcn_exp2f(-1.4426950408889634f * v)); }

struct EpiInProj {
    static constexpr bool PERM = true, AFTER_DRAIN = false, MIDK = false;
    bf16_t* O;
    __device__ __forceinline__ void operator()(const f32x4 (&acc)[2][2][4][2], const Unit& u, int wr, int wc, int fr, int fq) const {
        const int row0 = u.pm * BM + wr * 64 + fr; int colt = u.pn * BM; const int t = colt >> 9; colt -= t << 9;
        bf16_t* base = O + (size_t)t * ((size_t)16384 * 512); const float sc = (t == 0) ? (0.125f * 1.4426950408889634f) : 1.f;
        const int col0 = colt + wc * 32 + 8 * fq;
#pragma unroll
        for (int ai = 0; ai < 2; ++ai)
#pragma unroll
            for (int m = 0; m < 4; ++m) { bf16_t* rowp = base + (size_t)(row0 + ai * HALF + m * 16) * 512 + col0;
#pragma unroll
                for (int bj = 0; bj < 2; ++bj) { const f32x4 v0 = acc[ai][bj][m][0] * sc, v1 = acc[ai][bj][m][1] * sc;
                    u32x4 w; w.x = cvt_pk_bf16(v0[0], v0[1]); w.y = cvt_pk_bf16(v0[2], v0[3]); w.z = cvt_pk_bf16(v1[0], v1[1]); w.w = cvt_pk_bf16(v1[2], v1[3]);
                    *(u32x4*)(rowp + bj * HALF) = w; } }
    }
};
struct EpiGlu {
    static constexpr bool PERM = true, AFTER_DRAIN = false, MIDK = false;
    const bf16_t* Yg; const float* bias; bf16_t* CC; float* SSQP;
    __device__ __forceinline__ void operator()(const f32x4 (&acc)[2][2][4][2], const Unit& u, int wr, int wc, int fr, int fq) const {
        const int row0 = u.pm * BM + wr * 64 + fr, col0 = u.pn * BM + wc * 32 + 8 * fq;
        f32x4 bv[2][2];
#pragma unroll
        for (int bj = 0; bj < 2; ++bj)
#pragma unroll
            for (int n = 0; n < 2; ++n) bv[bj][n] = *(const f32x4*)(bias + col0 + bj * HALF + 4 * n);
#pragma unroll
        for (int ai = 0; ai < 2; ++ai)
#pragma unroll
            for (int m = 0; m < 4; ++m) { const int row = row0 + ai * HALF + m * 16; float ss = 0.f;
#pragma unroll
                for (int bj = 0; bj < 2; ++bj) { const int col = col0 + bj * HALF;
                    const u32x4 y8 = *(const u32x4*)(Yg + (size_t)row * 512 + col);
                    const f32x4 a0 = acc[ai][bj][m][0] + bv[bj][0], a1 = acc[ai][bj][m][1] + bv[bj][1];
                    float z[8];
                    z[0] = bf_lo(y8.x) * sigmoid_f(a0[0]); z[1] = bf_hi(y8.x) * sigmoid_f(a0[1]); z[2] = bf_lo(y8.y) * sigmoid_f(a0[2]); z[3] = bf_hi(y8.y) * sigmoid_f(a0[3]);
                    z[4] = bf_lo(y8.z) * sigmoid_f(a1[0]); z[5] = bf_hi(y8.z) * sigmoid_f(a1[1]); z[6] = bf_lo(y8.w) * sigmoid_f(a1[2]); z[7] = bf_hi(y8.w) * sigmoid_f(a1[3]);
#pragma unroll
                    for (int i = 0; i < 8; ++i) ss += z[i] * z[i];
                    u32x4 w; w.x = cvt_pk_bf16(z[0], z[1]); w.y = cvt_pk_bf16(z[2], z[3]); w.z = cvt_pk_bf16(z[4], z[5]); w.w = cvt_pk_bf16(z[6], z[7]);
                    *(u32x4*)(CC + (size_t)row * 1024 + col) = w; }
                ss += __shfl_xor(ss, 16); ss += __shfl_xor(ss, 32);
                if (fq == 0) SSQP[(size_t)row * 8 + u.pn * 4 + wc] = ss; }
    }
};
struct EpiOut {
    static constexpr bool PERM = false, AFTER_DRAIN = false, MIDK = true;
    const float* x; float* out; const float* SSQP;
    __device__ __forceinline__ void midk(f32x4 (&acc)[2][2][4][2], const Unit& u, int wr, int wc, int fr, int fq) const {
#pragma unroll
        for (int ai = 0; ai < 2; ++ai)
#pragma unroll
            for (int m = 0; m < 4; ++m) { const int row = u.pm * BM + ai * HALF + wr * 64 + m * 16 + fr;
                const f32x4 s0 = *(const f32x4*)(SSQP + (size_t)row * 8), s1 = *(const f32x4*)(SSQP + (size_t)row * 8 + 4);
                const float s = ((s0[0] + s0[1]) + (s0[2] + s0[3])) + ((s1[0] + s1[1]) + (s1[2] + s1[3]));
                const float r = __builtin_amdgcn_rsqf(s * (1.0f / 512.0f) + 1e-6f);
#pragma unroll
                for (int bj = 0; bj < 2; ++bj)
#pragma unroll
                    for (int n = 0; n < 2; ++n) acc[ai][bj][m][n] *= r; }
    }
    __device__ __forceinline__ void operator()(const f32x4 (&acc)[2][2][4][2], const Unit& u, int wr, int wc, int fr, int fq) const {
        const int col0 = u.pn * BM + wc * 32 + 4 * fq;
#pragma unroll
        for (int ai = 0; ai < 2; ++ai)
#pragma unroll
            for (int m = 0; m < 4; ++m) { const size_t off = (size_t)(u.pm * BM + ai * HALF + wr * 64 + m * 16 + fr) * 1024 + col0;
#pragma unroll
                for (int bj = 0; bj < 2; ++bj)
#pragma unroll
                    for (int n = 0; n < 2; ++n) { const f32x4 bs = *(const f32x4*)(x + off + bj * HALF + n * 16); *(f32x4*)(out + off + bj * HALF + n * 16) = bs + acc[ai][bj][m][n]; } }
    }
};
struct EpiMoeUp {
    static constexpr bool PERM = true, AFTER_DRAIN = false, MIDK = false;
    bf16_t* HID; const float* ROWSC;
    __device__ __forceinline__ void operator()(const f32x4 (&acc)[2][2][4][2], const Unit& u, int wr, int wc, int fr, int fq) const {
        const int row0 = u.pm * BM + wr * 64 + fr, j0 = (u.pn & 3) * HALF + wc * 32 + 8 * fq;
#pragma unroll
        for (int ai = 0; ai < 2; ++ai)
#pragma unroll
            for (int m = 0; m < 4; ++m) { const int row = row0 + ai * HALF + m * 16; const float rs = ROWSC[row];
                float h[8];
#pragma unroll
                for (int n = 0; n < 2; ++n)
#pragma unroll
                    for (int i = 0; i < 4; ++i) { const float g = acc[ai][0][m][n][i] * rs, up = acc[ai][1][m][n][i] * rs; h[n * 4 + i] = g * sigmoid_f(g) * up; }
                u32x4 w; w.x = cvt_pk_bf16(h[0], h[1]); w.y = cvt_pk_bf16(h[2], h[3]); w.z = cvt_pk_bf16(h[4], h[5]); w.w = cvt_pk_bf16(h[6], h[7]);
                *(u32x4*)(HID + (size_t)row * 512 + j0) = w; }
    }
};
struct EpiMoeDown {
    static constexpr bool PERM = true, AFTER_DRAIN = false, MIDK = false;
    bf16_t* Y; const float* ROWGT;
    __device__ __forceinline__ void operator()(const f32x4 (&acc)[2][2][4][2], const Unit& u, int wr, int wc, int fr, int fq) const {
        const int row0 = u.pm * BM + wr * 64 + fr, col0 = (u.pn & 3) * BM + wc * 32 + 8 * fq;
#pragma unroll
        for (int ai = 0; ai < 2; ++ai)
#pragma unroll
            for (int m = 0; m < 4; ++m) { const int row = row0 + ai * HALF + m * 16; const float gt = ROWGT[row];
#pragma unroll
                for (int bj = 0; bj < 2; ++bj) { const f32x4 v0 = acc[ai][bj][m][0] * gt, v1 = acc[ai][bj][m][1] * gt;
                    u32x4 w; w.x = cvt_pk_bf16(v0[0], v0[1]); w.y = cvt_pk_bf16(v0[2], v0[3]); w.z = cvt_pk_bf16(v1[0], v1[1]); w.w = cvt_pk_bf16(v1[2], v1[3]);
                    *(u32x4*)(Y + (size_t)row * 1024 + col0 + bj * HALF) = w; } }
    }
};
struct MoeOrder {
    const int* tile_e; int ntiles, G, c;
    __device__ __forceinline__ bool next(int i, Unit& u) const {
        const int L = i * G + c; if (L >= ntiles * 4) return false;
        u.pm = L >> 2; const int e = __builtin_amdgcn_readfirstlane(tile_e[u.pm]); u.pn = e * 4 + (L & 3); return true;
    }
    __device__ __forceinline__ void a_ready(const Unit&) const {}
    __device__ __forceinline__ void done(const Unit&) const {}
};
template <class Epi, class Sched, bool ALIGN_EPI = false, bool SP2 = false>
__device__ __forceinline__ void gemm_phase(PG8_LAS unsigned char* lds, const Gemm g, const Sched& S, const Epi& E) {
    const int tid = threadIdx.x, wid = __builtin_amdgcn_readfirstlane(tid >> 6), lane = tid & 63, wr = wid >> 2, wc = wid & 3, fr = lane & 15, fq = lane >> 4;
    const int K = g.K, nt = K / BK;
    unsigned voffA[2], voffB[2];
#pragma unroll
    for (int i = 0; i < 2; ++i) { int R, C; stage_rc(tid * 16 + i * 8192, R, C); const int Rb = Epi::PERM ? ((R & ~31) + perm32(R & 31)) : R;
        voffA[i] = (unsigned)(R * K + C) * 2u; voffB[i] = (unsigned)(Rb * K + C) * 2u; }
    const size_t kstep = (size_t)(BK * 2);
    const size_t hstep = (size_t)HALF * K * 2;
    const size_t tstep = 2 * hstep;
    const unsigned ldsw = (unsigned)wid * 1024u;
    const int aoff = lds_byte(wr * 64 + fr, fq * 8), boff = lds_byte(wc * 32 + fr, fq * 8);
#define PG8_SA(b, h) (((b) * 2 + (h)) * HTB)
#define PG8_SB(b, h) ((4 + (b) * 2 + (h)) * HTB)
#define PG8_STAGE(bufoff, gbase, voff) do { _Pragma("unroll") for (int _i = 0; _i < 2; ++_i) \
        __builtin_amdgcn_global_load_lds((const unsigned*)((const char*)(gbase) + (voff)[_i]), (PG8_LAS unsigned*)(lds + (bufoff) + ldsw + _i * 8192), 16, 0, 0); } while (0)
#define PG8_LDA(dst, b, h) do { _Pragma("unroll") for (int m = 0; m < 4; ++m) _Pragma("unroll") for (int k = 0; k < 2; ++k) dst[m][k] = *(const PG8_LAS bf16x8*)(lds + PG8_SA(b, h) + aoff + m * 2048 + k * 1024); } while (0)
#define PG8_LDB(dst, b, h) do { _Pragma("unroll") for (int n = 0; n < 2; ++n) _Pragma("unroll") for (int k = 0; k < 2; ++k) dst[n][k] = *(const PG8_LAS bf16x8*)(lds + PG8_SB(b, h) + boff + n * 2048 + k * 1024); } while (0)
#define PG8_MMA(ai, bj, At, Bt) do { __builtin_amdgcn_s_setprio(1); _Pragma("unroll") for (int m = 0; m < 4; ++m) _Pragma("unroll") for (int n = 0; n < 2; ++n) _Pragma("unroll") for (int k = 0; k < 2; ++k) \
        acc[ai][bj][m][n] = __builtin_amdgcn_mfma_f32_16x16x32_bf16(Bt[n][k], At[m][k], acc[ai][bj][m][n], 0, 0, 0); __builtin_amdgcn_s_setprio(0); } while (0)
#define PG8_WAIT_V(n) asm volatile("s_waitcnt vmcnt(" #n ")" ::: "memory")
#define PG8_WAIT_L(n) asm volatile("s_waitcnt lgkmcnt(" #n ")" ::: "memory")
#define PG8_BAR __builtin_amdgcn_s_barrier()
#define PG8_SCHED __builtin_amdgcn_sched_barrier(0)
    Unit cur, nxt; int ui = 0;
    if (!S.next(0, cur)) return;
    f32x4 acc[2][2][4][2];
#pragma unroll
    for (int a = 0; a < 2; ++a)
#pragma unroll
        for (int b = 0; b < 2; ++b)
#pragma unroll
            for (int m = 0; m < 4; ++m)
#pragma unroll
                for (int n = 0; n < 2; ++n) acc[a][b][m][n] = (f32x4){0.f, 0.f, 0.f, 0.f};
    bf16x8 At[4][2], B0[2][2], B1[2][2];
    const char* cA = (const char*)g.A + (size_t)cur.pm * tstep; const char* cB = (const char*)g.Bt + (size_t)cur.pn * tstep;
    S.a_ready(cur);
    if constexpr (SP2) {
        PG8_STAGE(PG8_SB(0, 0), cB, voffB); PG8_STAGE(PG8_SB(0, 1), cB + hstep, voffB); PG8_STAGE(PG8_SA(0, 0), cA, voffA); PG8_STAGE(PG8_SA(0, 1), cA + hstep, voffA);
        if (wr == 1) PG8_BAR;
        PG8_WAIT_V(2); PG8_BAR;
        PG8_STAGE(PG8_SB(1, 0), cB + kstep, voffB); PG8_STAGE(PG8_SA(1, 0), cA + kstep, voffA); PG8_STAGE(PG8_SB(1, 1), cB + hstep + kstep, voffB);
        PG8_WAIT_V(6); PG8_BAR;
    } else {
        PG8_STAGE(PG8_SB(0, 0), cB, voffB); PG8_STAGE(PG8_SA(0, 0), cA, voffA); PG8_STAGE(PG8_SB(0, 1), cB + hstep, voffB); PG8_STAGE(PG8_SA(0, 1), cA + hstep, voffA);
        if (wr == 1) PG8_BAR;
        PG8_WAIT_V(4); PG8_BAR;
        PG8_STAGE(PG8_SB(1, 0), cB + kstep, voffB); PG8_STAGE(PG8_SA(1, 0), cA + kstep, voffA); PG8_STAGE(PG8_SB(1, 1), cB + hstep + kstep, voffB);
        PG8_WAIT_V(6); PG8_BAR;
    }
    for (;;) {
        const bool has_next = S.next(ui + 1, nxt);
        const char* nA = has_next ? (const char*)g.A + (size_t)nxt.pm * tstep : cA; const char* nB = has_next ? (const char*)g.Bt + (size_t)nxt.pn * tstep : cB;
        for (int t = 0; t < nt; t += 2) {
            if constexpr (Epi::MIDK) { if (t == (nt >> 1)) E.midk(acc, cur, wr, wc, fr, fq); }
            const bool last = (t == nt - 2);
            const char* a1 = cA + (size_t)(t + 1) * kstep;
            const char* a2 = last ? nA : cA + (size_t)(t + 2) * kstep; const char* b2 = last ? nB : cB + (size_t)(t + 2) * kstep;
            const char* a3 = a2 + kstep; const char* b3 = b2 + kstep;
            if (last && has_next) S.a_ready(nxt);
            if constexpr (SP2) {
            PG8_LDB(B0, 0, 0); PG8_LDB(B1, 0, 1); PG8_SCHED; PG8_LDA(At, 0, 0); PG8_STAGE(PG8_SA(1, 1), a1 + hstep, voffA);
            PG8_WAIT_V(8); PG8_WAIT_L(0); PG8_BAR; PG8_MMA(0, 0, At, B0); PG8_MMA(0, 1, At, B1); PG8_BAR; PG8_SCHED;
            PG8_LDA(At, 0, 1); PG8_STAGE(PG8_SB(0, 0), b2, voffB); PG8_STAGE(PG8_SB(0, 1), b2 + hstep, voffB); PG8_STAGE(PG8_SA(0, 0), a2, voffA);
            PG8_WAIT_V(8); PG8_WAIT_L(0); PG8_BAR; PG8_MMA(1, 0, At, B0); PG8_MMA(1, 1, At, B1); PG8_BAR; PG8_SCHED;
            PG8_LDB(B0, 1, 0); PG8_LDB(B1, 1, 1); PG8_SCHED; PG8_LDA(At, 1, 0); PG8_STAGE(PG8_SA(0, 1), a2 + hstep, voffA);
            PG8_WAIT_V(8); PG8_WAIT_L(0); PG8_BAR; PG8_MMA(0, 0, At, B0); PG8_MMA(0, 1, At, B1); PG8_BAR; PG8_SCHED;
            PG8_LDA(At, 1, 1); PG8_STAGE(PG8_SB(1, 0), b3, voffB); PG8_STAGE(PG8_SB(1, 1), b3 + hstep, voffB); PG8_STAGE(PG8_SA(1, 0), a3, voffA);
            PG8_WAIT_V(8); PG8_WAIT_L(0); PG8_BAR; PG8_MMA(1, 0, At, B0); PG8_MMA(1, 1, At, B1); PG8_BAR; PG8_SCHED;
            } else {
            PG8_LDB(B0, 0, 0); PG8_SCHED; PG8_LDA(At, 0, 0); PG8_STAGE(PG8_SA(1, 1), a1 + hstep, voffA);
            PG8_WAIT_L(8); PG8_BAR; PG8_WAIT_L(0); PG8_MMA(0, 0, At, B0); PG8_BAR; PG8_SCHED;
            PG8_LDB(B1, 0, 1); PG8_STAGE(PG8_SB(0, 0), b2, voffB);
            PG8_BAR; PG8_WAIT_L(0); PG8_MMA(0, 1, At, B1); PG8_BAR;
            PG8_LDA(At, 0, 1); PG8_STAGE(PG8_SA(0, 0), a2, voffA);
            PG8_BAR; PG8_WAIT_L(0); PG8_MMA(1, 0, At, B0); PG8_BAR; PG8_SCHED;
            PG8_STAGE(PG8_SB(0, 1), b2 + hstep, voffB);
            PG8_WAIT_V(6); PG8_BAR; PG8_MMA(1, 1, At, B1); PG8_BAR;
            PG8_LDB(B0, 1, 0); PG8_SCHED; PG8_LDA(At, 1, 0); PG8_STAGE(PG8_SA(0, 1), a2 + hstep, voffA);
            PG8_WAIT_L(8); PG8_BAR; PG8_WAIT_L(0); PG8_MMA(0, 0, At, B0); PG8_BAR; PG8_SCHED;
            PG8_LDB(B1, 1, 1); PG8_STAGE(PG8_SB(1, 0), b3, voffB);
            PG8_BAR; PG8_WAIT_L(0); PG8_MMA(0, 1, At, B1); PG8_BAR;
            PG8_LDA(At, 1, 1); PG8_STAGE(PG8_SA(1, 0), a3, voffA);
            PG8_BAR; PG8_WAIT_L(0); PG8_MMA(1, 0, At, B0); PG8_BAR; PG8_SCHED;
            PG8_STAGE(PG8_SB(1, 1), b3 + hstep, voffB);
            PG8_WAIT_V(6); PG8_BAR; PG8_MMA(1, 1, At, B1); PG8_BAR;
            }
        }
        if constexpr (ALIGN_EPI) { if (wr == 0) PG8_BAR; }
        if constexpr (!Epi::AFTER_DRAIN) { E(acc, cur, wr, wc, fr, fq); S.done(cur); }
        if (!has_next) break;
#pragma unroll
        for (int a = 0; a < 2; ++a)
#pragma unroll
            for (int b = 0; b < 2; ++b)
#pragma unroll
                for (int m = 0; m < 4; ++m)
#pragma unroll
                    for (int n = 0; n < 2; ++n) acc[a][b][m][n] = (f32x4){0.f, 0.f, 0.f, 0.f};
        cur = nxt; cA = nA; cB = nB; ++ui;
        if constexpr (ALIGN_EPI) { if (wr == 1) PG8_BAR; }
    }
    PG8_WAIT_V(0);
    if constexpr (!ALIGN_EPI) { if (wr == 0) PG8_BAR; }
    PG8_BAR;
    if constexpr (Epi::AFTER_DRAIN) { E.fused(acc, cur, wr, wc, fr, fq, lds, wid, lane); S.done(cur); }
#undef PG8_SA
#undef PG8_SB
#undef PG8_STAGE
#undef PG8_LDA
#undef PG8_LDB
#undef PG8_MMA
#undef PG8_WAIT_V
#undef PG8_WAIT_L
#undef PG8_BAR
#undef PG8_SCHED
}
}
using pg8::bf16_t;
constexpr size_t MiB = 1u << 20, KiB = 1u << 10;
constexpr size_t WS_CTL = 0, CTL_ZERO_BYTES = 1 * MiB;
constexpr size_t WS_SMALL = 1 * MiB;
constexpr size_t WS_WTIN = 4 * MiB, WS_WTOUT = 8 * MiB, WS_WTGLU = 10 * MiB, WS_WR = 10 * MiB + 512 * KiB, WS_WTGU = 11 * MiB, WS_WTD = 75 * MiB;
constexpr size_t WS_R1 = 107 * MiB;
constexpr size_t WS_BIG = 139 * MiB;
constexpr size_t WS_Q = WS_BIG, WS_K = WS_BIG + 16 * MiB, WS_V = WS_BIG + 32 * MiB, WS_U = WS_BIG + 48 * MiB, WS_O1 = WS_BIG + 64 * MiB, WS_O2 = WS_BIG + 80 * MiB, WS_YG = WS_BIG + 96 * MiB;
constexpr size_t WS_ROWS = WS_BIG, WS_HID = WS_BIG + 80 * MiB;
constexpr size_t WS_END = WS_BIG + 120 * MiB;
static_assert((size_t)MAXROWS * 1024 * 2 == 80 * MiB && (size_t)MAXROWS * 512 * 2 == 40 * MiB, "moe buffers");
constexpr size_t SM_SSQP = 0, SM_RINV = 512 * KiB, SM_EID = 576 * KiB, SM_GATE = 704 * KiB, SM_DEST = 832 * KiB, SM_LRANK = 960 * KiB, SM_TOKROW = 1088 * KiB,
                 SM_ROWSC = 1248 * KiB, SM_ROWGT = 1408 * KiB, SM_TILEE = 1568 * KiB, SM_CNT = 1572 * KiB, SM_META = 1604 * KiB;
constexpr int CW_BAR = 4096;

constexpr int RING_BYTES = 131072, LDSCTL_OFF = RING_BYTES, MISC_OFF = LDSCTL_OFF + 320, LDS_BYTES = 147456;

#define GAS __attribute__((address_space(1)))
#define LAS __attribute__((address_space(3)))
typedef unsigned v4u __attribute__((ext_vector_type(4)));
typedef unsigned v2u __attribute__((ext_vector_type(2)));
typedef float f32x4 __attribute__((ext_vector_type(4)));
typedef short bf16x8 __attribute__((ext_vector_type(8)));
#define LDS_WAIT() asm volatile("s_waitcnt lgkmcnt(0)" ::: "memory")
#define VM_WAIT() asm volatile("s_waitcnt vmcnt(0)" ::: "memory")
__device__ __forceinline__ unsigned f2bf(float f) { unsigned u = __builtin_bit_cast(unsigned, f); return (u + 0x7fffu + ((u >> 16) & 1u)) >> 16; }
__device__ __forceinline__ unsigned pk2(float lo, float hi) { return f2bf(lo) | (f2bf(hi) << 16); }
__device__ __forceinline__ float bf2f(unsigned short h) { return __uint_as_float(((unsigned)h) << 16); }
__device__ __forceinline__ float wave_sum(float v) {
#pragma unroll
    for (int o = 1; o < 64; o <<= 1) v += __shfl_xor(v, o);
    return v;
}
__device__ __forceinline__ float wave_max(float v) {
#pragma unroll
    for (int o = 1; o < 64; o <<= 1) v = fmaxf(v, __shfl_xor(v, o));
    return v;
}
#define XB_TMO      128
#define XB_XCNT(j)  (256  + 64 * (j))
#define XB_XSUB(j)  (1280 + 64 * (j))
#define XB_XGEN(j)  (2304 + 64 * (j))
#define XB_TOP      3328
#define XB_TOPGEN   3392
#define XCD_BAR_WORDS 3456
#define XB_SPIN_CAP (1u << 18)

__device__ __forceinline__ unsigned xb_ld(unsigned* p)              { return __hip_atomic_load(p, __ATOMIC_RELAXED, __HIP_MEMORY_SCOPE_AGENT); }
__device__ __forceinline__ unsigned xb_add(unsigned* p, unsigned v) { return __hip_atomic_fetch_add(p, v, __ATOMIC_RELAXED, __HIP_MEMORY_SCOPE_AGENT); }
__device__ __forceinline__ unsigned xb_xcc_id() { return (unsigned)__builtin_amdgcn_s_getreg((3 << 11) | 20) & 0xFu; }
#define XB_SPIN(cond, bar) do { unsigned _sp = 0; while (cond) { __builtin_amdgcn_s_sleep(1); \
    if ((++_sp & 255u) == 0u) { if (xb_ld(&(bar)[XB_TMO])) break; if (_sp > XB_SPIN_CAP) { atomicAdd(&(bar)[XB_TMO], 1u); break; } } } } while (0)

struct XcdBarrier {
    unsigned* bar; unsigned x;
    volatile LAS unsigned* st;
};

__device__ __forceinline__ XcdBarrier xcd_barrier_post(unsigned* bar, volatile LAS unsigned* st) {
    XcdBarrier b; b.bar = bar; b.x = xb_xcc_id(); b.st = st;
    if (threadIdx.x == 0) (void)xb_add(&bar[XB_XCNT(b.x)], 1u);
    return b;
}
__device__ __forceinline__ void xcd_barrier_complete(unsigned* bar, unsigned x, unsigned& nloc, unsigned& nx) {
    const unsigned G = gridDim.x * gridDim.y * gridDim.z;
    unsigned sum, cnt, mine, sp = 0u;
    for (;;) {
        sum = 0u; cnt = 0u; mine = 0u;
#pragma unroll
        for (unsigned j = 0; j < 16; ++j) { const unsigned c = xb_ld(&bar[XB_XCNT(j)]); sum += c; cnt += (c > 0u) ? 1u : 0u; mine = (j == x) ? c : mine; }
        if (sum == G) break;
        __builtin_amdgcn_s_sleep(1);
        if ((++sp & 255u) == 0u) { if (xb_ld(&bar[XB_TMO])) break; if (sp > XB_SPIN_CAP) { atomicAdd(&bar[XB_TMO], 1u); break; } }
    }
    nloc = mine > 0u ? mine : 1u; nx = cnt > 0u ? cnt : 1u;
}

__device__ __forceinline__ void xcd_barrier(const XcdBarrier& b) {
    asm volatile("s_waitcnt vmcnt(0)" ::: "memory");
    __syncthreads();
    if (threadIdx.x == 0) {
        unsigned* bar = b.bar;
        __builtin_amdgcn_s_waitcnt(0);
        unsigned nloc = b.st[0], nx = b.st[1];
        if (nloc == 0u) { xcd_barrier_complete(bar, b.x, nloc, nx); b.st[0] = nloc; b.st[1] = nx; }
        const unsigned old = xb_add(&bar[XB_XSUB(b.x)], 1u);
        const unsigned gen = old / nloc;
        if (old + 1u == (gen + 1u) * nloc) {
            __builtin_amdgcn_fence(__ATOMIC_RELEASE, "agent");
            asm volatile("s_waitcnt vmcnt(0)" ::: "memory");
            const unsigned og = xb_add(&bar[XB_TOP], 1u);
            const unsigned tg = og / nx;
            if (og + 1u == (tg + 1u) * nx) xb_add(&bar[XB_TOPGEN], 1u);
            else XB_SPIN(xb_ld(&bar[XB_TOPGEN]) == tg, bar);
            __builtin_amdgcn_fence(__ATOMIC_ACQUIRE, "agent");
            xb_add(&bar[XB_XGEN(b.x)], 1u);
            asm volatile("s_waitcnt vmcnt(0)" ::: "memory");
        } else {
            XB_SPIN(xb_ld(&bar[XB_XGEN(b.x)]) == gen, bar);
            __builtin_amdgcn_fence(__ATOMIC_ACQUIRE, "agent");
            asm volatile("s_waitcnt vmcnt(0)" ::: "memory");
        }
    }
    __syncthreads();
}

struct Args { const float* in[29]; float* out; unsigned char* ws; int ph_lo, ph_hi; };
enum { IN_X = 0, IN_NORM_ATTN, IN_W_IN, IN_LQ1, IN_LK1, IN_LQ2, IN_LK2, IN_SUBLN, IN_LAM_RE, IN_LAM_IM, IN_LOG_DT, IN_B_RE, IN_B_IM, IN_C_RE, IN_C_IM, IN_SSM_D,
       IN_W_GLU, IN_B_GLU, IN_SSM_NORM, IN_W_OUT, IN_NORM_MOE, IN_WRG, IN_BRG, IN_WRE, IN_BRE, IN_W_GATE, IN_W_UP, IN_W_DOWN, IN_NORM_FINAL };

__device__ __forceinline__ void tr_item(const float* __restrict__ W, int ldw, int ks0, int ns0, bf16_t* WT, int ldt, int rd0, int kd0, const float* kscale, LAS float* scr, int lane) {
#pragma unroll 8
    for (int i = 0; i < 32; ++i) { const int kk = 2 * i + (lane >> 5); float v = W[(size_t)(ks0 + kk) * ldw + ns0 + (lane & 31)]; if (kscale) v *= kscale[kk]; scr[kk * 33 + (lane & 31)] = v; }
    LDS_WAIT(); asm volatile("" ::: "memory");
    const int c = lane & 7;
#pragma unroll
    for (int j = 0; j < 4; ++j) { const int n = (lane >> 3) + 8 * j; const LAS float* s = scr + (8 * c) * 33 + n;
        v4u o; o.x = pk2(s[0 * 33], s[1 * 33]); o.y = pk2(s[2 * 33], s[3 * 33]); o.z = pk2(s[4 * 33], s[5 * 33]); o.w = pk2(s[6 * 33], s[7 * 33]);
        *(GAS v4u*)(WT + (size_t)(rd0 + n) * ldt + kd0 + 8 * c) = o; }
    LDS_WAIT(); asm volatile("" ::: "memory");
}
__device__ __forceinline__ void phase0(const Args& a, LAS unsigned char* lds, int lane, int wave, int vcu, int G) {
    LAS float* scr = (LAS float*)(lds + wave * 16384);
    const int gw = vcu * 8 + wave, NGW = G * 8;
    unsigned char* ws = a.ws;
    bf16_t* WT_in = (bf16_t*)(ws + WS_WTIN); bf16_t* WT_out = (bf16_t*)(ws + WS_WTOUT); bf16_t* WT_glu = (bf16_t*)(ws + WS_WTGLU);
    bf16_t* WT_gu = (bf16_t*)(ws + WS_WTGU); bf16_t* WT_d = (bf16_t*)(ws + WS_WTD);
    constexpr int I_IN = 16 * 64, I_OUT = 16 * 32, I_GLU = 8 * 16, I_E = 768, NITEMS = I_IN + I_OUT + I_GLU + NE * I_E;
    for (int it = gw; it < NITEMS; it += NGW) {
        int r = it;
        if (r < I_IN) { const int kb = r >> 6, nb = r & 63; tr_item(a.in[IN_W_IN], IN_COLS, 64 * kb, 32 * nb, WT_in, 1024, 32 * nb, 64 * kb, nullptr, scr, lane); continue; } r -= I_IN;
        if (r < I_OUT) { const int kb = r >> 5, nb = r & 31, ks0 = 64 * kb;
            tr_item(a.in[IN_W_OUT], 1024, ks0, 32 * nb, WT_out, 1024, 32 * nb, (ks0 + 512) & 1023, ks0 >= 512 ? a.in[IN_SSM_NORM] + (ks0 - 512) : nullptr, scr, lane); continue; } r -= I_OUT;
        if (r < I_GLU) { const int kb = r >> 4, nb = r & 15; tr_item(a.in[IN_W_GLU], 512, 64 * kb, 32 * nb, WT_glu, 512, 32 * nb, 64 * kb, nullptr, scr, lane); continue; } r -= I_GLU;
        const int e = r / I_E; r -= e * I_E;
        if (r < 512) { const int up = r >> 8; r &= 255; const int kb = r >> 4, nb = r & 15, n0 = 32 * nb;
            tr_item(a.in[up ? IN_W_UP : IN_W_GATE] + (size_t)e * 1024 * 512, 512, 64 * kb, n0, WT_gu, 1024, e * 1024 + (n0 >> 7) * 256 + up * 128 + (n0 & 127), 64 * kb, nullptr, scr, lane); continue; }
        r -= 512; { const int kb = r >> 5, nb = r & 31; tr_item(a.in[IN_W_DOWN] + (size_t)e * 512 * 1024, 1024, 64 * kb, 32 * nb, WT_d, 512, e * 1024 + 32 * nb, 64 * kb, nullptr, scr, lane); }
    }
    { const float* x = a.in[IN_X]; const float* g = a.in[IN_NORM_ATTN]; bf16_t* XN = (bf16_t*)(ws + WS_R1);
      f32x4 gv[4];
#pragma unroll
      for (int j = 0; j < 4; ++j) gv[j] = *(const f32x4*)(g + 4 * lane + 256 * j);
      for (int m = gw; m < T_TOK; m += NGW) {
        const GAS f32x4* xr = (const GAS f32x4*)(x + (size_t)m * D_MODEL) + lane;
        f32x4 v[4]; float s = 0.f;
#pragma unroll
        for (int j = 0; j < 4; ++j) { v[j] = xr[64 * j]; s += (v[j].x * v[j].x + v[j].y * v[j].y) + (v[j].z * v[j].z + v[j].w * v[j].w); }
        const float rstd = 1.f / sqrtf(wave_sum(s) * (1.f / D_MODEL) + RMS_EPS);
        GAS v2u* o8 = (GAS v2u*)(XN + (size_t)m * D_MODEL) + lane;
#pragma unroll
        for (int j = 0; j < 4; ++j) { v2u o; o.x = pk2(v[j].x * rstd * gv[j].x, v[j].y * rstd * gv[j].y); o.y = pk2(v[j].z * rstd * gv[j].z, v[j].w * rstd * gv[j].w); o8[64 * j] = o; }
      } }
    { bf16_t* WRhi = (bf16_t*)(ws + WS_WR); bf16_t* WRlo = WRhi + 48 * 1024;
      for (int i = gw * 64 + lane; i < 48 * 1024; i += NGW * 64) { const int c = i >> 10, k = i & 1023;
        const float w = c < 4 ? a.in[IN_WRG][k * 4 + c] : (c < 36 ? a.in[IN_WRE][k * 32 + (c - 4)] : 0.f);
        const unsigned hi = f2bf(w); WRhi[i] = (bf16_t)hi; WRlo[i] = (bf16_t)f2bf(w - bf2f((unsigned short)hi)); } }
}

__device__ __forceinline__ void phase5(const Args& a, LAS unsigned char* lds, int tid, int lane, int wave, int vcu, int G) {
    unsigned char* ws = a.ws;
    const float* x1 = a.out; const float* g2 = a.in[IN_NORM_MOE];
    bf16_t* H2 = (bf16_t*)(ws + WS_R1);
    const bf16_t* WRhi = (const bf16_t*)(ws + WS_WR); const bf16_t* WRlo = WRhi + 48 * 1024;
    float* RINV = (float*)(ws + WS_SMALL + SM_RINV); int* EID = (int*)(ws + WS_SMALL + SM_EID); float* GATE = (float*)(ws + WS_SMALL + SM_GATE);
    int* LRANK = (int*)(ws + WS_SMALL + SM_LRANK); int* CNT = (int*)(ws + WS_SMALL + SM_CNT);
    LAS float* PL = (LAS float*)lds;
    LAS float* PS = PL + 2 * 4 * 16 * 49;
    LAS int* EL = (LAS int*)(PS + 2 * 4 * 16);
    const int tg = wave & 3, kh = wave >> 2, r16 = lane & 15, kq = lane >> 4;
    for (int wgi = vcu; wgi < T_TOK / 64; wgi += G) {
        const int row = 64 * wgi + 16 * tg + r16;
        f32x4 acc[3]; acc[0] = acc[1] = acc[2] = (f32x4){0.f, 0.f, 0.f, 0.f};
        float ssq = 0.f;
#pragma unroll 4
        for (int ks = 0; ks < 16; ++ks) {
            const int k0 = kh * 512 + ks * 32 + kq * 8;
            const f32x4 xa = *(const f32x4*)(x1 + (size_t)row * D_MODEL + k0), xb = *(const f32x4*)(x1 + (size_t)row * D_MODEL + k0 + 4);
            const f32x4 ga = *(const f32x4*)(g2 + k0), gb = *(const f32x4*)(g2 + k0 + 4);
            ssq += (xa.x * xa.x + xa.y * xa.y) + (xa.z * xa.z + xa.w * xa.w) + (xb.x * xb.x + xb.y * xb.y) + (xb.z * xb.z + xb.w * xb.w);
            float v[8] = {xa.x * ga.x, xa.y * ga.y, xa.z * ga.z, xa.w * ga.w, xb.x * gb.x, xb.y * gb.y, xb.z * gb.z, xb.w * gb.w};
            unsigned hi[8], lo[8];
#pragma unroll
            for (int i = 0; i < 8; ++i) { hi[i] = f2bf(v[i]); lo[i] = f2bf(v[i] - __uint_as_float(hi[i] << 16)); }
            v4u hw, lw;
            hw.x = hi[0] | (hi[1] << 16); hw.y = hi[2] | (hi[3] << 16); hw.z = hi[4] | (hi[5] << 16); hw.w = hi[6] | (hi[7] << 16);
            lw.x = lo[0] | (lo[1] << 16); lw.y = lo[2] | (lo[3] << 16); lw.z = lo[4] | (lo[5] << 16); lw.w = lo[6] | (lo[7] << 16);
            *(v4u*)(H2 + (size_t)row * D_MODEL + k0) = hw;
            const bf16x8 ahi = __builtin_bit_cast(bf16x8, hw), alo = __builtin_bit_cast(bf16x8, lw);
#pragma unroll
            for (int nt = 0; nt < 3; ++nt) {
                const bf16x8 bh = *(const bf16x8*)(WRhi + (size_t)(nt * 16 + r16) * 1024 + k0), bl = *(const bf16x8*)(WRlo + (size_t)(nt * 16 + r16) * 1024 + k0);
                acc[nt] = __builtin_amdgcn_mfma_f32_16x16x32_bf16(ahi, bh, acc[nt], 0, 0, 0);
                acc[nt] = __builtin_amdgcn_mfma_f32_16x16x32_bf16(ahi, bl, acc[nt], 0, 0, 0);
                acc[nt] = __builtin_amdgcn_mfma_f32_16x16x32_bf16(alo, bh, acc[nt], 0, 0, 0);
            }
        }
        ssq += __shfl_xor(ssq, 16); ssq += __shfl_xor(ssq, 32);
        __syncthreads();
#pragma unroll
        for (int nt = 0; nt < 3; ++nt)
#pragma unroll
            for (int rg = 0; rg < 4; ++rg) PL[((kh * 4 + tg) * 16 + 4 * kq + rg) * 49 + nt * 16 + r16] = acc[nt][rg];
        if (kq == 0) PS[(kh * 4 + tg) * 16 + r16] = ssq;
        __syncthreads();
        if (wave < 4 && lane < 16) {
            const int tl = lane, tok = 64 * wgi + 16 * tg + tl;
            const float ss = PS[(0 * 4 + tg) * 16 + tl] + PS[(1 * 4 + tg) * 16 + tl];
            const float rinv = 1.0f / sqrtf(ss * (1.0f / D_MODEL) + RMS_EPS);
            const LAS float* p0 = PL + ((0 * 4 + tg) * 16 + tl) * 49; const LAS float* p1 = PL + ((1 * 4 + tg) * 16 + tl) * 49;
            float gl[NEG]; float gm = -INFINITY; int gs = 0;
#pragma unroll
            for (int i = 0; i < NEG; ++i) { gl[i] = rinv * (p0[i] + p1[i]) + a.in[IN_BRG][i]; if (gl[i] > gm) { gm = gl[i]; gs = i; } }
            float gsum = 0.f;
#pragma unroll
            for (int i = 0; i < NEG; ++i) gsum += expf(gl[i] - gm);
            const float pg = 1.0f / gsum;
            float el[EPG]; float em = -INFINITY;
#pragma unroll
            for (int i = 0; i < EPG; ++i) { const int c = 4 + gs * EPG + i; el[i] = rinv * (p0[c] + p1[c]) + a.in[IN_BRE][gs * EPG + i]; em = fmaxf(em, el[i]); }
            float esum = 0.f;
#pragma unroll
            for (int i = 0; i < EPG; ++i) esum += expf(el[i] - em);
            int i0 = 0;
#pragma unroll
            for (int i = 1; i < EPG; ++i) if (el[i] > el[i0]) i0 = i;
            int i1 = (i0 == 0) ? 1 : 0;
#pragma unroll
            for (int i = 0; i < EPG; ++i) if (i != i0 && el[i] > el[i1]) i1 = i;
            float e0v = 0.f, e1v = 0.f;
#pragma unroll
            for (int i = 0; i < EPG; ++i) { if (i == i0) e0v = el[i]; if (i == i1) e1v = el[i]; }
            const int ea = gs * EPG + i0, eb = gs * EPG + i1;
            EID[tok * 2] = ea; EID[tok * 2 + 1] = eb;
            GATE[tok * 2] = pg * expf(e0v - em) / esum; GATE[tok * 2 + 1] = pg * expf(e1v - em) / esum;
            RINV[tok] = rinv;
            EL[(16 * tg + tl) * 2] = ea; EL[(16 * tg + tl) * 2 + 1] = eb;
        }
        __syncthreads();
        if (tid < 128) { const int e = EL[tid]; int rk = 0; for (int j = 0; j < tid; ++j) rk += (EL[j] == e) ? 1 : 0; LRANK[wgi * 128 + tid] = rk; }
        else if (tid < 160) { const int e = tid - 128; int c = 0; for (int j = 0; j < 128; ++j) c += (EL[j] == e) ? 1 : 0; CNT[wgi * 32 + e] = c; }
    }
    __syncthreads();
}

__device__ __forceinline__ void phase6(const Args& a, LAS unsigned char* lds, int tid, int lane, int wave, int vcu, int G) {
    unsigned char* ws = a.ws;
    const bf16_t* H2 = (const bf16_t*)(ws + WS_R1); bf16_t* ROWS = (bf16_t*)(ws + WS_ROWS);
    const float* RINV = (const float*)(ws + WS_SMALL + SM_RINV); const int* EID = (const int*)(ws + WS_SMALL + SM_EID); const float* GATE = (const float*)(ws + WS_SMALL + SM_GATE);
    const int* LRANK = (const int*)(ws + WS_SMALL + SM_LRANK); const int* CNT = (const int*)(ws + WS_SMALL + SM_CNT);
    int* DEST = (int*)(ws + WS_SMALL + SM_DEST); int* TOKROW = (int*)(ws + WS_SMALL + SM_TOKROW); float* ROWSC = (float*)(ws + WS_SMALL + SM_ROWSC); float* ROWGT = (float*)(ws + WS_SMALL + SM_ROWGT);
    int* TILEE = (int*)(ws + WS_SMALL + SM_TILEE); int* META = (int*)(ws + WS_SMALL + SM_META);
    LAS int* totS = (LAS int*)lds; LAS int* preS = totS + 32; LAS int* pstS = preS + 32; LAS int* dstS = pstS + 32;
    for (int wgi = vcu; wgi < T_TOK / 64; wgi += G) {
        __syncthreads();
        if (tid < 32) { int tot = 0, pre = 0; for (int w = 0; w < T_TOK / 64; ++w) { const int c = CNT[w * 32 + tid]; tot += c; pre += (w < wgi) ? c : 0; } totS[tid] = tot; preS[tid] = pre; }
        __syncthreads();
        if (tid == 0) { int run = 0; for (int e = 0; e < NE; ++e) { pstS[e] = run; run += ((totS[e] + 255) >> 8) << 8; }
            if (wgi == 0) { META[0] = run >> 8; for (int e = 0; e < NE; ++e) { const int t0 = pstS[e] >> 8, nt = (totS[e] + 255) >> 8; for (int j = 0; j < nt; ++j) TILEE[t0 + j] = e; } } }
        __syncthreads();
        if (tid < 128) { const int tok = 64 * wgi + (tid >> 1); const int e = EID[wgi * 128 + tid]; const int dest = pstS[e] + preS[e] + LRANK[wgi * 128 + tid];
            TOKROW[dest] = tok; ROWSC[dest] = RINV[tok]; ROWGT[dest] = GATE[wgi * 128 + tid]; DEST[wgi * 128 + tid] = dest; dstS[tid] = dest; }
        if (wgi == 0) { for (int e = 0; e < NE; ++e) { const int lo = pstS[e] + totS[e], hi = pstS[e] + (((totS[e] + 255) >> 8) << 8); for (int r = lo + tid; r < hi; r += 512) { TOKROW[r] = -1; ROWSC[r] = 0.f; ROWGT[r] = 0.f; } } }
        __syncthreads();
        for (int as = wave; as < 128; as += 8) { const int tok = 64 * wgi + (as >> 1), dest = dstS[as];
            const GAS v4u* src = (const GAS v4u*)(H2 + (size_t)tok * D_MODEL) + lane; GAS v4u* dst = (GAS v4u*)(ROWS + (size_t)dest * D_MODEL) + lane;
            const v4u r0 = src[0], r1 = src[64]; dst[0] = r0; dst[64] = r1; }
    }
    __syncthreads();
}

__device__ __forceinline__ void phase9(const Args& a, int lane, int wave, int vcu, int G) {
    unsigned char* ws = a.ws; float* out = a.out; const float* gf = a.in[IN_NORM_FINAL];
    const bf16_t* Y = (const bf16_t*)(ws + WS_ROWS); const int* DEST = (const int*)(ws + WS_SMALL + SM_DEST);
    const int gw = vcu * 8 + wave, NGW = G * 8;
    f32x4 gv[4];
#pragma unroll
    for (int j = 0; j < 4; ++j) gv[j] = *(const f32x4*)(gf + 4 * lane + 256 * j);
    for (int m = gw; m < T_TOK; m += NGW) {
        const int d0 = DEST[m * 2], d1 = DEST[m * 2 + 1];
        GAS f32x4* xr = (GAS f32x4*)(out + (size_t)m * D_MODEL) + lane;
        const GAS v2u* y0 = (const GAS v2u*)(Y + (size_t)d0 * D_MODEL) + lane; const GAS v2u* y1 = (const GAS v2u*)(Y + (size_t)d1 * D_MODEL) + lane;
        f32x4 v[4]; float s = 0.f;
#pragma unroll
        for (int j = 0; j < 4; ++j) { v[j] = xr[64 * j]; const v2u p = y0[64 * j], q = y1[64 * j];
            v[j].x += pg8::bf_lo(p.x) + pg8::bf_lo(q.x); v[j].y += pg8::bf_hi(p.x) + pg8::bf_hi(q.x); v[j].z += pg8::bf_lo(p.y) + pg8::bf_lo(q.y); v[j].w += pg8::bf_hi(p.y) + pg8::bf_hi(q.y);
            s += (v[j].x * v[j].x + v[j].y * v[j].y) + (v[j].z * v[j].z + v[j].w * v[j].w); }
        const float rstd = 1.f / sqrtf(wave_sum(s) * (1.f / D_MODEL) + RMS_EPS);
#pragma unroll
        for (int j = 0; j < 4; ++j) xr[64 * j] = v[j] * rstd * gv[j];
    }
}


__device__ __forceinline__ float half_sum(float v, LAS float* scr, int half, int tid) {
    v = wave_sum(v); __syncthreads();
    if ((tid & 63) == 0) scr[tid >> 6] = v;
    __syncthreads();
    const LAS float* s = scr + half * 4; return (s[0] + s[1]) + (s[2] + s[3]);
}
__device__ __forceinline__ float half_max(float v, LAS float* scr, int half, int tid) {
    v = wave_max(v); __syncthreads();
    if ((tid & 63) == 0) scr[tid >> 6] = v;
    __syncthreads();
    const LAS float* s = scr + half * 4; return fmaxf(fmaxf(s[0], s[1]), fmaxf(s[2], s[3]));
}
__device__ __forceinline__ void phase2_attn_naive(const Args& a, LAS unsigned char* lds, int tid, int vcu, int G) {
    unsigned char* ws = a.ws;
    const bf16_t* Q = (const bf16_t*)(ws + WS_Q); const bf16_t* K = (const bf16_t*)(ws + WS_K); const bf16_t* V = (const bf16_t*)(ws + WS_V); bf16_t* CC = (bf16_t*)(ws + WS_R1);
    const int half = tid >> 8, t8 = tid & 255;
    LAS float* sc = (LAS float*)lds + half * SEQ;
    LAS float* qs = (LAS float*)lds + 2 * SEQ + half * DH;
    LAS float* red = (LAS float*)lds + 2 * SEQ + 2 * DH + half * 2 * DV;
    LAS float* scr = (LAS float*)lds + 2 * SEQ + 2 * DH + 4 * DV;
    float s1 = 0.f, s2 = 0.f;
    for (int i = 0; i < DH; ++i) { s1 += a.in[IN_LQ1][i] * a.in[IN_LK1][i]; s2 += a.in[IN_LQ2][i] * a.in[IN_LK2][i]; }
    const float lam = expf(s1) - expf(s2) + LAM_INIT;
    const int NR = BATCH * NH * SEQ;
    for (int r0 = vcu * 2; r0 < NR; r0 += G * 2) {
        const int rr = r0 + half;
        const int q = rr % SEQ, h = (rr / SEQ) % NH, b = rr / (SEQ * NH);
        const float slope2 = exp2f(-2.0f * (float)(h + 1)) * LOG2E;
        const size_t row = (size_t)(b * SEQ + q);
        const int nk = q + 1;
        const int d = t8 & 127, hf = t8 >> 7;
        float otot = 0.f;
        for (int m = 0; m < 2; ++m) {
            __syncthreads();
            if (t8 < DH) qs[t8] = bf2f(Q[row * 512 + h * 128 + m * 64 + t8]);
            __syncthreads();
            float mx = -INFINITY;
            for (int j = t8; j < nk; j += 256) {
                const bf16_t* krow = K + (size_t)(b * SEQ + j) * 512 + h * 128 + m * 64;
                float s = 0.f;
                for (int dd = 0; dd < DH; ++dd) s += qs[dd] * bf2f(krow[dd]);
                s -= slope2 * (float)(q - j);
                sc[j] = s; mx = fmaxf(mx, s);
            }
            const float mm = half_max(mx, scr, half, tid);
            float sm = 0.f;
            for (int j = t8; j < nk; j += 256) { const float e = exp2f(sc[j] - mm); sc[j] = e; sm += e; }
            const float ll = half_sum(sm, scr, half, tid);
            __syncthreads();
            float o = 0.f;
            for (int j = hf; j < nk; j += 2) o += sc[j] * bf2f(V[(size_t)(b * SEQ + j) * 512 + h * 128 + d]);
            o /= ll;
            otot += (m == 0) ? o : -lam * o;
        }
        red[hf * DV + d] = otot;
        __syncthreads();
        float ov = 0.f, sq = 0.f;
        if (t8 < 128) { ov = red[t8] + red[DV + t8]; sq = ov * ov; }
        sq = half_sum(sq, scr, half, tid);
        const float r = rsqrtf(sq / (float)DV + RMS_EPS);
        if (t8 < 128) CC[row * D_MODEL + 512 + h * 128 + t8] = (bf16_t)f2bf(ov * r * a.in[IN_SUBLN][t8] * (1.0f - LAM_INIT));
    }
    __syncthreads();
}
__device__ __forceinline__ void phase2_s5_naive(const Args& a, LAS unsigned char* lds, int lane, int wave, int vcu, int G) {
    unsigned char* ws = a.ws;
    const bf16_t* U = (const bf16_t*)(ws + WS_U); bf16_t* Yg = (bf16_t*)(ws + WS_YG);
    if (wave != 0) return;
    LAS float* xr_s = (LAS float*)lds; LAS float* xi_s = xr_s + NS;
    for (int unit = vcu; unit < BATCH * NG; unit += G) {
        const int g = unit % NG, b = unit / NG, n = lane;
        const double dt = exp((double)a.in[IN_LOG_DT][g]);
        const double lr = a.in[IN_LAM_RE][g * NS + n], li = a.in[IN_LAM_IM][g * NS + n];
        const double mag = exp(lr * dt);
        const double ar_d = mag * cos(li * dt), ai_d = mag * sin(li * dt);
        const double nr = ar_d - 1.0, ni = ai_d, den = lr * lr + li * li;
        const double kr = (nr * lr + ni * li) / den, ki = (ni * lr - nr * li) / den;
        float bbr[GC], bbi[GC];
#pragma unroll
        for (int c = 0; c < GC; ++c) { const double br = a.in[IN_B_RE][(g * NS + n) * GC + c], bi = a.in[IN_B_IM][(g * NS + n) * GC + c]; bbr[c] = (float)(kr * br - ki * bi); bbi[c] = (float)(kr * bi + ki * br); }
        const float ar = (float)ar_d, ai = (float)ai_d;
        const int cc = n & 15, part = n >> 4;
        float cr[16], ci[16];
#pragma unroll
        for (int k = 0; k < 16; ++k) { cr[k] = a.in[IN_C_RE][(g * GC + cc) * NS + part * 16 + k]; ci[k] = a.in[IN_C_IM][(g * GC + cc) * NS + part * 16 + k]; }
        const float dd = a.in[IN_SSM_D][g * GC + cc];
        float xr = 0.f, xi = 0.f;
        for (int t = 0; t < SEQ; ++t) {
            const bf16_t* urow = U + (size_t)(b * SEQ + t) * SSM_W + g * GC;
            float bur = 0.f, bui = 0.f;
#pragma unroll
            for (int c = 0; c < GC; ++c) { const float u = bf2f(urow[c]); bur += bbr[c] * u; bui += bbi[c] * u; }
            const float nxr = ar * xr - ai * xi + bur, nxi = ar * xi + ai * xr + bui;
            xr = nxr; xi = nxi;
            xr_s[n] = xr; xi_s[n] = xi;
            LDS_WAIT(); asm volatile("" ::: "memory");
            float y = 0.f;
#pragma unroll
            for (int k = 0; k < 16; ++k) y += cr[k] * xr_s[part * 16 + k] - ci[k] * xi_s[part * 16 + k];
            LDS_WAIT(); asm volatile("" ::: "memory");
            y += __shfl_xor(y, 16); y += __shfl_xor(y, 32);
            if (part == 0) {
                y += dd * bf2f(urow[cc]);
                const float gl = 0.5f * y * (1.0f + tanhf(0.7978845608028654f * (y + 0.044715f * y * y * y)));
                Yg[(size_t)(b * SEQ + t) * SSM_W + g * GC + cc] = (bf16_t)f2bf(gl);
            }
        }
    }
}

__global__ void __launch_bounds__(512, 2) mk_fwd(Args args) {
    extern __shared__ __attribute__((aligned(16))) unsigned char lds_raw[];
    LAS unsigned char* lds = (LAS unsigned char*)lds_raw;
    const int tid = threadIdx.x, lane = tid & 63, wave = __builtin_amdgcn_readfirstlane(tid >> 6);
    const int G = gridDim.x; const int bx = blockIdx.x; const int vcu = (G % 8 == 0) ? (bx % 8) * (G / 8) + bx / 8 : bx;
    unsigned char* ws = args.ws;
    volatile LAS unsigned* MISC = (volatile LAS unsigned*)(lds + MISC_OFF);
    for (int u = tid; u < (LDS_BYTES - LDSCTL_OFF) / 4; u += 512) ((LAS unsigned*)(lds + LDSCTL_OFF))[u] = 0u;
    __syncthreads();
    const int lo = args.ph_lo, hi = args.ph_hi;
    XcdBarrier bar; bar.bar = (unsigned*)(ws + WS_CTL) + CW_BAR; bar.x = 0; bar.st = nullptr;
    if (hi - lo > 1) bar = xcd_barrier_post((unsigned*)(ws + WS_CTL) + CW_BAR, MISC + 8);
#define IN(k) (lo <= (k) && (k) < hi)
#define SEAM(k) do { if (IN(k) && IN((k) + 1)) xcd_barrier(bar); } while (0)
    if (IN(0)) { phase0(args, lds, lane, wave, vcu, G); } SEAM(0);
    if (IN(1)) { pg8::Gemm g{(const bf16_t*)(ws + WS_R1), (const bf16_t*)(ws + WS_WTIN), T_TOK, IN_COLS, D_MODEL}; pg8::StaticOrder S; S.init(T_TOK, IN_COLS, G, bx);
        pg8::EpiInProj E{(bf16_t*)(ws + WS_Q)};
        pg8::gemm_phase<pg8::EpiInProj, pg8::StaticOrder, true, true>(lds, g, S, E); } SEAM(1);
    if (IN(2)) { phase2_s5_naive(args, lds + 100 * 1024, lane, wave, vcu, G); phase2_attn_naive(args, lds, tid, vcu, G); } SEAM(2);
    if (IN(3)) { pg8::Gemm g{(const bf16_t*)(ws + WS_YG), (const bf16_t*)(ws + WS_WTGLU), T_TOK, SSM_W, SSM_W}; pg8::StaticOrder S; S.init(T_TOK, SSM_W, G, bx);
        pg8::EpiGlu E{(const bf16_t*)(ws + WS_YG), args.in[IN_B_GLU], (bf16_t*)(ws + WS_R1), (float*)(ws + WS_SMALL + SM_SSQP)};
        pg8::gemm_phase<pg8::EpiGlu, pg8::StaticOrder, true, true>(lds, g, S, E); } SEAM(3);
    if (IN(4)) { pg8::Gemm g{(const bf16_t*)(ws + WS_R1), (const bf16_t*)(ws + WS_WTOUT), T_TOK, D_MODEL, D_MODEL}; pg8::StaticOrder S; S.init(T_TOK, D_MODEL, G, bx);
        pg8::EpiOut E{args.in[IN_X], args.out, (const float*)(ws + WS_SMALL + SM_SSQP)};
        pg8::gemm_phase<pg8::EpiOut, pg8::StaticOrder, true, true>(lds, g, S, E); } SEAM(4);
    if (IN(5)) { phase5(args, lds, tid, lane, wave, vcu, G); } SEAM(5);
    if (IN(6)) { phase6(args, lds, tid, lane, wave, vcu, G); } SEAM(6);
    if (IN(7)) { const int ntiles = __builtin_amdgcn_readfirstlane(((const int*)(ws + WS_SMALL + SM_META))[0]);
        pg8::Gemm g{(const bf16_t*)(ws + WS_ROWS), (const bf16_t*)(ws + WS_WTGU), ntiles * 256, NE * 1024, D_MODEL}; pg8::MoeOrder S{(const int*)(ws + WS_SMALL + SM_TILEE), ntiles, G, vcu};
        pg8::EpiMoeUp E{(bf16_t*)(ws + WS_HID), (const float*)(ws + WS_SMALL + SM_ROWSC)};
        pg8::gemm_phase<pg8::EpiMoeUp, pg8::MoeOrder, true, true>(lds, g, S, E); } SEAM(7);
    if (IN(8)) { const int ntiles = __builtin_amdgcn_readfirstlane(((const int*)(ws + WS_SMALL + SM_META))[0]);
        pg8::Gemm g{(const bf16_t*)(ws + WS_HID), (const bf16_t*)(ws + WS_WTD), ntiles * 256, NE * 1024, FF}; pg8::MoeOrder S{(const int*)(ws + WS_SMALL + SM_TILEE), ntiles, G, vcu};
        pg8::EpiMoeDown E{(bf16_t*)(ws + WS_ROWS), (const float*)(ws + WS_SMALL + SM_ROWGT)};
        pg8::gemm_phase<pg8::EpiMoeDown, pg8::MoeOrder, true, true>(lds, g, S, E); } SEAM(8);
    if (IN(9)) { phase9(args, lane, wave, vcu, G); }
#undef IN
#undef SEAM
}

extern "C" void kernel_launch(void* const* d_in, const int* in_sizes, int n_in, void* d_out, int out_size, void* d_ws, size_t ws_size, hipStream_t stream) {
    static int grid = 0;
    if (grid == 0) {
        if (n_in != 29 || out_size != T_TOK * D_MODEL || ws_size < WS_END) { fprintf(stderr, "kernel_launch: unexpected shapes (n_in %d, out %d, ws %zu < %zu)\n", n_in, out_size, ws_size, (size_t)WS_END); grid = -1; return; }
        int dev = 0, cus = 0;
        if (hipGetDevice(&dev) != hipSuccess || hipDeviceGetAttribute(&cus, hipDeviceAttributeMultiprocessorCount, dev) != hipSuccess) { grid = -1; return; }
        if (hipFuncSetAttribute((const void*)mk_fwd, hipFuncAttributeMaxDynamicSharedMemorySize, LDS_BYTES) != hipSuccess) { fprintf(stderr, "kernel_launch: hipFuncSetAttribute failed\n"); grid = -1; return; }
        grid = cus;
    }
    if (grid < 0) return;
    (void)hipMemsetAsync((char*)d_ws + WS_CTL, 0, CTL_ZERO_BYTES, stream);
    Args a{};
    for (int i = 0; i < 29; ++i) a.in[i] = (const float*)d_in[i];
    a.out = (float*)d_out; a.ws = (unsigned char*)d_ws;
    unsigned char* ws = (unsigned char*)d_ws;
    a.ph_lo = 0; a.ph_hi = 10;
    hipLaunchKernelGGL(mk_fwd, dim3(grid), dim3(512), LDS_BYTES, stream, a);
}
```

```cpp
#include <hip/hip_runtime.h>
#include <cstdio>
#include <cstdint>
#include <cmath>

constexpr int D_MODEL = 1024, BATCH = 2, SEQ = 8192, T_TOK = BATCH * SEQ;
constexpr int IN_COLS = 2048, ATTN_W = 512, SSM_W = 512, NH = 4, DH = 64, DV = 128;
constexpr int NG = 32, GC = 16, NS = 64;
constexpr int NEG = 4, EPG = 8, NE = 32, FF = 512;
constexpr float RMS_EPS = 1e-6f;
constexpr float LAM_INIT = 0.2f;
constexpr float C2 = 0.125f * 1.4426950408889634f;
constexpr float LOG2E = 1.4426950408889634f;
constexpr int MAXROWS = 2 * T_TOK + NE * 256;

namespace pg8 {
#define PG8_LAS __attribute__((address_space(3)))
typedef unsigned short bf16_t;
typedef short bf16x8 __attribute__((ext_vector_type(8)));
typedef float f32x4 __attribute__((ext_vector_type(4)));
typedef unsigned u32x4 __attribute__((ext_vector_type(4)));
constexpr int BM = 256, BK = 64, HALF = 128, HTB = HALF * BK * 2  , STAGE_BYTES = 8 * HTB, NXCD = 8, WGM = 8;

__host__ __device__ __forceinline__ int lds_byte(int r, int c) { const int st = (r >> 4) * 2 + (c >> 5), rr = r & 15, cc = c & 31, ob = rr * 64 + cc * 2; return st * 1024 + (ob ^ (((ob >> 9) & 1) << 5)); }
__host__ __device__ __forceinline__ void stage_rc(int b, int& R, int& C) { const int st = b / 1024, sb = b % 1024, swz = sb ^ (((sb >> 9) & 1) << 5); R = (st >> 1) * 16 + swz / 64; C = (st & 1) * 32 + (swz % 64) / 2; }
__host__ __device__ __forceinline__ int perm32(int rho) { const int n = rho >> 4, i = rho & 15; return 8 * (i >> 2) + 4 * n + (i & 3); }

struct Unit { int pm, pn; };
struct Gemm { const bf16_t* A; const bf16_t* Bt; int M, N, K; };

struct StaticOrder {
    int nM, nN, nwg, G, c;
    __host__ __device__ void init(int M, int N, int G_, int c_) { nM = M / BM; nN = N / BM; nwg = nM * nN; G = G_; c = c_; }
    __host__ __device__ bool next(int i, Unit& u) const {
        const long L = (long)i * G + c; if (L >= nwg) return false;
        int wgid = (int)L; { const int q = nwg / NXCD, r = nwg % NXCD, xcd = wgid % NXCD, off = wgid / NXCD; wgid = (xcd < r ? xcd * (q + 1) : r * (q + 1) + (xcd - r) * q) + off; }
        const int nig = WGM * nN, gid = wgid / nig, fm = gid * WGM, gsz = (nM - fm) < WGM ? (nM - fm) : WGM;
        u.pm = fm + ((wgid % nig) % gsz); u.pn = (wgid % nig) / gsz; return true;
    }
    __device__ __forceinline__ void a_ready(const Unit&) const {}
    __device__ __forceinline__ void done(const Unit&) const {}
};

typedef unsigned u32x4 __attribute__((ext_vector_type(4)));
__device__ __forceinline__ unsigned cvt_pk_bf16(float lo, float hi) { unsigned r; asm volatile("v_cvt_pk_bf16_f32 %0, %1, %2" : "=v"(r) : "v"(lo), "v"(hi)); return r; }
__device__ __forceinline__ float bf_lo(unsigned w) { return __uint_as_float(w << 16); }
__device__ __forceinline__ float bf_hi(unsigned w) { return __uint_as_float(w & 0xffff0000u); }
__device__ __forceinline__ float sigmoid_f(float v) { return __builtin_amdgcn_rcpf(1.0f + __builtin_amdgcn_exp2f(-1.4426950408889634f * v)); }

struct EpiInProj {
    static constexpr bool PERM = true, AFTER_DRAIN = false, MIDK = false;
    bf16_t* O;
    __device__ __forceinline__ void operator()(const f32x4 (&acc)[2][2][4][2], const Unit& u, int wr, int wc, int fr, int fq) const {
        const int row0 = u.pm * BM + wr * 64 + fr; int colt = u.pn * BM; const int t = colt >> 9; colt -= t << 9;
        bf16_t* base = O + (size_t)t * ((size_t)16384 * 512); const float sc = (t == 0) ? (0.125f * 1.4426950408889634f) : 1.f;
        const int col0 = colt + wc * 32 + 8 * fq;
#pragma unroll
        for (int ai = 0; ai < 2; ++ai)
#pragma unroll
            for (int m = 0; m < 4; ++m) { bf16_t* rowp = base + (size_t)(row0 + ai * HALF + m * 16) * 512 + col0;
#pragma unroll
                for (int bj = 0; bj < 2; ++bj) { const f32x4 v0 = acc[ai][bj][m][0] * sc, v1 = acc[ai][bj][m][1] * sc;
                    u32x4 w; w.x = cvt_pk_bf16(v0[0], v0[1]); w.y = cvt_pk_bf16(v0[2], v0[3]); w.z = cvt_pk_bf16(v1[0], v1[1]); w.w = cvt_pk_bf16(v1[2], v1[3]);
                    *(u32x4*)(rowp + bj * HALF) = w; } }
    }
};
struct EpiGlu {
    static constexpr bool PERM = true, AFTER_DRAIN = false, MIDK = false;
    const bf16_t* Yg; const float* bias; bf16_t* CC; float* SSQP;
    __device__ __forceinline__ void operator()(const f32x4 (&acc)[2][2][4][2], const Unit& u, int wr, int wc, int fr, int fq) const {
        const int row0 = u.pm * BM + wr * 64 + fr, col0 = u.pn * BM + wc * 32 + 8 * fq;
        f32x4 bv[2][2];
#pragma unroll
        for (int bj = 0; bj < 2; ++bj)
#pragma unroll
            for (int n = 0; n < 2; ++n) bv[bj][n] = *(const f32x4*)(bias + col0 + bj * HALF + 4 * n);
#pragma unroll
        for (int ai = 0; ai < 2; ++ai)
#pragma unroll
            for (int m = 0; m < 4; ++m) { const int row = row0 + ai * HALF + m * 16; float ss = 0.f;
#pragma unroll
                for (int bj = 0; bj < 2; ++bj) { const int col = col0 + bj * HALF;
                    const u32x4 y8 = *(const u32x4*)(Yg + (size_t)row * 512 + col);
                    const f32x4 a0 = acc[ai][bj][m][0] + bv[bj][0], a1 = acc[ai][bj][m][1] + bv[bj][1];
                    float z[8];
                    z[0] = bf_lo(y8.x) * sigmoid_f(a0[0]); z[1] = bf_hi(y8.x) * sigmoid_f(a0[1]); z[2] = bf_lo(y8.y) * sigmoid_f(a0[2]); z[3] = bf_hi(y8.y) * sigmoid_f(a0[3]);
                    z[4] = bf_lo(y8.z) * sigmoid_f(a1[0]); z[5] = bf_hi(y8.z) * sigmoid_f(a1[1]); z[6] = bf_lo(y8.w) * sigmoid_f(a1[2]); z[7] = bf_hi(y8.w) * sigmoid_f(a1[3]);
#pragma unroll
                    for (int i = 0; i < 8; ++i) ss += z[i] * z[i];
                    u32x4 w; w.x = cvt_pk_bf16(z[0], z[1]); w.y = cvt_pk_bf16(z[2], z[3]); w.z = cvt_pk_bf16(z[4], z[5]); w.w = cvt_pk_bf16(z[6], z[7]);
                    *(u32x4*)(CC + (size_t)row * 1024 + col) = w; }
                ss += __shfl_xor(ss, 16); ss += __shfl_xor(ss, 32);
                if (fq == 0) SSQP[(size_t)row * 8 + u.pn * 4 + wc] = ss; }
    }
};
struct EpiOut {
    static constexpr bool PERM = false, AFTER_DRAIN = false, MIDK = true;
    const float* x; float* out; const float* SSQP;
    __device__ __forceinline__ void midk(f32x4 (&acc)[2][2][4][2], const Unit& u, int wr, int wc, int fr, int fq) const {
#pragma unroll
        for (int ai = 0; ai < 2; ++ai)
#pragma unroll
            for (int m = 0; m < 4; ++m) { const int row = u.pm * BM + ai * HALF + wr * 64 + m * 16 + fr;
                const f32x4 s0 = *(const f32x4*)(SSQP + (size_t)row * 8), s1 = *(const f32x4*)(SSQP + (size_t)row * 8 + 4);
                const float s = ((s0[0] + s0[1]) + (s0[2] + s0[3])) + ((s1[0] + s1[1]) + (s1[2] + s1[3]));
                const float r = __builtin_amdgcn_rsqf(s * (1.0f / 512.0f) + 1e-6f);
#pragma unroll
                for (int bj = 0; bj < 2; ++bj)
#pragma unroll
                    for (int n = 0; n < 2; ++n) acc[ai][bj][m][n] *= r; }
    }
    __device__ __forceinline__ void operator()(const f32x4 (&acc)[2][2][4][2], const Unit& u, int wr, int wc, int fr, int fq) const {
        const int col0 = u.pn * BM + wc * 32 + 4 * fq;
#pragma unroll
        for (int ai = 0; ai < 2; ++ai)
#pragma unroll
            for (int m = 0; m < 4; ++m) { const size_t off = (size_t)(u.pm * BM + ai * HALF + wr * 64 + m * 16 + fr) * 1024 + col0;
#pragma unroll
                for (int bj = 0; bj < 2; ++bj)
#pragma unroll
                    for (int n = 0; n < 2; ++n) { const f32x4 bs = *(const f32x4*)(x + off + bj * HALF + n * 16); *(f32x4*)(out + off + bj * HALF + n * 16) = bs + acc[ai][bj][m][n]; } }
    }
};
struct EpiMoeUp {
    static constexpr bool PERM = true, AFTER_DRAIN = false, MIDK = false;
    bf16_t* HID; const float* ROWSC;
    __device__ __forceinline__ void operator()(const f32x4 (&acc)[2][2][4][2], const Unit& u, int wr, int wc, int fr, int fq) const {
        const int row0 = u.pm * BM + wr * 64 + fr, j0 = (u.pn & 3) * HALF + wc * 32 + 8 * fq;
#pragma unroll
        for (int ai = 0; ai < 2; ++ai)
#pragma unroll
            for (int m = 0; m < 4; ++m) { const int row = row0 + ai * HALF + m * 16; const float rs = ROWSC[row];
                float h[8];
#pragma unroll
                for (int n = 0; n < 2; ++n)
#pragma unroll
                    for (int i = 0; i < 4; ++i) { const float g = acc[ai][0][m][n][i] * rs, up = acc[ai][1][m][n][i] * rs; h[n * 4 + i] = g * sigmoid_f(g) * up; }
                u32x4 w; w.x = cvt_pk_bf16(h[0], h[1]); w.y = cvt_pk_bf16(h[2], h[3]); w.z = cvt_pk_bf16(h[4], h[5]); w.w = cvt_pk_bf16(h[6], h[7]);
                *(u32x4*)(HID + (size_t)row * 512 + j0) = w; }
    }
};
struct EpiMoeDown {
    static constexpr bool PERM = true, AFTER_DRAIN = false, MIDK = false;
    bf16_t* Y; const float* ROWGT;
    __device__ __forceinline__ void operator()(const f32x4 (&acc)[2][2][4][2], const Unit& u, int wr, int wc, int fr, int fq) const {
        const int row0 = u.pm * BM + wr * 64 + fr, col0 = (u.pn & 3) * BM + wc * 32 + 8 * fq;
#pragma unroll
        for (int ai = 0; ai < 2; ++ai)
#pragma unroll
            for (int m = 0; m < 4; ++m) { const int row = row0 + ai * HALF + m * 16; const float gt = ROWGT[row];
#pragma unroll
                for (int bj = 0; bj < 2; ++bj) { const f32x4 v0 = acc[ai][bj][m][0] * gt, v1 = acc[ai][bj][m][1] * gt;
                    u32x4 w; w.x = cvt_pk_bf16(v0[0], v0[1]); w.y = cvt_pk_bf16(v0[2], v0[3]); w.z = cvt_pk_bf16(v1[0], v1[1]); w.w = cvt_pk_bf16(v1[2], v1[3]);
                    *(u32x4*)(Y + (size_t)row * 1024 + col0 + bj * HALF) = w; } }
    }
};
struct MoeOrder {
    const int* tile_e; int ntiles, G, c;
    __device__ __forceinline__ bool next(int i, Unit& u) const {
        const int L = i * G + c; if (L >= ntiles * 4) return false;
        u.pm = L >> 2; const int e = __builtin_amdgcn_readfirstlane(tile_e[u.pm]); u.pn = e * 4 + (L & 3); return true;
    }
    __device__ __forceinline__ void a_ready(const Unit&) const {}
    __device__ __forceinline__ void done(const Unit&) const {}
};
template <class Epi, class Sched, bool ALIGN_EPI = false, bool SP2 = false>
__device__ __forceinline__ void gemm_phase(PG8_LAS unsigned char* lds, const Gemm g, const Sched& S, const Epi& E) {
    const int tid = threadIdx.x, wid = __builtin_amdgcn_readfirstlane(tid >> 6), lane = tid & 63, wr = wid >> 2, wc = wid & 3, fr = lane & 15, fq = lane >> 4;
    const int K = g.K, nt = K / BK;
    unsigned voffA[2], voffB[2];
#pragma unroll
    for (int i = 0; i < 2; ++i) { int R, C; stage_rc(tid * 16 + i * 8192, R, C); const int Rb = Epi::PERM ? ((R & ~31) + perm32(R & 31)) : R;
        voffA[i] = (unsigned)(R * K + C) * 2u; voffB[i] = (unsigned)(Rb * K + C) * 2u; }
    const size_t kstep = (size_t)(BK * 2);
    const size_t hstep = (size_t)HALF * K * 2;
    const size_t tstep = 2 * hstep;
    const unsigned ldsw = (unsigned)wid * 1024u;
    const int aoff = lds_byte(wr * 64 + fr, fq * 8), boff = lds_byte(wc * 32 + fr, fq * 8);
#define PG8_SA(b, h) (((b) * 2 + (h)) * HTB)
#define PG8_SB(b, h) ((4 + (b) * 2 + (h)) * HTB)
#define PG8_STAGE(bufoff, gbase, voff) do { _Pragma("unroll") for (int _i = 0; _i < 2; ++_i) \
        __builtin_amdgcn_global_load_lds((const unsigned*)((const char*)(gbase) + (voff)[_i]), (PG8_LAS unsigned*)(lds + (bufoff) + ldsw + _i * 8192), 16, 0, 0); } while (0)
#define PG8_LDA(dst, b, h) do { _Pragma("unroll") for (int m = 0; m < 4; ++m) _Pragma("unroll") for (int k = 0; k < 2; ++k) dst[m][k] = *(const PG8_LAS bf16x8*)(lds + PG8_SA(b, h) + aoff + m * 2048 + k * 1024); } while (0)
#define PG8_LDB(dst, b, h) do { _Pragma("unroll") for (int n = 0; n < 2; ++n) _Pragma("unroll") for (int k = 0; k < 2; ++k) dst[n][k] = *(const PG8_LAS bf16x8*)(lds + PG8_SB(b, h) + boff + n * 2048 + k * 1024); } while (0)
#define PG8_MMA(ai, bj, At, Bt) do { __builtin_amdgcn_s_setprio(1); _Pragma("unroll") for (int m = 0; m < 4; ++m) _Pragma("unroll") for (int n = 0; n < 2; ++n) _Pragma("unroll") for (int k = 0; k < 2; ++k) \
        acc[ai][bj][m][n] = __builtin_amdgcn_mfma_f32_16x16x32_bf16(Bt[n][k], At[m][k], acc[ai][bj][m][n], 0, 0, 0); __builtin_amdgcn_s_setprio(0); } while (0)
#define PG8_WAIT_V(n) asm volatile("s_waitcnt vmcnt(" #n ")" ::: "memory")
#define PG8_WAIT_L(n) asm volatile("s_waitcnt lgkmcnt(" #n ")" ::: "memory")
#define PG8_BAR __builtin_amdgcn_s_barrier()
#define PG8_SCHED __builtin_amdgcn_sched_barrier(0)
    Unit cur, nxt; int ui = 0;
    if (!S.next(0, cur)) return;
    f32x4 acc[2][2][4][2];
#pragma unroll
    for (int a = 0; a < 2; ++a)
#pragma unroll
        for (int b = 0; b < 2; ++b)
#pragma unroll
            for (int m = 0; m < 4; ++m)
#pragma unroll
                for (int n = 0; n < 2; ++n) acc[a][b][m][n] = (f32x4){0.f, 0.f, 0.f, 0.f};
    bf16x8 At[4][2], B0[2][2], B1[2][2];
    const char* cA = (const char*)g.A + (size_t)cur.pm * tstep; const char* cB = (const char*)g.Bt + (size_t)cur.pn * tstep;
    S.a_ready(cur);
    if constexpr (SP2) {
        PG8_STAGE(PG8_SB(0, 0), cB, voffB); PG8_STAGE(PG8_SB(0, 1), cB + hstep, voffB); PG8_STAGE(PG8_SA(0, 0), cA, voffA); PG8_STAGE(PG8_SA(0, 1), cA + hstep, voffA);
        if (wr == 1) PG8_BAR;
        PG8_WAIT_V(2); PG8_BAR;
        PG8_STAGE(PG8_SB(1, 0), cB + kstep, voffB); PG8_STAGE(PG8_SA(1, 0), cA + kstep, voffA); PG8_STAGE(PG8_SB(1, 1), cB + hstep + kstep, voffB);
        PG8_WAIT_V(6); PG8_BAR;
    } else {
        PG8_STAGE(PG8_SB(0, 0), cB, voffB); PG8_STAGE(PG8_SA(0, 0), cA, voffA); PG8_STAGE(PG8_SB(0, 1), cB + hstep, voffB); PG8_STAGE(PG8_SA(0, 1), cA + hstep, voffA);
        if (wr == 1) PG8_BAR;
        PG8_WAIT_V(4); PG8_BAR;
        PG8_STAGE(PG8_SB(1, 0), cB + kstep, voffB); PG8_STAGE(PG8_SA(1, 0), cA + kstep, voffA); PG8_STAGE(PG8_SB(1, 1), cB + hstep + kstep, voffB);
        PG8_WAIT_V(6); PG8_BAR;
    }
    for (;;) {
        const bool has_next = S.next(ui + 1, nxt);
        const char* nA = has_next ? (const char*)g.A + (size_t)nxt.pm * tstep : cA; const char* nB = has_next ? (const char*)g.Bt + (size_t)nxt.pn * tstep : cB;
        for (int t = 0; t < nt; t += 2) {
            if constexpr (Epi::MIDK) { if (t == (nt >> 1)) E.midk(acc, cur, wr, wc, fr, fq); }
            const bool last = (t == nt - 2);
            const char* a1 = cA + (size_t)(t + 1) * kstep;
            const char* a2 = last ? nA : cA + (size_t)(t + 2) * kstep; const char* b2 = last ? nB : cB + (size_t)(t + 2) * kstep;
            const char* a3 = a2 + kstep; const char* b3 = b2 + kstep;
            if (last && has_next) S.a_ready(nxt);
            if constexpr (SP2) {
            PG8_LDB(B0, 0, 0); PG8_LDB(B1, 0, 1); PG8_SCHED; PG8_LDA(At, 0, 0); PG8_STAGE(PG8_SA(1, 1), a1 + hstep, voffA);
            PG8_WAIT_V(8); PG8_WAIT_L(0); PG8_BAR; PG8_MMA(0, 0, At, B0); PG8_MMA(0, 1, At, B1); PG8_BAR; PG8_SCHED;
            PG8_LDA(At, 0, 1); PG8_STAGE(PG8_SB(0, 0), b2, voffB); PG8_STAGE(PG8_SB(0, 1), b2 + hstep, voffB); PG8_STAGE(PG8_SA(0, 0), a2, voffA);
            PG8_WAIT_V(8); PG8_WAIT_L(0); PG8_BAR; PG8_MMA(1, 0, At, B0); PG8_MMA(1, 1, At, B1); PG8_BAR; PG8_SCHED;
            PG8_LDB(B0, 1, 0); PG8_LDB(B1, 1, 1); PG8_SCHED; PG8_LDA(At, 1, 0); PG8_STAGE(PG8_SA(0, 1), a2 + hstep, voffA);
            PG8_WAIT_V(8); PG8_WAIT_L(0); PG8_BAR; PG8_MMA(0, 0, At, B0); PG8_MMA(0, 1, At, B1); PG8_BAR; PG8_SCHED;
            PG8_LDA(At, 1, 1); PG8_STAGE(PG8_SB(1, 0), b3, voffB); PG8_STAGE(PG8_SB(1, 1), b3 + hstep, voffB); PG8_STAGE(PG8_SA(1, 0), a3, voffA);
            PG8_WAIT_V(8); PG8_WAIT_L(0); PG8_BAR; PG8_MMA(1, 0, At, B0); PG8_MMA(1, 1, At, B1); PG8_BAR; PG8_SCHED;
            } else {
            PG8_LDB(B0, 0, 0); PG8_SCHED; PG8_LDA(At, 0, 0); PG8_STAGE(PG8_SA(1, 1), a1 + hstep, voffA);
            PG8_WAIT_L(8); PG8_BAR; PG8_WAIT_L(0); PG8_MMA(0, 0, At, B0); PG8_BAR; PG8_SCHED;
            PG8_LDB(B1, 0, 1); PG8_STAGE(PG8_SB(0, 0), b2, voffB);
            PG8_BAR; PG8_WAIT_L(0); PG8_MMA(0, 1, At, B1); PG8_BAR;
            PG8_LDA(At, 0, 1); PG8_STAGE(PG8_SA(0, 0), a2, voffA);
            PG8_BAR; PG8_WAIT_L(0); PG8_MMA(1, 0, At, B0); PG8_BAR; PG8_SCHED;
            PG8_STAGE(PG8_SB(0, 1), b2 + hstep, voffB);
            PG8_WAIT_V(6); PG8_BAR; PG8_MMA(1, 1, At, B1); PG8_BAR;
            PG8_LDB(B0, 1, 0); PG8_SCHED; PG8_LDA(At, 1, 0); PG8_STAGE(PG8_SA(0, 1), a2 + hstep, voffA);
            PG8_WAIT_L(8); PG8_BAR; PG8_WAIT_L(0); PG8_MMA(0, 0, At, B0); PG8_BAR; PG8_SCHED;
            PG8_LDB(B1, 1, 1); PG8_STAGE(PG8_SB(1, 0), b3, voffB);
            PG8_BAR; PG8_WAIT_L(0); PG8_MMA(0, 1, At, B1); PG8_BAR;
            PG8_LDA(At, 1, 1); PG8_STAGE(PG8_SA(1, 0), a3, voffA);
            PG8_BAR; PG8_WAIT_L(0); PG8_MMA(1, 0, At, B0); PG8_BAR; PG8_SCHED;
            PG8_STAGE(PG8_SB(1, 1), b3 + hstep, voffB);
            PG8_WAIT_V(6); PG8_BAR; PG8_MMA(1, 1, At, B1); PG8_BAR;
            }
        }
        if constexpr (ALIGN_EPI) { if (wr == 0) PG8_BAR; }
        if constexpr (!Epi::AFTER_DRAIN) { E(acc, cur, wr, wc, fr, fq); S.done(cur); }
        if (!has_next) break;
#pragma unroll
        for (int a = 0; a < 2; ++a)
#pragma unroll
            for (int b = 0; b < 2; ++b)
#pragma unroll
                for (int m = 0; m < 4; ++m)
#pragma unroll
                    for (int n = 0; n < 2; ++n) acc[a][b][m][n] = (f32x4){0.f, 0.f, 0.f, 0.f};
        cur = nxt; cA = nA; cB = nB; ++ui;
        if constexpr (ALIGN_EPI) { if (wr == 1) PG8_BAR; }
    }
    PG8_WAIT_V(0);
    if constexpr (!ALIGN_EPI) { if (wr == 0) PG8_BAR; }
    PG8_BAR;
    if constexpr (Epi::AFTER_DRAIN) { E.fused(acc, cur, wr, wc, fr, fq, lds, wid, lane); S.done(cur); }
#undef PG8_SA
#undef PG8_SB
#undef PG8_STAGE
#undef PG8_LDA
#undef PG8_LDB
#undef PG8_MMA
#undef PG8_WAIT_V
#undef PG8_WAIT_L
#undef PG8_BAR
#undef PG8_SCHED
}
}
using pg8::bf16_t;
constexpr size_t MiB = 1u << 20, KiB = 1u << 10;
constexpr size_t WS_CTL = 0, CTL_ZERO_BYTES = 1 * MiB;
constexpr size_t WS_SMALL = 1 * MiB;
constexpr size_t WS_WTIN = 4 * MiB, WS_WTOUT = 8 * MiB, WS_WTGLU = 10 * MiB, WS_WR = 10 * MiB + 512 * KiB, WS_WTGU = 11 * MiB, WS_WTD = 75 * MiB;
constexpr size_t WS_R1 = 107 * MiB;
constexpr size_t WS_BIG = 139 * MiB;
constexpr size_t WS_Q = WS_BIG, WS_K = WS_BIG + 16 * MiB, WS_V = WS_BIG + 32 * MiB, WS_U = WS_BIG + 48 * MiB, WS_O1 = WS_BIG + 64 * MiB, WS_O2 = WS_BIG + 80 * MiB, WS_YG = WS_BIG + 96 * MiB;
constexpr size_t WS_ROWS = WS_BIG, WS_HID = WS_BIG + 80 * MiB;
constexpr size_t WS_END = WS_BIG + 120 * MiB;
static_assert((size_t)MAXROWS * 1024 * 2 == 80 * MiB && (size_t)MAXROWS * 512 * 2 == 40 * MiB, "moe buffers");
constexpr size_t SM_SSQP = 0, SM_RINV = 512 * KiB, SM_EID = 576 * KiB, SM_GATE = 704 * KiB, SM_DEST = 832 * KiB, SM_LRANK = 960 * KiB, SM_TOKROW = 1088 * KiB,
                 SM_ROWSC = 1248 * KiB, SM_ROWGT = 1408 * KiB, SM_TILEE = 1568 * KiB, SM_CNT = 1572 * KiB, SM_META = 1604 * KiB;
constexpr int CW_BAR = 4096;

constexpr int RING_BYTES = 131072, LDSCTL_OFF = RING_BYTES, MISC_OFF = LDSCTL_OFF + 320, LDS_BYTES = 147456;

#define GAS __attribute__((address_space(1)))
#define LAS __attribute__((address_space(3)))
typedef unsigned v4u __attribute__((ext_vector_type(4)));
typedef unsigned v2u __attribute__((ext_vector_type(2)));
typedef float f32x4 __attribute__((ext_vector_type(4)));
typedef short bf16x8 __attribute__((ext_vector_type(8)));
#define LDS_WAIT() asm volatile("s_waitcnt lgkmcnt(0)" ::: "memory")
#define VM_WAIT() asm volatile("s_waitcnt vmcnt(0)" ::: "memory")
__device__ __forceinline__ unsigned f2bf(float f) { unsigned u = __builtin_bit_cast(unsigned, f); return (u + 0x7fffu + ((u >> 16) & 1u)) >> 16; }
__device__ __forceinline__ unsigned pk2(float lo, float hi) { return f2bf(lo) | (f2bf(hi) << 16); }
__device__ __forceinline__ float bf2f(unsigned short h) { return __uint_as_float(((unsigned)h) << 16); }
__device__ __forceinline__ float wave_sum(float v) {
#pragma unroll
    for (int o = 1; o < 64; o <<= 1) v += __shfl_xor(v, o);
    return v;
}
__device__ __forceinline__ float wave_max(float v) {
#pragma unroll
    for (int o = 1; o < 64; o <<= 1) v = fmaxf(v, __shfl_xor(v, o));
    return v;
}
#define XB_TMO      128
#define XB_XCNT(j)  (256  + 64 * (j))
#define XB_XSUB(j)  (1280 + 64 * (j))
#define XB_XGEN(j)  (2304 + 64 * (j))
#define XB_TOP      3328
#define XB_TOPGEN   3392
#define XCD_BAR_WORDS 3456
#define XB_SPIN_CAP (1u << 18)

__device__ __forceinline__ unsigned xb_ld(unsigned* p)              { return __hip_atomic_load(p, __ATOMIC_RELAXED, __HIP_MEMORY_SCOPE_AGENT); }
__device__ __forceinline__ unsigned xb_add(unsigned* p, unsigned v) { return __hip_atomic_fetch_add(p, v, __ATOMIC_RELAXED, __HIP_MEMORY_SCOPE_AGENT); }
__device__ __forceinline__ unsigned xb_xcc_id() { return (unsigned)__builtin_amdgcn_s_getreg((3 << 11) | 20) & 0xFu; }
#define XB_SPIN(cond, bar) do { unsigned _sp = 0; while (cond) { __builtin_amdgcn_s_sleep(1); \
    if ((++_sp & 255u) == 0u) { if (xb_ld(&(bar)[XB_TMO])) break; if (_sp > XB_SPIN_CAP) { atomicAdd(&(bar)[XB_TMO], 1u); break; } } } } while (0)

struct XcdBarrier {
    unsigned* bar; unsigned x;
    volatile LAS unsigned* st;
};

__device__ __forceinline__ XcdBarrier xcd_barrier_post(unsigned* bar, volatile LAS unsigned* st) {
    XcdBarrier b; b.bar = bar; b.x = xb_xcc_id(); b.st = st;
    if (threadIdx.x == 0) (void)xb_add(&bar[XB_XCNT(b.x)], 1u);
    return b;
}
__device__ __forceinline__ void xcd_barrier_complete(unsigned* bar, unsigned x, unsigned& nloc, unsigned& nx) {
    const unsigned G = gridDim.x * gridDim.y * gridDim.z;
    unsigned sum, cnt, mine, sp = 0u;
    for (;;) {
        sum = 0u; cnt = 0u; mine = 0u;
#pragma unroll
        for (unsigned j = 0; j < 16; ++j) { const unsigned c = xb_ld(&bar[XB_XCNT(j)]); sum += c; cnt += (c > 0u) ? 1u : 0u; mine = (j == x) ? c : mine; }
        if (sum == G) break;
        __builtin_amdgcn_s_sleep(1);
        if ((++sp & 255u) == 0u) { if (xb_ld(&bar[XB_TMO])) break; if (sp > XB_SPIN_CAP) { atomicAdd(&bar[XB_TMO], 1u); break; } }
    }
    nloc = mine > 0u ? mine : 1u; nx = cnt > 0u ? cnt : 1u;
}

__device__ __forceinline__ void xcd_barrier(const XcdBarrier& b) {
    asm volatile("s_waitcnt vmcnt(0)" ::: "memory");
    __syncthreads();
    if (threadIdx.x == 0) {
        unsigned* bar = b.bar;
        __builtin_amdgcn_s_waitcnt(0);
        unsigned nloc = b.st[0], nx = b.st[1];
        if (nloc == 0u) { xcd_barrier_complete(bar, b.x, nloc, nx); b.st[0] = nloc; b.st[1] = nx; }
        const unsigned old = xb_add(&bar[XB_XSUB(b.x)], 1u);
        const unsigned gen = old / nloc;
        if (old + 1u == (gen + 1u) * nloc) {
            __builtin_amdgcn_fence(__ATOMIC_RELEASE, "agent");
            asm volatile("s_waitcnt vmcnt(0)" ::: "memory");
            const unsigned og = xb_add(&bar[XB_TOP], 1u);
            const unsigned tg = og / nx;
            if (og + 1u == (tg + 1u) * nx) xb_add(&bar[XB_TOPGEN], 1u);
            else XB_SPIN(xb_ld(&bar[XB_TOPGEN]) == tg, bar);
            __builtin_amdgcn_fence(__ATOMIC_ACQUIRE, "agent");
            xb_add(&bar[XB_XGEN(b.x)], 1u);
            asm volatile("s_waitcnt vmcnt(0)" ::: "memory");
        } else {
            XB_SPIN(xb_ld(&bar[XB_XGEN(b.x)]) == gen, bar);
            __builtin_amdgcn_fence(__ATOMIC_ACQUIRE, "agent");
            asm volatile("s_waitcnt vmcnt(0)" ::: "memory");
        }
    }
    __syncthreads();
}

struct Args { const float* in[29]; float* out; unsigned char* ws; int ph_lo, ph_hi; };
enum { IN_X = 0, IN_NORM_ATTN, IN_W_IN, IN_LQ1, IN_LK1, IN_LQ2, IN_LK2, IN_SUBLN, IN_LAM_RE, IN_LAM_IM, IN_LOG_DT, IN_B_RE, IN_B_IM, IN_C_RE, IN_C_IM, IN_SSM_D,
       IN_W_GLU, IN_B_GLU, IN_SSM_NORM, IN_W_OUT, IN_NORM_MOE, IN_WRG, IN_BRG, IN_WRE, IN_BRE, IN_W_GATE, IN_W_UP, IN_W_DOWN, IN_NORM_FINAL };

__device__ __forceinline__ void tr_item(const float* __restrict__ W, int ldw, int ks0, int ns0, bf16_t* WT, int ldt, int rd0, int kd0, const float* kscale, LAS float* scr, int lane) {
#pragma unroll 8
    for (int i = 0; i < 32; ++i) { const int kk = 2 * i + (lane >> 5); float v = W[(size_t)(ks0 + kk) * ldw + ns0 + (lane & 31)]; if (kscale) v *= kscale[kk]; scr[kk * 33 + (lane & 31)] = v; }
    LDS_WAIT(); asm volatile("" ::: "memory");
    const int c = lane & 7;
#pragma unroll
    for (int j = 0; j < 4; ++j) { const int n = (lane >> 3) + 8 * j; const LAS float* s = scr + (8 * c) * 33 + n;
        v4u o; o.x = pk2(s[0 * 33], s[1 * 33]); o.y = pk2(s[2 * 33], s[3 * 33]); o.z = pk2(s[4 * 33], s[5 * 33]); o.w = pk2(s[6 * 33], s[7 * 33]);
        *(GAS v4u*)(WT + (size_t)(rd0 + n) * ldt + kd0 + 8 * c) = o; }
    LDS_WAIT(); asm volatile("" ::: "memory");
}
__device__ __forceinline__ void phase0(const Args& a, LAS unsigned char* lds, int lane, int wave, int vcu, int G) {
    LAS float* scr = (LAS float*)(lds + wave * 16384);
    const int gw = vcu * 8 + wave, NGW = G * 8;
    unsigned char* ws = a.ws;
    bf16_t* WT_in = (bf16_t*)(ws + WS_WTIN); bf16_t* WT_out = (bf16_t*)(ws + WS_WTOUT); bf16_t* WT_glu = (bf16_t*)(ws + WS_WTGLU);
    bf16_t* WT_gu = (bf16_t*)(ws + WS_WTGU); bf16_t* WT_d = (bf16_t*)(ws + WS_WTD);
    constexpr int I_IN = 16 * 64, I_OUT = 16 * 32, I_GLU = 8 * 16, I_E = 768, NITEMS = I_IN + I_OUT + I_GLU + NE * I_E;
    for (int it = gw; it < NITEMS; it += NGW) {
        int r = it;
        if (r < I_IN) { const int kb = r >> 6, nb = r & 63; tr_item(a.in[IN_W_IN], IN_COLS, 64 * kb, 32 * nb, WT_in, 1024, 32 * nb, 64 * kb, nullptr, scr, lane); continue; } r -= I_IN;
        if (r < I_OUT) { const int kb = r >> 5, nb = r & 31, ks0 = 64 * kb;
            tr_item(a.in[IN_W_OUT], 1024, ks0, 32 * nb, WT_out, 1024, 32 * nb, (ks0 + 512) & 1023, ks0 >= 512 ? a.in[IN_SSM_NORM] + (ks0 - 512) : nullptr, scr, lane); continue; } r -= I_OUT;
        if (r < I_GLU) { const int kb = r >> 4, nb = r & 15; tr_item(a.in[IN_W_GLU], 512, 64 * kb, 32 * nb, WT_glu, 512, 32 * nb, 64 * kb, nullptr, scr, lane); continue; } r -= I_GLU;
        const int e = r / I_E; r -= e * I_E;
        if (r < 512) { const int up = r >> 8; r &= 255; const int kb = r >> 4, nb = r & 15, n0 = 32 * nb;
            tr_item(a.in[up ? IN_W_UP : IN_W_GATE] + (size_t)e * 1024 * 512, 512, 64 * kb, n0, WT_gu, 1024, e * 1024 + (n0 >> 7) * 256 + up * 128 + (n0 & 127), 64 * kb, nullptr, scr, lane); continue; }
        r -= 512; { const int kb = r >> 5, nb = r & 31; tr_item(a.in[IN_W_DOWN] + (size_t)e * 512 * 1024, 1024, 64 * kb, 32 * nb, WT_d, 512, e * 1024 + 32 * nb, 64 * kb, nullptr, scr, lane); }
    }
    { const float* x = a.in[IN_X]; const float* g = a.in[IN_NORM_ATTN]; bf16_t* XN = (bf16_t*)(ws + WS_R1);
      f32x4 gv[4];
#pragma unroll
      for (int j = 0; j < 4; ++j) gv[j] = *(const f32x4*)(g + 4 * lane + 256 * j);
      for (int m = gw; m < T_TOK; m += NGW) {
        const GAS f32x4* xr = (const GAS f32x4*)(x + (size_t)m * D_MODEL) + lane;
        f32x4 v[4]; float s = 0.f;
#pragma unroll
        for (int j = 0; j < 4; ++j) { v[j] = xr[64 * j]; s += (v[j].x * v[j].x + v[j].y * v[j].y) + (v[j].z * v[j].z + v[j].w * v[j].w); }
        const float rstd = 1.f / sqrtf(wave_sum(s) * (1.f / D_MODEL) + RMS_EPS);
        GAS v2u* o8 = (GAS v2u*)(XN + (size_t)m * D_MODEL) + lane;
#pragma unroll
        for (int j = 0; j < 4; ++j) { v2u o; o.x = pk2(v[j].x * rstd * gv[j].x, v[j].y * rstd * gv[j].y); o.y = pk2(v[j].z * rstd * gv[j].z, v[j].w * rstd * gv[j].w); o8[64 * j] = o; }
      } }
    { bf16_t* WRhi = (bf16_t*)(ws + WS_WR); bf16_t* WRlo = WRhi + 48 * 1024;
      for (int i = gw * 64 + lane; i < 48 * 1024; i += NGW * 64) { const int c = i >> 10, k = i & 1023;
        const float w = c < 4 ? a.in[IN_WRG][k * 4 + c] : (c < 36 ? a.in[IN_WRE][k * 32 + (c - 4)] : 0.f);
        const unsigned hi = f2bf(w); WRhi[i] = (bf16_t)hi; WRlo[i] = (bf16_t)f2bf(w - bf2f((unsigned short)hi)); } }
}

__device__ __forceinline__ void phase5(const Args& a, LAS unsigned char* lds, int tid, int lane, int wave, int vcu, int G) {
    unsigned char* ws = a.ws;
    const float* x1 = a.out; const float* g2 = a.in[IN_NORM_MOE];
    bf16_t* H2 = (bf16_t*)(ws + WS_R1);
    const bf16_t* WRhi = (const bf16_t*)(ws + WS_WR); const bf16_t* WRlo = WRhi + 48 * 1024;
    float* RINV = (float*)(ws + WS_SMALL + SM_RINV); int* EID = (int*)(ws + WS_SMALL + SM_EID); float* GATE = (float*)(ws + WS_SMALL + SM_GATE);
    int* LRANK = (int*)(ws + WS_SMALL + SM_LRANK); int* CNT = (int*)(ws + WS_SMALL + SM_CNT);
    LAS float* PL = (LAS float*)lds;
    LAS float* PS = PL + 2 * 4 * 16 * 49;
    LAS int* EL = (LAS int*)(PS + 2 * 4 * 16);
    const int tg = wave & 3, kh = wave >> 2, r16 = lane & 15, kq = lane >> 4;
    for (int wgi = vcu; wgi < T_TOK / 64; wgi += G) {
        const int row = 64 * wgi + 16 * tg + r16;
        f32x4 acc[3]; acc[0] = acc[1] = acc[2] = (f32x4){0.f, 0.f, 0.f, 0.f};
        float ssq = 0.f;
#pragma unroll 4
        for (int ks = 0; ks < 16; ++ks) {
            const int k0 = kh * 512 + ks * 32 + kq * 8;
            const f32x4 xa = *(const f32x4*)(x1 + (size_t)row * D_MODEL + k0), xb = *(const f32x4*)(x1 + (size_t)row * D_MODEL + k0 + 4);
            const f32x4 ga = *(const f32x4*)(g2 + k0), gb = *(const f32x4*)(g2 + k0 + 4);
            ssq += (xa.x * xa.x + xa.y * xa.y) + (xa.z * xa.z + xa.w * xa.w) + (xb.x * xb.x + xb.y * xb.y) + (xb.z * xb.z + xb.w * xb.w);
            float v[8] = {xa.x * ga.x, xa.y * ga.y, xa.z * ga.z, xa.w * ga.w, xb.x * gb.x, xb.y * gb.y, xb.z * gb.z, xb.w * gb.w};
            unsigned hi[8], lo[8];
#pragma unroll
            for (int i = 0; i < 8; ++i) { hi[i] = f2bf(v[i]); lo[i] = f2bf(v[i] - __uint_as_float(hi[i] << 16)); }
            v4u hw, lw;
            hw.x = hi[0] | (hi[1] << 16); hw.y = hi[2] | (hi[3] << 16); hw.z = hi[4] | (hi[5] << 16); hw.w = hi[6] | (hi[7] << 16);
            lw.x = lo[0] | (lo[1] << 16); lw.y = lo[2] | (lo[3] << 16); lw.z = lo[4] | (lo[5] << 16); lw.w = lo[6] | (lo[7] << 16);
            *(v4u*)(H2 + (size_t)row * D_MODEL + k0) = hw;
            const bf16x8 ahi = __builtin_bit_cast(bf16x8, hw), alo = __builtin_bit_cast(bf16x8, lw);
#pragma unroll
            for (int nt = 0; nt < 3; ++nt) {
                const bf16x8 bh = *(const bf16x8*)(WRhi + (size_t)(nt * 16 + r16) * 1024 + k0), bl = *(const bf16x8*)(WRlo + (size_t)(nt * 16 + r16) * 1024 + k0);
                acc[nt] = __builtin_amdgcn_mfma_f32_16x16x32_bf16(ahi, bh, acc[nt], 0, 0, 0);
                acc[nt] = __builtin_amdgcn_mfma_f32_16x16x32_bf16(ahi, bl, acc[nt], 0, 0, 0);
                acc[nt] = __builtin_amdgcn_mfma_f32_16x16x32_bf16(alo, bh, acc[nt], 0, 0, 0);
            }
        }
        ssq += __shfl_xor(ssq, 16); ssq += __shfl_xor(ssq, 32);
        __syncthreads();
#pragma unroll
        for (int nt = 0; nt < 3; ++nt)
#pragma unroll
            for (int rg = 0; rg < 4; ++rg) PL[((kh * 4 + tg) * 16 + 4 * kq + rg) * 49 + nt * 16 + r16] = acc[nt][rg];
        if (kq == 0) PS[(kh * 4 + tg) * 16 + r16] = ssq;
        __syncthreads();
        if (wave < 4 && lane < 16) {
            const int tl = lane, tok = 64 * wgi + 16 * tg + tl;
            const float ss = PS[(0 * 4 + tg) * 16 + tl] + PS[(1 * 4 + tg) * 16 + tl];
            const float rinv = 1.0f / sqrtf(ss * (1.0f / D_MODEL) + RMS_EPS);
            const LAS float* p0 = PL + ((0 * 4 + tg) * 16 + tl) * 49; const LAS float* p1 = PL + ((1 * 4 + tg) * 16 + tl) * 49;
            float gl[NEG]; float gm = -INFINITY; int gs = 0;
#pragma unroll
            for (int i = 0; i < NEG; ++i) { gl[i] = rinv * (p0[i] + p1[i]) + a.in[IN_BRG][i]; if (gl[i] > gm) { gm = gl[i]; gs = i; } }
            float gsum = 0.f;
#pragma unroll
            for (int i = 0; i < NEG; ++i) gsum += expf(gl[i] - gm);
            const float pg = 1.0f / gsum;
            float el[EPG]; float em = -INFINITY;
#pragma unroll
            for (int i = 0; i < EPG; ++i) { const int c = 4 + gs * EPG + i; el[i] = rinv * (p0[c] + p1[c]) + a.in[IN_BRE][gs * EPG + i]; em = fmaxf(em, el[i]); }
            float esum = 0.f;
#pragma unroll
            for (int i = 0; i < EPG; ++i) esum += expf(el[i] - em);
            int i0 = 0;
#pragma unroll
            for (int i = 1; i < EPG; ++i) if (el[i] > el[i0]) i0 = i;
            int i1 = (i0 == 0) ? 1 : 0;
#pragma unroll
            for (int i = 0; i < EPG; ++i) if (i != i0 && el[i] > el[i1]) i1 = i;
            float e0v = 0.f, e1v = 0.f;
#pragma unroll
            for (int i = 0; i < EPG; ++i) { if (i == i0) e0v = el[i]; if (i == i1) e1v = el[i]; }
            const int ea = gs * EPG + i0, eb = gs * EPG + i1;
            EID[tok * 2] = ea; EID[tok * 2 + 1] = eb;
            GATE[tok * 2] = pg * expf(e0v - em) / esum; GATE[tok * 2 + 1] = pg * expf(e1v - em) / esum;
            RINV[tok] = rinv;
            EL[(16 * tg + tl) * 2] = ea; EL[(16 * tg + tl) * 2 + 1] = eb;
        }
        __syncthreads();
        if (tid < 128) { const int e = EL[tid]; int rk = 0; for (int j = 0; j < tid; ++j) rk += (EL[j] == e) ? 1 : 0; LRANK[wgi * 128 + tid] = rk; }
        else if (tid < 160) { const int e = tid - 128; int c = 0; for (int j = 0; j < 128; ++j) c += (EL[j] == e) ? 1 : 0; CNT[wgi * 32 + e] = c; }
    }
    __syncthreads();
}

__device__ __forceinline__ void phase6(const Args& a, LAS unsigned char* lds, int tid, int lane, int wave, int vcu, int G) {
    unsigned char* ws = a.ws;
    const bf16_t* H2 = (const bf16_t*)(ws + WS_R1); bf16_t* ROWS = (bf16_t*)(ws + WS_ROWS);
    const float* RINV = (const float*)(ws + WS_SMALL + SM_RINV); const int* EID = (const int*)(ws + WS_SMALL + SM_EID); const float* GATE = (const float*)(ws + WS_SMALL + SM_GATE);
    const int* LRANK = (const int*)(ws + WS_SMALL + SM_LRANK); const int* CNT = (const int*)(ws + WS_SMALL + SM_CNT);
    int* DEST = (int*)(ws + WS_SMALL + SM_DEST); int* TOKROW = (int*)(ws + WS_SMALL + SM_TOKROW); float* ROWSC = (float*)(ws + WS_SMALL + SM_ROWSC); float* ROWGT = (float*)(ws + WS_SMALL + SM_ROWGT);
    int* TILEE = (int*)(ws + WS_SMALL + SM_TILEE); int* META = (int*)(ws + WS_SMALL + SM_META);
    LAS int* totS = (LAS int*)lds; LAS int* preS = totS + 32; LAS int* pstS = preS + 32; LAS int* dstS = pstS + 32;
    for (int wgi = vcu; wgi < T_TOK / 64; wgi += G) {
        __syncthreads();
        if (tid < 32) { int tot = 0, pre = 0; for (int w = 0; w < T_TOK / 64; ++w) { const int c = CNT[w * 32 + tid]; tot += c; pre += (w < wgi) ? c : 0; } totS[tid] = tot; preS[tid] = pre; }
        __syncthreads();
        if (tid == 0) { int run = 0; for (int e = 0; e < NE; ++e) { pstS[e] = run; run += ((totS[e] + 255) >> 8) << 8; }
            if (wgi == 0) { META[0] = run >> 8; for (int e = 0; e < NE; ++e) { const int t0 = pstS[e] >> 8, nt = (totS[e] + 255) >> 8; for (int j = 0; j < nt; ++j) TILEE[t0 + j] = e; } } }
        __syncthreads();
        if (tid < 128) { const int tok = 64 * wgi + (tid >> 1); const int e = EID[wgi * 128 + tid]; const int dest = pstS[e] + preS[e] + LRANK[wgi * 128 + tid];
            TOKROW[dest] = tok; ROWSC[dest] = RINV[tok]; ROWGT[dest] = GATE[wgi * 128 + tid]; DEST[wgi * 128 + tid] = dest; dstS[tid] = dest; }
        if (wgi == 0) { for (int e = 0; e < NE; ++e) { const int lo = pstS[e] + totS[e], hi = pstS[e] + (((totS[e] + 255) >> 8) << 8); for (int r = lo + tid; r < hi; r += 512) { TOKROW[r] = -1; ROWSC[r] = 0.f; ROWGT[r] = 0.f; } } }
        __syncthreads();
        for (int as = wave; as < 128; as += 8) { const int tok = 64 * wgi + (as >> 1), dest = dstS[as];
            const GAS v4u* src = (const GAS v4u*)(H2 + (size_t)tok * D_MODEL) + lane; GAS v4u* dst = (GAS v4u*)(ROWS + (size_t)dest * D_MODEL) + lane;
            const v4u r0 = src[0], r1 = src[64]; dst[0] = r0; dst[64] = r1; }
    }
    __syncthreads();
}

__device__ __forceinline__ void phase9(const Args& a, int lane, int wave, int vcu, int G) {
    unsigned char* ws = a.ws; float* out = a.out; const float* gf = a.in[IN_NORM_FINAL];
    const bf16_t* Y = (const bf16_t*)(ws + WS_ROWS); const int* DEST = (const int*)(ws + WS_SMALL + SM_DEST);
    const int gw = vcu * 8 + wave, NGW = G * 8;
    f32x4 gv[4];
#pragma unroll
    for (int j = 0; j < 4; ++j) gv[j] = *(const f32x4*)(gf + 4 * lane + 256 * j);
    for (int m = gw; m < T_TOK; m += NGW) {
        const int d0 = DEST[m * 2], d1 = DEST[m * 2 + 1];
        GAS f32x4* xr = (GAS f32x4*)(out + (size_t)m * D_MODEL) + lane;
        const GAS v2u* y0 = (const GAS v2u*)(Y + (size_t)d0 * D_MODEL) + lane; const GAS v2u* y1 = (const GAS v2u*)(Y + (size_t)d1 * D_MODEL) + lane;
        f32x4 v[4]; float s = 0.f;
#pragma unroll
        for (int j = 0; j < 4; ++j) { v[j] = xr[64 * j]; const v2u p = y0[64 * j], q = y1[64 * j];
            v[j].x += pg8::bf_lo(p.x) + pg8::bf_lo(q.x); v[j].y += pg8::bf_hi(p.x) + pg8::bf_hi(q.x); v[j].z += pg8::bf_lo(p.y) + pg8::bf_lo(q.y); v[j].w += pg8::bf_hi(p.y) + pg8::bf_hi(q.y);
            s += (v[j].x * v[j].x + v[j].y * v[j].y) + (v[j].z * v[j].z + v[j].w * v[j].w); }
        const float rstd = 1.f / sqrtf(wave_sum(s) * (1.f / D_MODEL) + RMS_EPS);
#pragma unroll
        for (int j = 0; j < 4; ++j) xr[64 * j] = v[j] * rstd * gv[j];
    }
}


__device__ __forceinline__ float half_sum(float v, LAS float* scr, int half, int tid) {
    v = wave_sum(v); __syncthreads();
    if ((tid & 63) == 0) scr[tid >> 6] = v;
    __syncthreads();
    const LAS float* s = scr + half * 4; return (s[0] + s[1]) + (s[2] + s[3]);
}
__device__ __forceinline__ float half_max(float v, LAS float* scr, int half, int tid) {
    v = wave_max(v); __syncthreads();
    if ((tid & 63) == 0) scr[tid >> 6] = v;
    __syncthreads();
    const LAS float* s = scr + half * 4; return fmaxf(fmaxf(s[0], s[1]), fmaxf(s[2], s[3]));
}
__device__ __forceinline__ void phase2_attn_naive(const Args& a, LAS unsigned char* lds, int tid, int vcu, int G) {
    unsigned char* ws = a.ws;
    const bf16_t* Q = (const bf16_t*)(ws + WS_Q); const bf16_t* K = (const bf16_t*)(ws + WS_K); const bf16_t* V = (const bf16_t*)(ws + WS_V); bf16_t* CC = (bf16_t*)(ws + WS_R1);
    const int half = tid >> 8, t8 = tid & 255;
    LAS float* sc = (LAS float*)lds + half * SEQ;
    LAS float* qs = (LAS float*)lds + 2 * SEQ + half * DH;
    LAS float* red = (LAS float*)lds + 2 * SEQ + 2 * DH + half * 2 * DV;
    LAS float* scr = (LAS float*)lds + 2 * SEQ + 2 * DH + 4 * DV;
    float s1 = 0.f, s2 = 0.f;
    for (int i = 0; i < DH; ++i) { s1 += a.in[IN_LQ1][i] * a.in[IN_LK1][i]; s2 += a.in[IN_LQ2][i] * a.in[IN_LK2][i]; }
    const float lam = expf(s1) - expf(s2) + LAM_INIT;
    const int NR = BATCH * NH * SEQ;
    for (int r0 = vcu * 2; r0 < NR; r0 += G * 2) {
        const int rr = r0 + half;
        const int q = rr % SEQ, h = (rr / SEQ) % NH, b = rr / (SEQ * NH);
        const float slope2 = exp2f(-2.0f * (float)(h + 1)) * LOG2E;
        const size_t row = (size_t)(b * SEQ + q);
        const int nk = q + 1;
        const int d = t8 & 127, hf = t8 >> 7;
        float otot = 0.f;
        for (int m = 0; m < 2; ++m) {
            __syncthreads();
            if (t8 < DH) qs[t8] = bf2f(Q[row * 512 + h * 128 + m * 64 + t8]);
            __syncthreads();
            float mx = -INFINITY;
            for (int j = t8; j < nk; j += 256) {
                const bf16_t* krow = K + (size_t)(b * SEQ + j) * 512 + h * 128 + m * 64;
                float s = 0.f;
                for (int dd = 0; dd < DH; ++dd) s += qs[dd] * bf2f(krow[dd]);
                s -= slope2 * (float)(q - j);
                sc[j] = s; mx = fmaxf(mx, s);
            }
            const float mm = half_max(mx, scr, half, tid);
            float sm = 0.f;
            for (int j = t8; j < nk; j += 256) { const float e = exp2f(sc[j] - mm); sc[j] = e; sm += e; }
            const float ll = half_sum(sm, scr, half, tid);
            __syncthreads();
            float o = 0.f;
            for (int j = hf; j < nk; j += 2) o += sc[j] * bf2f(V[(size_t)(b * SEQ + j) * 512 + h * 128 + d]);
            o /= ll;
            otot += (m == 0) ? o : -lam * o;
        }
        red[hf * DV + d] = otot;
        __syncthreads();
        float ov = 0.f, sq = 0.f;
        if (t8 < 128) { ov = red[t8] + red[DV + t8]; sq = ov * ov; }
        sq = half_sum(sq, scr, half, tid);
        const float r = rsqrtf(sq / (float)DV + RMS_EPS);
        if (t8 < 128) CC[row * D_MODEL + 512 + h * 128 + t8] = (bf16_t)f2bf(ov * r * a.in[IN_SUBLN][t8] * (1.0f - LAM_INIT));
    }
    __syncthreads();
}
__device__ __forceinline__ void phase2_s5_naive(const Args& a, LAS unsigned char* lds, int lane, int wave, int vcu, int G) {
    unsigned char* ws = a.ws;
    const bf16_t* U = (const bf16_t*)(ws + WS_U); bf16_t* Yg = (bf16_t*)(ws + WS_YG);
    if (wave != 0) return;
    LAS float* xr_s = (LAS float*)lds; LAS float* xi_s = xr_s + NS;
    for (int unit = vcu; unit < BATCH * NG; unit += G) {
        const int g = unit % NG, b = unit / NG, n = lane;
        const double dt = exp((double)a.in[IN_LOG_DT][g]);
        const double lr = a.in[IN_LAM_RE][g * NS + n], li = a.in[IN_LAM_IM][g * NS + n];
        const double mag = exp(lr * dt);
        const double ar_d = mag * cos(li * dt), ai_d = mag * sin(li * dt);
        const double nr = ar_d - 1.0, ni = ai_d, den = lr * lr + li * li;
        const double kr = (nr * lr + ni * li) / den, ki = (ni * lr - nr * li) / den;
        float bbr[GC], bbi[GC];
#pragma unroll
        for (int c = 0; c < GC; ++c) { const double br = a.in[IN_B_RE][(g * NS + n) * GC + c], bi = a.in[IN_B_IM][(g * NS + n) * GC + c]; bbr[c] = (float)(kr * br - ki * bi); bbi[c] = (float)(kr * bi + ki * br); }
        const float ar = (float)ar_d, ai = (float)ai_d;
        const int cc = n & 15, part = n >> 4;
        float cr[16], ci[16];
#pragma unroll
        for (int k = 0; k < 16; ++k) { cr[k] = a.in[IN_C_RE][(g * GC + cc) * NS + part * 16 + k]; ci[k] = a.in[IN_C_IM][(g * GC + cc) * NS + part * 16 + k]; }
        const float dd = a.in[IN_SSM_D][g * GC + cc];
        float xr = 0.f, xi = 0.f;
        for (int t = 0; t < SEQ; ++t) {
            const bf16_t* urow = U + (size_t)(b * SEQ + t) * SSM_W + g * GC;
            float bur = 0.f, bui = 0.f;
#pragma unroll
            for (int c = 0; c < GC; ++c) { const float u = bf2f(urow[c]); bur += bbr[c] * u; bui += bbi[c] * u; }
            const float nxr = ar * xr - ai * xi + bur, nxi = ar * xi + ai * xr + bui;
            xr = nxr; xi = nxi;
            xr_s[n] = xr; xi_s[n] = xi;
            LDS_WAIT(); asm volatile("" ::: "memory");
            float y = 0.f;
#pragma unroll
            for (int k = 0; k < 16; ++k) y += cr[k] * xr_s[part * 16 + k] - ci[k] * xi_s[part * 16 + k];
            LDS_WAIT(); asm volatile("" ::: "memory");
            y += __shfl_xor(y, 16); y += __shfl_xor(y, 32);
            if (part == 0) {
                y += dd * bf2f(urow[cc]);
                const float gl = 0.5f * y * (1.0f + tanhf(0.7978845608028654f * (y + 0.044715f * y * y * y)));
                Yg[(size_t)(b * SEQ + t) * SSM_W + g * GC + cc] = (bf16_t)f2bf(gl);
            }
        }
    }
}


namespace att {
typedef float f32x16 __attribute__((ext_vector_type(16)));
typedef short s16x4 __attribute__((ext_vector_type(4)));
typedef short v4i16_t __attribute__((ext_vector_type(4)));
constexpr int KBUF = 8192, VBUF = 16384, SLOT = KBUF + VBUF, OST = 2 * SLOT, WSF = OST + 8 * 8192, ATT_LDS = WSF + 8 * 256;
constexpr float THR = 8.0f;
__device__ __forceinline__ int crow(int r, int hi) { return (r & 3) + 8 * (r >> 2) + 4 * hi; }
__device__ __forceinline__ unsigned cvtpk(float lo, float hi) { typedef float f2 __attribute__((ext_vector_type(2))); typedef __bf16 b2 __attribute__((ext_vector_type(2))); f2 v = {lo, hi}; b2 b = __builtin_convertvector(v, b2); return __builtin_bit_cast(unsigned, b); }
__device__ __forceinline__ s16x4 vtr(const LAS unsigned char* p) { return __builtin_bit_cast(s16x4, __builtin_amdgcn_ds_read_tr16_b64_v4i16((LAS v4i16_t*)p)); }
#define MX3(a, b, c) __builtin_fmaxf(__builtin_fmaxf((a), (b)), (c))
__device__ __forceinline__ float rowmax(const f32x16& p0, const f32x16& p1) {
    float a = MX3(p0[0], p0[1], p1[0]), b = MX3(p0[2], p0[3], p1[1]); a = MX3(a, p1[2], p1[3]);
#pragma unroll
    for (int r = 4; r < 16; r += 4) { a = MX3(a, p0[r], p0[r + 1]); b = MX3(b, p0[r + 2], p0[r + 3]); a = MX3(a, p1[r], p1[r + 1]); b = MX3(b, p1[r + 2], p1[r + 3]); }
    float m = __builtin_fmaxf(a, b); auto rr = __builtin_amdgcn_permlane32_swap(__float_as_uint(m), __float_as_uint(m), false, false);
    return __builtin_fmaxf(__uint_as_float(rr[0]), __uint_as_float(rr[1]));
}
#undef MX3

__device__ __forceinline__ void attn_unit(int b, int h, int mp, int qb, const bf16_t* __restrict__ Q, const bf16_t* __restrict__ K, const bf16_t* __restrict__ V, bf16_t* __restrict__ O,
                                          LAS unsigned char* lds, int lane, int wid) {
    const int r32 = lane & 31, hi = lane >> 5;
    const int rowbase = b * SEQ, q0 = qb * 256, NT = (q0 + 256) >> 6;
    const int qabs = q0 + wid * 32 + r32;
    const float slope2 = exp2f(-2.0f * (float)(h + 1)) * LOG2E;
    const bf16_t* Qw = Q + (size_t)(rowbase + q0 + wid * 32) * 512 + h * 128 + mp * 64;
    bf16x8 qr[4];
#pragma unroll
    for (int d0 = 0; d0 < 4; ++d0) qr[d0] = *(const bf16x8*)(Qw + (size_t)r32 * 512 + d0 * 16 + hi * 8);
    const bf16_t* ksrc = K + (size_t)(rowbase + lane) * 512 + h * 128 + mp * 64 + wid * 8;
    const int p0i = 2 * wid, p1i = 2 * wid + 1;
    const bf16_t* vsrc0 = V + (size_t)(rowbase + 16 * (p0i & 3) + (lane >> 2)) * 512 + h * 128 + (p0i >> 2) * 32 + (lane & 3) * 8;
    const bf16_t* vsrc1 = V + (size_t)(rowbase + 16 * (p1i & 3) + (lane >> 2)) * 512 + h * 128 + (p1i >> 2) * 32 + (lane & 3) * 8;
#define ATT_DMA(t, slot) do { const size_t go_ = (size_t)(t) * 64 * 512; LAS unsigned char* sl_ = lds + (slot) * SLOT; \
        __builtin_amdgcn_global_load_lds((const unsigned*)(ksrc + go_), (LAS unsigned*)(sl_ + wid * 1024), 16, 0, 0); \
        __builtin_amdgcn_global_load_lds((const unsigned*)(vsrc0 + go_), (LAS unsigned*)(sl_ + KBUF + p0i * 1024), 16, 0, 0); \
        __builtin_amdgcn_global_load_lds((const unsigned*)(vsrc1 + go_), (LAS unsigned*)(sl_ + KBUF + p1i * 1024), 16, 0, 0); } while (0)
    float br[16];
#pragma unroll
    for (int r = 0; r < 16; ++r) br[r] = slope2 * (float)crow(r, hi);
    LAS float* wsf = (LAS float*)(lds + WSF) + wid * 64;
    float mref = 0.f, l_reg = 0.f; bool started = false;
    f32x16 o[4];
#pragma unroll
    for (int d = 0; d < 4; ++d) o[d] = (f32x16){};
    ATT_DMA(NT - 1, 0);
    VM_WAIT();
    __syncthreads();
    for (int it = 0; it < NT; ++it) {
        const int t = NT - 1 - it; const int slot = it & 1;
        if (it + 1 < NT) ATT_DMA(t - 1, slot ^ 1);
        const bool active = (64 * t <= q0 + 32 * wid + 31);
        if (active) {
            const LAS unsigned char* Ks = lds + slot * SLOT; const LAS unsigned char* Vs = Ks + KBUF;
            const float tb = slope2 * (float)(64 * t - qabs) - (started ? mref : 0.f), tb1 = tb + 32.0f * slope2;
            f32x16 c0, c1;
#pragma unroll
            for (int r = 0; r < 16; ++r) { c0[r] = br[r] + tb; c1[r] = br[r] + tb1; }
            const LAS unsigned char* kp = Ks + hi * 1024 + r32 * 16;
#pragma unroll
            for (int d0 = 0; d0 < 4; ++d0) {
                const bf16x8 k0 = *(const LAS bf16x8*)(kp + d0 * 2048), k1 = *(const LAS bf16x8*)(kp + d0 * 2048 + 512);
                c0 = __builtin_amdgcn_mfma_f32_32x32x16_bf16(k0, qr[d0], c0, 0, 0, 0);
                c1 = __builtin_amdgcn_mfma_f32_32x32x16_bf16(k1, qr[d0], c1, 0, 0, 0);
            }
            if (64 * t + 63 > q0 + 32 * wid) {
#pragma unroll
                for (int r = 0; r < 16; ++r) { const int kv = 64 * t + crow(r, hi); if (kv > qabs) c0[r] = -INFINITY; if (kv + 32 > qabs) c1[r] = -INFINITY; }
            }
            const float rm = rowmax(c0, c1);
            if (!started) {
                mref = rm;
#pragma unroll
                for (int r = 0; r < 16; ++r) { c0[r] -= rm; c1[r] -= rm; }
                started = true;
            } else if (__any(rm > THR)) {
                const float dl = __builtin_fmaxf(rm, 0.f); mref += dl;
#pragma unroll
                for (int r = 0; r < 16; ++r) { c0[r] -= dl; c1[r] -= dl; }
                const float f = __builtin_amdgcn_exp2f(-dl); l_reg *= f;
                if (hi == 0) wsf[r32] = f;
                float fr[16];
#pragma unroll
                for (int r = 0; r < 16; ++r) fr[r] = wsf[crow(r, hi)];
#pragma unroll
                for (int d = 0; d < 4; ++d)
#pragma unroll
                    for (int r = 0; r < 16; ++r) o[d][r] *= fr[r];
            }
            float sacc = 0.f;
#pragma unroll
            for (int r = 0; r < 16; ++r) { c0[r] = __builtin_amdgcn_exp2f(c0[r]); c1[r] = __builtin_amdgcn_exp2f(c1[r]); sacc += c0[r] + c1[r]; }
            l_reg += sacc;
            v4u pw[4];
#pragma unroll
            for (int i = 0; i < 4; ++i) { pw[0][i] = cvtpk(c0[2 * i], c0[2 * i + 1]); pw[1][i] = cvtpk(c0[8 + 2 * i], c0[8 + 2 * i + 1]); pw[2][i] = cvtpk(c1[2 * i], c1[2 * i + 1]); pw[3][i] = cvtpk(c1[8 + 2 * i], c1[8 + 2 * i + 1]); }
            const LAS unsigned char* vp = Vs + ((lane >> 4) & 1) * 32 + (lane & 3) * 8 + (4 * hi + ((lane & 15) >> 2)) * 64;
#pragma unroll
            for (int d = 0; d < 4; ++d)
#pragma unroll
                for (int ks = 0; ks < 4; ++ks) {
                    const s16x4 lo = vtr(vp + d * 4096 + ks * 1024), hh = vtr(vp + d * 4096 + ks * 1024 + 512);
                    const bf16x8 vf = (bf16x8){lo[0], lo[1], lo[2], lo[3], hh[0], hh[1], hh[2], hh[3]};
                    o[d] = __builtin_amdgcn_mfma_f32_32x32x16_bf16(__builtin_bit_cast(bf16x8, pw[ks]), vf, o[d], 0, 0, 0);
                }
        }
        VM_WAIT();
        __syncthreads();
    }
#undef ATT_DMA
    { auto rr = __builtin_amdgcn_permlane32_swap(__float_as_uint(l_reg), __float_as_uint(l_reg), false, false); l_reg = __uint_as_float(rr[0]) + __uint_as_float(rr[1]); }
    if (hi == 0) wsf[32 + r32] = l_reg;
    float rli[16];
#pragma unroll
    for (int r = 0; r < 16; ++r) rli[r] = 1.0f / wsf[32 + crow(r, hi)];
    LAS bf16_t* stg = (LAS bf16_t*)(lds + OST + wid * 8192);
#pragma unroll
    for (int r = 0; r < 16; ++r)
#pragma unroll
        for (int d = 0; d < 4; ++d) stg[crow(r, hi) * 128 + d * 32 + r32] = (bf16_t)f2bf(o[d][r] * rli[r]);
    bf16_t* Ow = O + (size_t)(rowbase + q0 + wid * 32) * 512 + h * 128;
#pragma unroll
    for (int i = 0; i < 8; ++i) { const int row = 4 * i + (lane >> 4), ch = lane & 15; const v4u v = *(const LAS v4u*)(stg + row * 128 + ch * 8); *(v4u*)(Ow + (size_t)row * 512 + ch * 8) = v; }
    __syncthreads();
}
}
__device__ __forceinline__ void phase2_attn(const Args& a, LAS unsigned char* lds, int lane, int wave, int vcu, int G) {
    unsigned char* ws = a.ws;
    const bf16_t* Q = (const bf16_t*)(ws + WS_Q); const bf16_t* K = (const bf16_t*)(ws + WS_K); const bf16_t* V = (const bf16_t*)(ws + WS_V);
    for (int pi = vcu; pi < 256; pi += G) {
        const int bhm = pi >> 4, s = pi & 15; const int b = bhm >> 3, h = (bhm >> 1) & 3, mp = bhm & 1;
        bf16_t* O = (bf16_t*)(ws + (mp ? WS_O2 : WS_O1));
        att::attn_unit(b, h, mp, 31 - s, Q, K, V, O, lds, lane, wave);
        att::attn_unit(b, h, mp, s, Q, K, V, O, lds, lane, wave);
    }
}
__device__ __forceinline__ void attn_finish(const Args& a, int lane, int wave, int vcu, int G) {
    unsigned char* ws = a.ws;
    const bf16_t* O1 = (const bf16_t*)(ws + WS_O1); const bf16_t* O2 = (const bf16_t*)(ws + WS_O2); bf16_t* CC = (bf16_t*)(ws + WS_R1);
    float s1 = a.in[IN_LQ1][lane] * a.in[IN_LK1][lane], s2 = a.in[IN_LQ2][lane] * a.in[IN_LK2][lane];
    s1 = wave_sum(s1); s2 = wave_sum(s2);
    const float lam = expf(s1) - expf(s2) + LAM_INIT;
    float gn[8];
#pragma unroll
    for (int i = 0; i < 8; ++i) gn[i] = a.in[IN_SUBLN][(8 * lane + i) & 127] * (1.0f - LAM_INIT);
    const int gw = vcu * 8 + wave, NGW = G * 8;
    for (int tok = gw; tok < T_TOK; tok += NGW) {
        const v4u x1 = *(const v4u*)(O1 + (size_t)tok * 512 + 8 * lane), x2 = *(const v4u*)(O2 + (size_t)tok * 512 + 8 * lane);
        float v[8];
        v[0] = pg8::bf_lo(x1.x) - lam * pg8::bf_lo(x2.x); v[1] = pg8::bf_hi(x1.x) - lam * pg8::bf_hi(x2.x); v[2] = pg8::bf_lo(x1.y) - lam * pg8::bf_lo(x2.y); v[3] = pg8::bf_hi(x1.y) - lam * pg8::bf_hi(x2.y);
        v[4] = pg8::bf_lo(x1.z) - lam * pg8::bf_lo(x2.z); v[5] = pg8::bf_hi(x1.z) - lam * pg8::bf_hi(x2.z); v[6] = pg8::bf_lo(x1.w) - lam * pg8::bf_lo(x2.w); v[7] = pg8::bf_hi(x1.w) - lam * pg8::bf_hi(x2.w);
        float ss = 0.f;
#pragma unroll
        for (int i = 0; i < 8; ++i) ss += v[i] * v[i];
        ss += __shfl_xor(ss, 1); ss += __shfl_xor(ss, 2); ss += __shfl_xor(ss, 4); ss += __shfl_xor(ss, 8);
        const float r = 1.0f / sqrtf(ss * (1.0f / DV) + RMS_EPS);
        v4u w; w.x = pk2(v[0] * r * gn[0], v[1] * r * gn[1]); w.y = pk2(v[2] * r * gn[2], v[3] * r * gn[3]); w.z = pk2(v[4] * r * gn[4], v[5] * r * gn[5]); w.w = pk2(v[6] * r * gn[6], v[7] * r * gn[7]);
        *(v4u*)(CC + (size_t)tok * D_MODEL + 512 + 8 * lane) = w;
    }
}


namespace s5 {
typedef float f32x16 __attribute__((ext_vector_type(16)));
typedef short s16x4 __attribute__((ext_vector_type(4)));
typedef short v4i16_t __attribute__((ext_vector_type(4)));
constexpr int ES_OFF = 132096, KAP_OFF = ES_OFF + 4096;
__device__ __forceinline__ s16x4 vtr(const LAS unsigned char* p) { return __builtin_bit_cast(s16x4, __builtin_amdgcn_ds_read_tr16_b64_v4i16((LAS v4i16_t*)p)); }
__device__ __forceinline__ void s5_unit(int b, int g, const Args& a, LAS unsigned char* lds, int lane, int wid) {
    const bf16_t* U = (const bf16_t*)(a.ws + WS_U); bf16_t* Yg = (bf16_t*)(a.ws + WS_YG);
    const int n = lane, r32 = lane & 31, hi = lane >> 5, r16 = lane & 15, kq = lane >> 4;
    LAS unsigned char* wl = lds + wid * 16384;
    LAS float* es = (LAS float*)(lds + ES_OFF);
    LAS float* kap = (LAS float*)(lds + KAP_OFF) + wid * 128;
    const double dt = exp((double)a.in[IN_LOG_DT][g]);
    const double lr = a.in[IN_LAM_RE][g * NS + n], li = a.in[IN_LAM_IM][g * NS + n];
    const double mag = exp(lr * dt);
    const double ar_d = mag * cos(li * dt), ai_d = mag * sin(li * dt);
    const double nr = ar_d - 1.0, ni = ai_d, den = lr * lr + li * li;
    const float ar = (float)ar_d, ai = (float)ai_d;
    kap[n] = (float)((nr * lr + ni * li) / den); kap[64 + n] = (float)((ni * lr - nr * li) / den);
    const double magL = exp(lr * dt * 1024.0);
    const float pr = (float)(magL * cos(li * dt * 1024.0)), pim = (float)(magL * sin(li * dt * 1024.0));
    bf16x8 bfrag[4];
#pragma unroll
    for (int nb = 0; nb < 4; ++nb) {
        const int n2 = 32 * (nb & 1) + r32; const float kr2 = kap[n2], ki2 = kap[64 + n2];
        const float* pre = a.in[IN_B_RE] + (size_t)(g * NS + n2) * GC + 8 * hi; const float* pim_ = a.in[IN_B_IM] + (size_t)(g * NS + n2) * GC + 8 * hi;
        float v[8];
#pragma unroll
        for (int j = 0; j < 8; ++j) v[j] = (nb < 2) ? (kr2 * pre[j] - ki2 * pim_[j]) : (kr2 * pim_[j] + ki2 * pre[j]);
        v4u w; w.x = pk2(v[0], v[1]); w.y = pk2(v[2], v[3]); w.z = pk2(v[4], v[5]); w.w = pk2(v[6], v[7]);
        bfrag[nb] = __builtin_bit_cast(bf16x8, w);
    }
    bf16x8 cfrag[4];
#pragma unroll
    for (int ks = 0; ks < 4; ++ks) {
        const int k0 = 32 * (ks & 1) + 8 * kq; const float* src = a.in[ks < 2 ? IN_C_RE : IN_C_IM] + (size_t)(g * GC + r16) * NS + k0; const float sg = ks < 2 ? 1.f : -1.f;
        v4u w; w.x = pk2(sg * src[0], sg * src[1]); w.y = pk2(sg * src[2], sg * src[3]); w.z = pk2(sg * src[4], sg * src[5]); w.w = pk2(sg * src[6], sg * src[7]);
        cfrag[ks] = __builtin_bit_cast(bf16x8, w);
    }
    const float dsk = a.in[IN_SSM_D][g * GC + r16];
    const int tokbase = b * SEQ + wid * 1024;
    const int sw = n & 7;
    float cr_ = 0.f, ci_ = 0.f;
    for (int pass = 0; pass < 2; ++pass) {
        float xr = cr_, xi = ci_;
        for (int ch = 0; ch < 32; ++ch) {
            const int t0 = tokbase + 32 * ch;
            const bf16x8 ufrag = *(const bf16x8*)(U + (size_t)(t0 + r32) * SSM_W + g * GC + 8 * hi);
#pragma unroll
            for (int nb = 0; nb < 4; ++nb) {
                const f32x16 acc = __builtin_amdgcn_mfma_f32_32x32x16_bf16(ufrag, bfrag[nb], (f32x16){}, 0, 0, 0);
                const int col = 32 * nb + r32;
#pragma unroll
                for (int rr = 0; rr < 4; ++rr) *(LAS f32x4*)(wl + col * 128 + (((2 * rr + hi) ^ (col & 7)) * 16)) = (f32x4){acc[4 * rr], acc[4 * rr + 1], acc[4 * rr + 2], acc[4 * rr + 3]};
            }
            f32x4 bur[8], bui[8];
#pragma unroll
            for (int s = 0; s < 8; ++s) { bur[s] = *(const LAS f32x4*)(wl + n * 128 + ((s ^ sw) * 16)); bui[s] = *(const LAS f32x4*)(wl + (64 + n) * 128 + ((s ^ sw) * 16)); }
            unsigned xrp[16], xip[16];
#pragma unroll
            for (int s = 0; s < 8; ++s) {
                float xa[4], xb[4];
#pragma unroll
                for (int i = 0; i < 4; ++i) { const float nxr = ar * xr - ai * xi + bur[s][i], nxi = ar * xi + ai * xr + bui[s][i]; xr = nxr; xi = nxi; xa[i] = xr; xb[i] = xi; }
                xrp[2 * s] = pk2(xa[0], xa[1]); xrp[2 * s + 1] = pk2(xa[2], xa[3]); xip[2 * s] = pk2(xb[0], xb[1]); xip[2 * s + 1] = pk2(xb[2], xb[3]);
            }
            if (pass == 1) {
#pragma unroll
                for (int s2 = 0; s2 < 4; ++s2) {
                    *(LAS v4u*)(wl + n * 128 + ((s2 ^ (n & 3)) * 16)) = (v4u){xrp[4 * s2], xrp[4 * s2 + 1], xrp[4 * s2 + 2], xrp[4 * s2 + 3]};
                    *(LAS v4u*)(wl + (64 + n) * 128 + ((s2 ^ (n & 3)) * 16)) = (v4u){xip[4 * s2], xip[4 * s2 + 1], xip[4 * s2 + 2], xip[4 * s2 + 3]};
                }
                const int q = r16 >> 2, p = r16 & 3;
#pragma unroll
                for (int tt = 0; tt < 2; ++tt) {
                    f32x4 acc4 = (f32x4){0.f, 0.f, 0.f, 0.f};
                    const int s2 = 2 * tt + (p >> 1);
#pragma unroll
                    for (int ks = 0; ks < 4; ++ks) {
                        const LAS unsigned char* ad = wl + (32 * ks + 8 * kq + q) * 128 + ((s2 ^ q) * 16) + (p & 1) * 8;
                        const s16x4 lo = vtr(ad), hh = vtr(ad + 4 * 128);
                        const bf16x8 af = (bf16x8){lo[0], lo[1], lo[2], lo[3], hh[0], hh[1], hh[2], hh[3]};
                        acc4 = __builtin_amdgcn_mfma_f32_16x16x32_bf16(af, cfrag[ks], acc4, 0, 0, 0);
                    }
#pragma unroll
                    for (int rg = 0; rg < 4; ++rg) {
                        const size_t tk = (size_t)(t0 + 16 * tt + 4 * kq + rg);
                        const float y = acc4[rg] + dsk * bf2f(U[tk * SSM_W + g * GC + r16]);
                        const float z = 0.7978845608028654f * (y + 0.044715f * y * y * y);
                        Yg[tk * SSM_W + g * GC + r16] = (bf16_t)f2bf(y * pg8::sigmoid_f(2.0f * z));
                    }
                }
            }
        }
        if (pass == 0) {
            es[(wid * 64 + n) * 2] = xr; es[(wid * 64 + n) * 2 + 1] = xi;
            __syncthreads();
            float c_r = 0.f, c_i = 0.f;
            for (int v = 0; v < wid; ++v) { const float er = es[(v * 64 + n) * 2], ei = es[(v * 64 + n) * 2 + 1]; const float t_r = pr * c_r - pim * c_i + er, t_i = pr * c_i + pim * c_r + ei; c_r = t_r; c_i = t_i; }
            cr_ = c_r; ci_ = c_i;
        }
    }
    __syncthreads();
}
}
__device__ __forceinline__ void phase2_s5(const Args& a, LAS unsigned char* lds, int lane, int wave, int vcu, int G) {
    for (int unit = vcu; unit < BATCH * NG; unit += G) s5::s5_unit(unit / NG, unit % NG, a, lds, lane, wave);
}

__global__ void __launch_bounds__(512, 2) mk_fwd(Args args) {
    extern __shared__ __attribute__((aligned(16))) unsigned char lds_raw[];
    LAS unsigned char* lds = (LAS unsigned char*)lds_raw;
    const int tid = threadIdx.x, lane = tid & 63, wave = __builtin_amdgcn_readfirstlane(tid >> 6);
    const int G = gridDim.x; const int bx = blockIdx.x; const int vcu = (G % 8 == 0) ? (bx % 8) * (G / 8) + bx / 8 : bx;
    unsigned char* ws = args.ws;
    volatile LAS unsigned* MISC = (volatile LAS unsigned*)(lds + MISC_OFF);
    for (int u = tid; u < (LDS_BYTES - LDSCTL_OFF) / 4; u += 512) ((LAS unsigned*)(lds + LDSCTL_OFF))[u] = 0u;
    __syncthreads();
    const int lo = args.ph_lo, hi = args.ph_hi;
    XcdBarrier bar; bar.bar = (unsigned*)(ws + WS_CTL) + CW_BAR; bar.x = 0; bar.st = nullptr;
    if (hi - lo > 1) bar = xcd_barrier_post((unsigned*)(ws + WS_CTL) + CW_BAR, MISC + 8);
#define IN(k) (lo <= (k) && (k) < hi)
#define SEAM(k) do { if (IN(k) && IN((k) + 1)) xcd_barrier(bar); } while (0)
    if (IN(0)) { phase0(args, lds, lane, wave, vcu, G); } SEAM(0);
    if (IN(1)) { pg8::Gemm g{(const bf16_t*)(ws + WS_R1), (const bf16_t*)(ws + WS_WTIN), T_TOK, IN_COLS, D_MODEL}; pg8::StaticOrder S; S.init(T_TOK, IN_COLS, G, bx);
        pg8::EpiInProj E{(bf16_t*)(ws + WS_Q)};
        pg8::gemm_phase<pg8::EpiInProj, pg8::StaticOrder, true, true>(lds, g, S, E); } SEAM(1);
    if (IN(2)) { phase2_s5(args, lds, lane, wave, vcu, G); __syncthreads(); phase2_attn(args, lds, lane, wave, vcu, G); } SEAM(2);
    if (IN(3)) { pg8::Gemm g{(const bf16_t*)(ws + WS_YG), (const bf16_t*)(ws + WS_WTGLU), T_TOK, SSM_W, SSM_W}; pg8::StaticOrder S; S.init(T_TOK, SSM_W, G, bx);
        pg8::EpiGlu E{(const bf16_t*)(ws + WS_YG), args.in[IN_B_GLU], (bf16_t*)(ws + WS_R1), (float*)(ws + WS_SMALL + SM_SSQP)};
        pg8::gemm_phase<pg8::EpiGlu, pg8::StaticOrder, true, true>(lds, g, S, E); attn_finish(args, lane, wave, vcu, G); } SEAM(3);
    if (IN(4)) { pg8::Gemm g{(const bf16_t*)(ws + WS_R1), (const bf16_t*)(ws + WS_WTOUT), T_TOK, D_MODEL, D_MODEL}; pg8::StaticOrder S; S.init(T_TOK, D_MODEL, G, bx);
        pg8::EpiOut E{args.in[IN_X], args.out, (const float*)(ws + WS_SMALL + SM_SSQP)};
        pg8::gemm_phase<pg8::EpiOut, pg8::StaticOrder, true, true>(lds, g, S, E); } SEAM(4);
    if (IN(5)) { phase5(args, lds, tid, lane, wave, vcu, G); } SEAM(5);
    if (IN(6)) { phase6(args, lds, tid, lane, wave, vcu, G); } SEAM(6);
    if (IN(7)) { const int ntiles = __builtin_amdgcn_readfirstlane(((const int*)(ws + WS_SMALL + SM_META))[0]);
        pg8::Gemm g{(const bf16_t*)(ws + WS_ROWS), (const bf16_t*)(ws + WS_WTGU), ntiles * 256, NE * 1024, D_MODEL}; pg8::MoeOrder S{(const int*)(ws + WS_SMALL + SM_TILEE), ntiles, G, vcu};
        pg8::EpiMoeUp E{(bf16_t*)(ws + WS_HID), (const float*)(ws + WS_SMALL + SM_ROWSC)};
        pg8::gemm_phase<pg8::EpiMoeUp, pg8::MoeOrder, true, true>(lds, g, S, E); } SEAM(7);
    if (IN(8)) { const int ntiles = __builtin_amdgcn_readfirstlane(((const int*)(ws + WS_SMALL + SM_META))[0]);
        pg8::Gemm g{(const bf16_t*)(ws + WS_HID), (const bf16_t*)(ws + WS_WTD), ntiles * 256, NE * 1024, FF}; pg8::MoeOrder S{(const int*)(ws + WS_SMALL + SM_TILEE), ntiles, G, vcu};
        pg8::EpiMoeDown E{(bf16_t*)(ws + WS_ROWS), (const float*)(ws + WS_SMALL + SM_ROWGT)};
        pg8::gemm_phase<pg8::EpiMoeDown, pg8::MoeOrder, true, true>(lds, g, S, E); } SEAM(8);
    if (IN(9)) { phase9(args, lane, wave, vcu, G); }
#undef IN
#undef SEAM
}

extern "C" void kernel_launch(void* const* d_in, const int* in_sizes, int n_in, void* d_out, int out_size, void* d_ws, size_t ws_size, hipStream_t stream) {
    static int grid = 0;
    if (grid == 0) {
        if (n_in != 29 || out_size != T_TOK * D_MODEL || ws_size < WS_END) { fprintf(stderr, "kernel_launch: unexpected shapes (n_in %d, out %d, ws %zu < %zu)\n", n_in, out_size, ws_size, (size_t)WS_END); grid = -1; return; }
        int dev = 0, cus = 0;
        if (hipGetDevice(&dev) != hipSuccess || hipDeviceGetAttribute(&cus, hipDeviceAttributeMultiprocessorCount, dev) != hipSuccess) { grid = -1; return; }
        if (hipFuncSetAttribute((const void*)mk_fwd, hipFuncAttributeMaxDynamicSharedMemorySize, LDS_BYTES) != hipSuccess) { fprintf(stderr, "kernel_launch: hipFuncSetAttribute failed\n"); grid = -1; return; }
        grid = cus;
    }
    if (grid < 0) return;
    (void)hipMemsetAsync((char*)d_ws + WS_CTL, 0, CTL_ZERO_BYTES, stream);
    Args a{};
    for (int i = 0; i < 29; ++i) a.in[i] = (const float*)d_in[i];
    a.out = (float*)d_out; a.ws = (unsigned char*)d_ws;
    unsigned char* ws = (unsigned char*)d_ws;
    a.ph_lo = 0; a.ph_hi = 10;
    hipLaunchKernelGGL(mk_fwd, dim3(grid), dim3(512), LDS_BYTES, stream, a);
}
```

```cpp
#define ATT_WINDOW 1
#include <hip/hip_runtime.h>
#include <cstdio>
#include <cstdint>
#include <cmath>

constexpr int D_MODEL = 1024, BATCH = 2, SEQ = 8192, T_TOK = BATCH * SEQ;
constexpr int IN_COLS = 2048, ATTN_W = 512, SSM_W = 512, NH = 4, DH = 64, DV = 128;
constexpr int NG = 32, GC = 16, NS = 64;
constexpr int NEG = 4, EPG = 8, NE = 32, FF = 512;
constexpr float RMS_EPS = 1e-6f;
constexpr float LAM_INIT = 0.2f;
constexpr float C2 = 0.125f * 1.4426950408889634f;
constexpr float LOG2E = 1.4426950408889634f;
constexpr int MAXROWS = 2 * T_TOK + NE * 256;

namespace pg8 {
#define PG8_LAS __attribute__((address_space(3)))
typedef unsigned short bf16_t;
typedef short bf16x8 __attribute__((ext_vector_type(8)));
typedef float f32x4 __attribute__((ext_vector_type(4)));
typedef unsigned u32x4 __attribute__((ext_vector_type(4)));
constexpr int BM = 256, BK = 64, HALF = 128, HTB = HALF * BK * 2  , STAGE_BYTES = 8 * HTB, NXCD = 8, WGM = 8;

__host__ __device__ __forceinline__ int lds_byte(int r, int c) { const int st = (r >> 4) * 2 + (c >> 5), rr = r & 15, cc = c & 31, ob = rr * 64 + cc * 2; return st * 1024 + (ob ^ (((ob >> 9) & 1) << 5)); }
__host__ __device__ __forceinline__ void stage_rc(int b, int& R, int& C) { const int st = b / 1024, sb = b % 1024, swz = sb ^ (((sb >> 9) & 1) << 5); R = (st >> 1) * 16 + swz / 64; C = (st & 1) * 32 + (swz % 64) / 2; }
__host__ __device__ __forceinline__ int perm32(int rho) { const int n = rho >> 4, i = rho & 15; return 8 * (i >> 2) + 4 * n + (i & 3); }

struct Unit { int pm, pn; };
struct Gemm { const bf16_t* A; const bf16_t* Bt; int M, N, K; };

struct StaticOrder {
    int nM, nN, nwg, G, c;
    __host__ __device__ void init(int M, int N, int G_, int c_) { nM = M / BM; nN = N / BM; nwg = nM * nN; G = G_; c = c_; }
    __host__ __device__ bool next(int i, Unit& u) const {
        const long L = (long)i * G + c; if (L >= nwg) return false;
        int wgid = (int)L; { const int q = nwg / NXCD, r = nwg % NXCD, xcd = wgid % NXCD, off = wgid / NXCD; wgid = (xcd < r ? xcd * (q + 1) : r * (q + 1) + (xcd - r) * q) + off; }
        const int nig = WGM * nN, gid = wgid / nig, fm = gid * WGM, gsz = (nM - fm) < WGM ? (nM - fm) : WGM;
        u.pm = fm + ((wgid % nig) % gsz); u.pn = (wgid % nig) / gsz; return true;
    }
    __device__ __forceinline__ void a_ready(const Unit&) const {}
    __device__ __forceinline__ void done(const Unit&) const {}
};

typedef unsigned u32x4 __attribute__((ext_vector_type(4)));
__device__ __forceinline__ unsigned cvt_pk_bf16(float lo, float hi) { unsigned r; asm volatile("v_cvt_pk_bf16_f32 %0, %1, %2" : "=v"(r) : "v"(lo), "v"(hi)); return r; }
__device__ __forceinline__ float bf_lo(unsigned w) { return __uint_as_float(w << 16); }
__device__ __forceinline__ float bf_hi(unsigned w) { return __uint_as_float(w & 0xffff0000u); }
__device__ __forceinline__ float sigmoid_f(float v) { return __builtin_amdgcn_rcpf(1.0f + __builtin_amdgcn_exp2f(-1.4426950408889634f * v)); }

struct EpiInProj {
    static constexpr bool PERM = true, AFTER_DRAIN = false, MIDK = false;
    bf16_t* O; unsigned* NORMS;
    __device__ __forceinline__ void operator()(const f32x4 (&acc)[2][2][4][2], const Unit& u, int wr, int wc, int fr, int fq) const {
        const int row0 = u.pm * BM + wr * 64 + fr; int colt = u.pn * BM; const int t = colt >> 9; colt -= t << 9;
        bf16_t* base = O + (size_t)t * ((size_t)16384 * 512); const float sc = (t == 0) ? (0.125f * 1.4426950408889634f) : 1.f;
        const int col0 = colt + wc * 32 + 8 * fq;
#pragma unroll
        for (int ai = 0; ai < 2; ++ai)
#pragma unroll
            for (int m = 0; m < 4; ++m) { bf16_t* rowp = base + (size_t)(row0 + ai * HALF + m * 16) * 512 + col0;
#pragma unroll
                for (int bj = 0; bj < 2; ++bj) { const f32x4 v0 = acc[ai][bj][m][0] * sc, v1 = acc[ai][bj][m][1] * sc;
                    u32x4 w; w.x = cvt_pk_bf16(v0[0], v0[1]); w.y = cvt_pk_bf16(v0[2], v0[3]); w.z = cvt_pk_bf16(v1[0], v1[1]); w.w = cvt_pk_bf16(v1[2], v1[3]);
                    *(u32x4*)(rowp + bj * HALF) = w; } }
        if (t < 2) {
#pragma unroll
            for (int bj = 0; bj < 2; ++bj) { float mx = 0.f;
#pragma unroll
                for (int ai = 0; ai < 2; ++ai)
#pragma unroll
                    for (int m = 0; m < 4; ++m) { const f32x4 v0 = acc[ai][bj][m][0] * sc, v1 = acc[ai][bj][m][1] * sc;
                        float ss = (v0[0] * v0[0] + v0[1] * v0[1]) + (v0[2] * v0[2] + v0[3] * v0[3]) + (v1[0] * v1[0] + v1[1] * v1[1]) + (v1[2] * v1[2] + v1[3] * v1[3]);
                        ss += __shfl_xor(ss, 16); ss += __shfl_xor(ss, 32); mx = fmaxf(mx, ss); }
                mx = fmaxf(mx, __shfl_xor(mx, 1)); mx = fmaxf(mx, __shfl_xor(mx, 2)); mx = fmaxf(mx, __shfl_xor(mx, 4)); mx = fmaxf(mx, __shfl_xor(mx, 8));
                if (fr == 0 && fq == 0) atomicMax(NORMS + t * 32 + (u.pm >> 5) * 16 + ((colt + bj * HALF + wc * 32) >> 5), __float_as_uint(sqrtf(mx) * 1.001f)); }
        }
    }
};
struct EpiGlu {
    static constexpr bool PERM = true, AFTER_DRAIN = false, MIDK = false;
    const bf16_t* Yg; const float* bias; bf16_t* CC; float* SSQP;
    __device__ __forceinline__ void operator()(const f32x4 (&acc)[2][2][4][2], const Unit& u, int wr, int wc, int fr, int fq) const {
        const int row0 = u.pm * BM + wr * 64 + fr, col0 = u.pn * BM + wc * 32 + 8 * fq;
        f32x4 bv[2][2];
#pragma unroll
        for (int bj = 0; bj < 2; ++bj)
#pragma unroll
            for (int n = 0; n < 2; ++n) bv[bj][n] = *(const f32x4*)(bias + col0 + bj * HALF + 4 * n);
#pragma unroll
        for (int ai = 0; ai < 2; ++ai)
#pragma unroll
            for (int m = 0; m < 4; ++m) { const int row = row0 + ai * HALF + m * 16; float ss = 0.f;
#pragma unroll
                for (int bj = 0; bj < 2; ++bj) { const int col = col0 + bj * HALF;
                    const u32x4 y8 = *(const u32x4*)(Yg + (size_t)row * 512 + col);
                    const f32x4 a0 = acc[ai][bj][m][0] + bv[bj][0], a1 = acc[ai][bj][m][1] + bv[bj][1];
                    float z[8];
                    z[0] = bf_lo(y8.x) * sigmoid_f(a0[0]); z[1] = bf_hi(y8.x) * sigmoid_f(a0[1]); z[2] = bf_lo(y8.y) * sigmoid_f(a0[2]); z[3] = bf_hi(y8.y) * sigmoid_f(a0[3]);
                    z[4] = bf_lo(y8.z) * sigmoid_f(a1[0]); z[5] = bf_hi(y8.z) * sigmoid_f(a1[1]); z[6] = bf_lo(y8.w) * sigmoid_f(a1[2]); z[7] = bf_hi(y8.w) * sigmoid_f(a1[3]);
#pragma unroll
                    for (int i = 0; i < 8; ++i) ss += z[i] * z[i];
                    u32x4 w; w.x = cvt_pk_bf16(z[0], z[1]); w.y = cvt_pk_bf16(z[2], z[3]); w.z = cvt_pk_bf16(z[4], z[5]); w.w = cvt_pk_bf16(z[6], z[7]);
                    *(u32x4*)(CC + (size_t)row * 1024 + col) = w; }
                ss += __shfl_xor(ss, 16); ss += __shfl_xor(ss, 32);
                if (fq == 0) SSQP[(size_t)row * 8 + u.pn * 4 + wc] = ss; }
    }
};
struct EpiOut {
    static constexpr bool PERM = false, AFTER_DRAIN = false, MIDK = true;
    const float* x; float* out; const float* SSQP;
    __device__ __forceinline__ void midk(f32x4 (&acc)[2][2][4][2], const Unit& u, int wr, int wc, int fr, int fq) const {
#pragma unroll
        for (int ai = 0; ai < 2; ++ai)
#pragma unroll
            for (int m = 0; m < 4; ++m) { const int row = u.pm * BM + ai * HALF + wr * 64 + m * 16 + fr;
                const f32x4 s0 = *(const f32x4*)(SSQP + (size_t)row * 8), s1 = *(const f32x4*)(SSQP + (size_t)row * 8 + 4);
                const float s = ((s0[0] + s0[1]) + (s0[2] + s0[3])) + ((s1[0] + s1[1]) + (s1[2] + s1[3]));
                const float r = __builtin_amdgcn_rsqf(s * (1.0f / 512.0f) + 1e-6f);
#pragma unroll
                for (int bj = 0; bj < 2; ++bj)
#pragma unroll
                    for (int n = 0; n < 2; ++n) acc[ai][bj][m][n] *= r; }
    }
    __device__ __forceinline__ void operator()(const f32x4 (&acc)[2][2][4][2], const Unit& u, int wr, int wc, int fr, int fq) const {
        const int col0 = u.pn * BM + wc * 32 + 4 * fq;
#pragma unroll
        for (int ai = 0; ai < 2; ++ai)
#pragma unroll
            for (int m = 0; m < 4; ++m) { const size_t off = (size_t)(u.pm * BM + ai * HALF + wr * 64 + m * 16 + fr) * 1024 + col0;
#pragma unroll
                for (int bj = 0; bj < 2; ++bj)
#pragma unroll
                    for (int n = 0; n < 2; ++n) { const f32x4 bs = *(const f32x4*)(x + off + bj * HALF + n * 16); *(f32x4*)(out + off + bj * HALF + n * 16) = bs + acc[ai][bj][m][n]; } }
    }
};
struct EpiMoeUp {
    static constexpr bool PERM = true, AFTER_DRAIN = false, MIDK = false;
    bf16_t* HID; const float* ROWSC;
    __device__ __forceinline__ void operator()(const f32x4 (&acc)[2][2][4][2], const Unit& u, int wr, int wc, int fr, int fq) const {
        const int row0 = u.pm * BM + wr * 64 + fr, j0 = (u.pn & 3) * HALF + wc * 32 + 8 * fq;
#pragma unroll
        for (int ai = 0; ai < 2; ++ai)
#pragma unroll
            for (int m = 0; m < 4; ++m) { const int row = row0 + ai * HALF + m * 16; const float rs = ROWSC[row];
                float h[8];
#pragma unroll
                for (int n = 0; n < 2; ++n)
#pragma unroll
                    for (int i = 0; i < 4; ++i) { const float g = acc[ai][0][m][n][i] * rs, up = acc[ai][1][m][n][i] * rs; h[n * 4 + i] = g * sigmoid_f(g) * up; }
                u32x4 w; w.x = cvt_pk_bf16(h[0], h[1]); w.y = cvt_pk_bf16(h[2], h[3]); w.z = cvt_pk_bf16(h[4], h[5]); w.w = cvt_pk_bf16(h[6], h[7]);
                *(u32x4*)(HID + (size_t)row * 512 + j0) = w; }
    }
};
struct EpiMoeDown {
    static constexpr bool PERM = true, AFTER_DRAIN = false, MIDK = false;
    bf16_t* Y; const float* ROWGT;
    __device__ __forceinline__ void operator()(const f32x4 (&acc)[2][2][4][2], const Unit& u, int wr, int wc, int fr, int fq) const {
        const int row0 = u.pm * BM + wr * 64 + fr, col0 = (u.pn & 3) * BM + wc * 32 + 8 * fq;
#pragma unroll
        for (int ai = 0; ai < 2; ++ai)
#pragma unroll
            for (int m = 0; m < 4; ++m) { const int row = row0 + ai * HALF + m * 16; const float gt = ROWGT[row];
#pragma unroll
                for (int bj = 0; bj < 2; ++bj) { const f32x4 v0 = acc[ai][bj][m][0] * gt, v1 = acc[ai][bj][m][1] * gt;
                    u32x4 w; w.x = cvt_pk_bf16(v0[0], v0[1]); w.y = cvt_pk_bf16(v0[2], v0[3]); w.z = cvt_pk_bf16(v1[0], v1[1]); w.w = cvt_pk_bf16(v1[2], v1[3]);
                    *(u32x4*)(Y + (size_t)row * 1024 + col0 + bj * HALF) = w; } }
    }
};
struct MoeOrder {
    const int* tile_e; int ntiles, G, c;
    __device__ __forceinline__ bool next(int i, Unit& u) const {
        const int L = i * G + c; if (L >= ntiles * 4) return false;
        u.pm = L >> 2; const int e = __builtin_amdgcn_readfirstlane(tile_e[u.pm]); u.pn = e * 4 + (L & 3); return true;
    }
    __device__ __forceinline__ void a_ready(const Unit&) const {}
    __device__ __forceinline__ void done(const Unit&) const {}
};
template <class Epi, class Sched, bool ALIGN_EPI = false, bool SP2 = false>
__device__ __forceinline__ void gemm_phase(PG8_LAS unsigned char* lds, const Gemm g, const Sched& S, const Epi& E) {
    const int tid = threadIdx.x, wid = __builtin_amdgcn_readfirstlane(tid >> 6), lane = tid & 63, wr = wid >> 2, wc = wid & 3, fr = lane & 15, fq = lane >> 4;
    const int K = g.K, nt = K / BK;
    unsigned voffA[2], voffB[2];
#pragma unroll
    for (int i = 0; i < 2; ++i) { int R, C; stage_rc(tid * 16 + i * 8192, R, C); const int Rb = Epi::PERM ? ((R & ~31) + perm32(R & 31)) : R;
        voffA[i] = (unsigned)(R * K + C) * 2u; voffB[i] = (unsigned)(Rb * K + C) * 2u; }
    const size_t kstep = (size_t)(BK * 2);
    const size_t hstep = (size_t)HALF * K * 2;
    const size_t tstep = 2 * hstep;
    const unsigned ldsw = (unsigned)wid * 1024u;
    const int aoff = lds_byte(wr * 64 + fr, fq * 8), boff = lds_byte(wc * 32 + fr, fq * 8);
#define PG8_SA(b, h) (((b) * 2 + (h)) * HTB)
#define PG8_SB(b, h) ((4 + (b) * 2 + (h)) * HTB)
#define PG8_STAGE(bufoff, gbase, voff) do { _Pragma("unroll") for (int _i = 0; _i < 2; ++_i) \
        __builtin_amdgcn_global_load_lds((const unsigned*)((const char*)(gbase) + (voff)[_i]), (PG8_LAS unsigned*)(lds + (bufoff) + ldsw + _i * 8192), 16, 0, 0); } while (0)
#define PG8_LDA(dst, b, h) do { _Pragma("unroll") for (int m = 0; m < 4; ++m) _Pragma("unroll") for (int k = 0; k < 2; ++k) dst[m][k] = *(const PG8_LAS bf16x8*)(lds + PG8_SA(b, h) + aoff + m * 2048 + k * 1024); } while (0)
#define PG8_LDB(dst, b, h) do { _Pragma("unroll") for (int n = 0; n < 2; ++n) _Pragma("unroll") for (int k = 0; k < 2; ++k) dst[n][k] = *(const PG8_LAS bf16x8*)(lds + PG8_SB(b, h) + boff + n * 2048 + k * 1024); } while (0)
#define PG8_MMA(ai, bj, At, Bt) do { __builtin_amdgcn_s_setprio(1); _Pragma("unroll") for (int m = 0; m < 4; ++m) _Pragma("unroll") for (int n = 0; n < 2; ++n) _Pragma("unroll") for (int k = 0; k < 2; ++k) \
        acc[ai][bj][m][n] = __builtin_amdgcn_mfma_f32_16x16x32_bf16(Bt[n][k], At[m][k], acc[ai][bj][m][n], 0, 0, 0); __builtin_amdgcn_s_setprio(0); } while (0)
#define PG8_WAIT_V(n) asm volatile("s_waitcnt vmcnt(" #n ")" ::: "memory")
#define PG8_WAIT_L(n) asm volatile("s_waitcnt lgkmcnt(" #n ")" ::: "memory")
#define PG8_BAR __builtin_amdgcn_s_barrier()
#define PG8_SCHED __builtin_amdgcn_sched_barrier(0)
    Unit cur, nxt; int ui = 0;
    if (!S.next(0, cur)) return;
    f32x4 acc[2][2][4][2];
#pragma unroll
    for (int a = 0; a < 2; ++a)
#pragma unroll
        for (int b = 0; b < 2; ++b)
#pragma unroll
            for (int m = 0; m < 4; ++m)
#pragma unroll
                for (int n = 0; n < 2; ++n) acc[a][b][m][n] = (f32x4){0.f, 0.f, 0.f, 0.f};
    bf16x8 At[4][2], B0[2][2], B1[2][2];
    const char* cA = (const char*)g.A + (size_t)cur.pm * tstep; const char* cB = (const char*)g.Bt + (size_t)cur.pn * tstep;
    S.a_ready(cur);
    if constexpr (SP2) {
        PG8_STAGE(PG8_SB(0, 0), cB, voffB); PG8_STAGE(PG8_SB(0, 1), cB + hstep, voffB); PG8_STAGE(PG8_SA(0, 0), cA, voffA); PG8_STAGE(PG8_SA(0, 1), cA + hstep, voffA);
        if (wr == 1) PG8_BAR;
        PG8_WAIT_V(2); PG8_BAR;
        PG8_STAGE(PG8_SB(1, 0), cB + kstep, voffB); PG8_STAGE(PG8_SA(1, 0), cA + kstep, voffA); PG8_STAGE(PG8_SB(1, 1), cB + hstep + kstep, voffB);
        PG8_WAIT_V(6); PG8_BAR;
    } else {
        PG8_STAGE(PG8_SB(0, 0), cB, voffB); PG8_STAGE(PG8_SA(0, 0), cA, voffA); PG8_STAGE(PG8_SB(0, 1), cB + hstep, voffB); PG8_STAGE(PG8_SA(0, 1), cA + hstep, voffA);
        if (wr == 1) PG8_BAR;
        PG8_WAIT_V(4); PG8_BAR;
        PG8_STAGE(PG8_SB(1, 0), cB + kstep, voffB); PG8_STAGE(PG8_SA(1, 0), cA + kstep, voffA); PG8_STAGE(PG8_SB(1, 1), cB + hstep + kstep, voffB);
        PG8_WAIT_V(6); PG8_BAR;
    }
    for (;;) {
        const bool has_next = S.next(ui + 1, nxt);
        const char* nA = has_next ? (const char*)g.A + (size_t)nxt.pm * tstep : cA; const char* nB = has_next ? (const char*)g.Bt + (size_t)nxt.pn * tstep : cB;
        for (int t = 0; t < nt; t += 2) {
            if constexpr (Epi::MIDK) { if (t == (nt >> 1)) E.midk(acc, cur, wr, wc, fr, fq); }
            const bool last = (t == nt - 2);
            const char* a1 = cA + (size_t)(t + 1) * kstep;
            const char* a2 = last ? nA : cA + (size_t)(t + 2) * kstep; const char* b2 = last ? nB : cB + (size_t)(t + 2) * kstep;
            const char* a3 = a2 + kstep; const char* b3 = b2 + kstep;
            if (last && has_next) S.a_ready(nxt);
            if constexpr (SP2) {
            PG8_LDB(B0, 0, 0); PG8_LDB(B1, 0, 1); PG8_SCHED; PG8_LDA(At, 0, 0); PG8_STAGE(PG8_SA(1, 1), a1 + hstep, voffA);
            PG8_WAIT_V(8); PG8_WAIT_L(0); PG8_BAR; PG8_MMA(0, 0, At, B0); PG8_MMA(0, 1, At, B1); PG8_BAR; PG8_SCHED;
            PG8_LDA(At, 0, 1); PG8_STAGE(PG8_SB(0, 0), b2, voffB); PG8_STAGE(PG8_SB(0, 1), b2 + hstep, voffB); PG8_STAGE(PG8_SA(0, 0), a2, voffA);
            PG8_WAIT_V(8); PG8_WAIT_L(0); PG8_BAR; PG8_MMA(1, 0, At, B0); PG8_MMA(1, 1, At, B1); PG8_BAR; PG8_SCHED;
            PG8_LDB(B0, 1, 0); PG8_LDB(B1, 1, 1); PG8_SCHED; PG8_LDA(At, 1, 0); PG8_STAGE(PG8_SA(0, 1), a2 + hstep, voffA);
            PG8_WAIT_V(8); PG8_WAIT_L(0); PG8_BAR; PG8_MMA(0, 0, At, B0); PG8_MMA(0, 1, At, B1); PG8_BAR; PG8_SCHED;
            PG8_LDA(At, 1, 1); PG8_STAGE(PG8_SB(1, 0), b3, voffB); PG8_STAGE(PG8_SB(1, 1), b3 + hstep, voffB); PG8_STAGE(PG8_SA(1, 0), a3, voffA);
            PG8_WAIT_V(8); PG8_WAIT_L(0); PG8_BAR; PG8_MMA(1, 0, At, B0); PG8_MMA(1, 1, At, B1); PG8_BAR; PG8_SCHED;
            } else {
            PG8_LDB(B0, 0, 0); PG8_SCHED; PG8_LDA(At, 0, 0); PG8_STAGE(PG8_SA(1, 1), a1 + hstep, voffA);
            PG8_WAIT_L(8); PG8_BAR; PG8_WAIT_L(0); PG8_MMA(0, 0, At, B0); PG8_BAR; PG8_SCHED;
            PG8_LDB(B1, 0, 1); PG8_STAGE(PG8_SB(0, 0), b2, voffB);
            PG8_BAR; PG8_WAIT_L(0); PG8_MMA(0, 1, At, B1); PG8_BAR;
            PG8_LDA(At, 0, 1); PG8_STAGE(PG8_SA(0, 0), a2, voffA);
            PG8_BAR; PG8_WAIT_L(0); PG8_MMA(1, 0, At, B0); PG8_BAR; PG8_SCHED;
            PG8_STAGE(PG8_SB(0, 1), b2 + hstep, voffB);
            PG8_WAIT_V(6); PG8_BAR; PG8_MMA(1, 1, At, B1); PG8_BAR;
            PG8_LDB(B0, 1, 0); PG8_SCHED; PG8_LDA(At, 1, 0); PG8_STAGE(PG8_SA(0, 1), a2 + hstep, voffA);
            PG8_WAIT_L(8); PG8_BAR; PG8_WAIT_L(0); PG8_MMA(0, 0, At, B0); PG8_BAR; PG8_SCHED;
            PG8_LDB(B1, 1, 1); PG8_STAGE(PG8_SB(1, 0), b3, voffB);
            PG8_BAR; PG8_WAIT_L(0); PG8_MMA(0, 1, At, B1); PG8_BAR;
            PG8_LDA(At, 1, 1); PG8_STAGE(PG8_SA(1, 0), a3, voffA);
            PG8_BAR; PG8_WAIT_L(0); PG8_MMA(1, 0, At, B0); PG8_BAR; PG8_SCHED;
            PG8_STAGE(PG8_SB(1, 1), b3 + hstep, voffB);
            PG8_WAIT_V(6); PG8_BAR; PG8_MMA(1, 1, At, B1); PG8_BAR;
            }
        }
        if constexpr (ALIGN_EPI) { if (wr == 0) PG8_BAR; }
        if constexpr (!Epi::AFTER_DRAIN) { E(acc, cur, wr, wc, fr, fq); S.done(cur); }
        if (!has_next) break;
#pragma unroll
        for (int a = 0; a < 2; ++a)
#pragma unroll
            for (int b = 0; b < 2; ++b)
#pragma unroll
                for (int m = 0; m < 4; ++m)
#pragma unroll
                    for (int n = 0; n < 2; ++n) acc[a][b][m][n] = (f32x4){0.f, 0.f, 0.f, 0.f};
        cur = nxt; cA = nA; cB = nB; ++ui;
        if constexpr (ALIGN_EPI) { if (wr == 1) PG8_BAR; }
    }
    PG8_WAIT_V(0);
    if constexpr (!ALIGN_EPI) { if (wr == 0) PG8_BAR; }
    PG8_BAR;
    if constexpr (Epi::AFTER_DRAIN) { E.fused(acc, cur, wr, wc, fr, fq, lds, wid, lane); S.done(cur); }
#undef PG8_SA
#undef PG8_SB
#undef PG8_STAGE
#undef PG8_LDA
#undef PG8_LDB
#undef PG8_MMA
#undef PG8_WAIT_V
#undef PG8_WAIT_L
#undef PG8_BAR
#undef PG8_SCHED
}
}
using pg8::bf16_t;
constexpr size_t MiB = 1u << 20, KiB = 1u << 10;
constexpr size_t WS_CTL = 0, CTL_ZERO_BYTES = 1 * MiB;
constexpr size_t WS_SMALL = 1 * MiB;
constexpr size_t WS_WTIN = 4 * MiB, WS_WTOUT = 8 * MiB, WS_WTGLU = 10 * MiB, WS_WR = 10 * MiB + 512 * KiB, WS_WTGU = 11 * MiB, WS_WTD = 75 * MiB;
constexpr size_t WS_R1 = 107 * MiB;
constexpr size_t WS_BIG = 139 * MiB;
constexpr size_t WS_Q = WS_BIG, WS_K = WS_BIG + 16 * MiB, WS_V = WS_BIG + 32 * MiB, WS_U = WS_BIG + 48 * MiB, WS_O1 = WS_BIG + 64 * MiB, WS_O2 = WS_BIG + 80 * MiB, WS_YG = WS_BIG + 96 * MiB;
constexpr size_t WS_ROWS = WS_BIG, WS_HID = WS_BIG + 80 * MiB;
constexpr size_t WS_END = WS_BIG + 120 * MiB;
static_assert((size_t)MAXROWS * 1024 * 2 == 80 * MiB && (size_t)MAXROWS * 512 * 2 == 40 * MiB, "moe buffers");
constexpr size_t SM_SSQP = 0, SM_RINV = 512 * KiB, SM_EID = 576 * KiB, SM_GATE = 704 * KiB, SM_DEST = 832 * KiB, SM_LRANK = 960 * KiB, SM_TOKROW = 1088 * KiB,
                 SM_ROWSC = 1248 * KiB, SM_ROWGT = 1408 * KiB, SM_TILEE = 1568 * KiB, SM_CNT = 1572 * KiB, SM_META = 1604 * KiB;
constexpr int CW_BAR = 4096;

constexpr int RING_BYTES = 131072, LDSCTL_OFF = RING_BYTES, MISC_OFF = LDSCTL_OFF + 320, LDS_BYTES = 156672;

#define GAS __attribute__((address_space(1)))
#define LAS __attribute__((address_space(3)))
typedef unsigned v4u __attribute__((ext_vector_type(4)));
typedef unsigned v2u __attribute__((ext_vector_type(2)));
typedef float f32x4 __attribute__((ext_vector_type(4)));
typedef short bf16x8 __attribute__((ext_vector_type(8)));
#define LDS_WAIT() asm volatile("s_waitcnt lgkmcnt(0)" ::: "memory")
#define VM_WAIT() asm volatile("s_waitcnt vmcnt(0)" ::: "memory")
__device__ __forceinline__ unsigned f2bf(float f) { unsigned u = __builtin_bit_cast(unsigned, f); return (u + 0x7fffu + ((u >> 16) & 1u)) >> 16; }
__device__ __forceinline__ unsigned pk2(float lo, float hi) { return f2bf(lo) | (f2bf(hi) << 16); }
__device__ __forceinline__ float bf2f(unsigned short h) { return __uint_as_float(((unsigned)h) << 16); }
__device__ __forceinline__ float wave_sum(float v) {
#pragma unroll
    for (int o = 1; o < 64; o <<= 1) v += __shfl_xor(v, o);
    return v;
}
__device__ __forceinline__ float wave_max(float v) {
#pragma unroll
    for (int o = 1; o < 64; o <<= 1) v = fmaxf(v, __shfl_xor(v, o));
    return v;
}
#define XB_TMO      128
#define XB_XCNT(j)  (256  + 64 * (j))
#define XB_XSUB(j)  (1280 + 64 * (j))
#define XB_XGEN(j)  (2304 + 64 * (j))
#define XB_TOP      3328
#define XB_TOPGEN   3392
#define XCD_BAR_WORDS 3456
#define XB_SPIN_CAP (1u << 18)

__device__ __forceinline__ unsigned xb_ld(unsigned* p)              { return __hip_atomic_load(p, __ATOMIC_RELAXED, __HIP_MEMORY_SCOPE_AGENT); }
__device__ __forceinline__ unsigned xb_add(unsigned* p, unsigned v) { return __hip_atomic_fetch_add(p, v, __ATOMIC_RELAXED, __HIP_MEMORY_SCOPE_AGENT); }
__device__ __forceinline__ unsigned xb_xcc_id() { return (unsigned)__builtin_amdgcn_s_getreg((3 << 11) | 20) & 0xFu; }
#define XB_SPIN(cond, bar) do { unsigned _sp = 0; while (cond) { __builtin_amdgcn_s_sleep(1); \
    if ((++_sp & 255u) == 0u) { if (xb_ld(&(bar)[XB_TMO])) break; if (_sp > XB_SPIN_CAP) { atomicAdd(&(bar)[XB_TMO], 1u); break; } } } } while (0)

struct XcdBarrier {
    unsigned* bar; unsigned x;
    volatile LAS unsigned* st;
};

__device__ __forceinline__ XcdBarrier xcd_barrier_post(unsigned* bar, volatile LAS unsigned* st) {
    XcdBarrier b; b.bar = bar; b.x = xb_xcc_id(); b.st = st;
    if (threadIdx.x == 0) (void)xb_add(&bar[XB_XCNT(b.x)], 1u);
    return b;
}
__device__ __forceinline__ void xcd_barrier_complete(unsigned* bar, unsigned x, unsigned& nloc, unsigned& nx) {
    const unsigned G = gridDim.x * gridDim.y * gridDim.z;
    unsigned sum, cnt, mine, sp = 0u;
    for (;;) {
        sum = 0u; cnt = 0u; mine = 0u;
#pragma unroll
        for (unsigned j = 0; j < 16; ++j) { const unsigned c = xb_ld(&bar[XB_XCNT(j)]); sum += c; cnt += (c > 0u) ? 1u : 0u; mine = (j == x) ? c : mine; }
        if (sum == G) break;
        __builtin_amdgcn_s_sleep(1);
        if ((++sp & 255u) == 0u) { if (xb_ld(&bar[XB_TMO])) break; if (sp > XB_SPIN_CAP) { atomicAdd(&bar[XB_TMO], 1u); break; } }
    }
    nloc = mine > 0u ? mine : 1u; nx = cnt > 0u ? cnt : 1u;
}

__device__ __forceinline__ void xcd_barrier(const XcdBarrier& b) {
    asm volatile("s_waitcnt vmcnt(0)" ::: "memory");
    __syncthreads();
    if (threadIdx.x == 0) {
        unsigned* bar = b.bar;
        __builtin_amdgcn_s_waitcnt(0);
        unsigned nloc = b.st[0], nx = b.st[1];
        if (nloc == 0u) { xcd_barrier_complete(bar, b.x, nloc, nx); b.st[0] = nloc; b.st[1] = nx; }
        const unsigned old = xb_add(&bar[XB_XSUB(b.x)], 1u);
        const unsigned gen = old / nloc;
        if (old + 1u == (gen + 1u) * nloc) {
            __builtin_amdgcn_fence(__ATOMIC_RELEASE, "agent");
            asm volatile("s_waitcnt vmcnt(0)" ::: "memory");
            const unsigned og = xb_add(&bar[XB_TOP], 1u);
            const unsigned tg = og / nx;
            if (og + 1u == (tg + 1u) * nx) xb_add(&bar[XB_TOPGEN], 1u);
            else XB_SPIN(xb_ld(&bar[XB_TOPGEN]) == tg, bar);
            __builtin_amdgcn_fence(__ATOMIC_ACQUIRE, "agent");
            xb_add(&bar[XB_XGEN(b.x)], 1u);
            asm volatile("s_waitcnt vmcnt(0)" ::: "memory");
        } else {
            XB_SPIN(xb_ld(&bar[XB_XGEN(b.x)]) == gen, bar);
            __builtin_amdgcn_fence(__ATOMIC_ACQUIRE, "agent");
            asm volatile("s_waitcnt vmcnt(0)" ::: "memory");
        }
    }
    __syncthreads();
}

struct Args { const float* in[29]; float* out; unsigned char* ws; int ph_lo, ph_hi, bar_region, pad; };
typedef const __attribute__((address_space(4))) Args* KArgs;
enum { IN_X = 0, IN_NORM_ATTN, IN_W_IN, IN_LQ1, IN_LK1, IN_LQ2, IN_LK2, IN_SUBLN, IN_LAM_RE, IN_LAM_IM, IN_LOG_DT, IN_B_RE, IN_B_IM, IN_C_RE, IN_C_IM, IN_SSM_D,
       IN_W_GLU, IN_B_GLU, IN_SSM_NORM, IN_W_OUT, IN_NORM_MOE, IN_WRG, IN_BRG, IN_WRE, IN_BRE, IN_W_GATE, IN_W_UP, IN_W_DOWN, IN_NORM_FINAL };

__device__ __forceinline__ void tr_item(const float* __restrict__ W, int ldw, int ks0, int ns0, bf16_t* WT, int ldt, int rd0, int kd0, const float* kscale, LAS float* scr, int lane) {
#pragma unroll 8
    for (int i = 0; i < 32; ++i) { const int kk = 2 * i + (lane >> 5); float v = W[(size_t)(ks0 + kk) * ldw + ns0 + (lane & 31)]; if (kscale) v *= kscale[kk]; scr[kk * 33 + (lane & 31)] = v; }
    LDS_WAIT(); asm volatile("" ::: "memory");
    const int c = lane & 7;
#pragma unroll
    for (int j = 0; j < 4; ++j) { const int n = (lane >> 3) + 8 * j; const LAS float* s = scr + (8 * c) * 33 + n;
        v4u o; o.x = pk2(s[0 * 33], s[1 * 33]); o.y = pk2(s[2 * 33], s[3 * 33]); o.z = pk2(s[4 * 33], s[5 * 33]); o.w = pk2(s[6 * 33], s[7 * 33]);
        *(GAS v4u*)(WT + (size_t)(rd0 + n) * ldt + kd0 + 8 * c) = o; }
    LDS_WAIT(); asm volatile("" ::: "memory");
}
__device__ __forceinline__ void phase0(KArgs a, LAS unsigned char* lds, int, int, int vcu, int G) {
    int tid_ = threadIdx.x; asm volatile("" : "+v"(tid_)); const int lane = tid_ & 63, wave = __builtin_amdgcn_readfirstlane(tid_ >> 6);
    LAS float* scr = (LAS float*)(lds + wave * 16384);
    const int gw = vcu * 8 + wave, NGW = G * 8;
    unsigned char* ws = a->ws;
    bf16_t* WT_in = (bf16_t*)(ws + WS_WTIN); bf16_t* WT_out = (bf16_t*)(ws + WS_WTOUT); bf16_t* WT_glu = (bf16_t*)(ws + WS_WTGLU);
    bf16_t* WT_gu = (bf16_t*)(ws + WS_WTGU); bf16_t* WT_d = (bf16_t*)(ws + WS_WTD);
    constexpr int I_IN = 16 * 64, I_OUT = 16 * 32, I_GLU = 8 * 16, I_E = 768, NITEMS = I_IN + I_OUT + I_GLU + NE * I_E;
    for (int it = gw; it < NITEMS; it += NGW) {
        int r = it;
        if (r < I_IN) { const int kb = r >> 6, nb = r & 63; tr_item(a->in[IN_W_IN], IN_COLS, 64 * kb, 32 * nb, WT_in, 1024, 32 * nb, 64 * kb, nullptr, scr, lane); continue; } r -= I_IN;
        if (r < I_OUT) { const int kb = r >> 5, nb = r & 31, ks0 = 64 * kb;
            tr_item(a->in[IN_W_OUT], 1024, ks0, 32 * nb, WT_out, 1024, 32 * nb, (ks0 + 512) & 1023, ks0 >= 512 ? a->in[IN_SSM_NORM] + (ks0 - 512) : nullptr, scr, lane); continue; } r -= I_OUT;
        if (r < I_GLU) { const int kb = r >> 4, nb = r & 15; tr_item(a->in[IN_W_GLU], 512, 64 * kb, 32 * nb, WT_glu, 512, 32 * nb, 64 * kb, nullptr, scr, lane); continue; } r -= I_GLU;
        const int e = r / I_E; r -= e * I_E;
        if (r < 512) { const int up = r >> 8; r &= 255; const int kb = r >> 4, nb = r & 15, n0 = 32 * nb;
            tr_item(a->in[up ? IN_W_UP : IN_W_GATE] + (size_t)e * 1024 * 512, 512, 64 * kb, n0, WT_gu, 1024, e * 1024 + (n0 >> 7) * 256 + up * 128 + (n0 & 127), 64 * kb, nullptr, scr, lane); continue; }
        r -= 512; { const int kb = r >> 5, nb = r & 31; tr_item(a->in[IN_W_DOWN] + (size_t)e * 512 * 1024, 1024, 64 * kb, 32 * nb, WT_d, 512, e * 1024 + 32 * nb, 64 * kb, nullptr, scr, lane); }
    }
    { const float* x = a->in[IN_X]; const float* g = a->in[IN_NORM_ATTN]; bf16_t* XN = (bf16_t*)(ws + WS_R1);
      f32x4 gv[4];
#pragma unroll
      for (int j = 0; j < 4; ++j) gv[j] = *(const f32x4*)(g + 4 * lane + 256 * j);
      for (int m = gw; m < T_TOK; m += NGW) {
        const GAS f32x4* xr = (const GAS f32x4*)(x + (size_t)m * D_MODEL) + lane;
        f32x4 v[4]; float s = 0.f;
#pragma unroll
        for (int j = 0; j < 4; ++j) { v[j] = xr[64 * j]; s += (v[j].x * v[j].x + v[j].y * v[j].y) + (v[j].z * v[j].z + v[j].w * v[j].w); }
        const float rstd = 1.f / sqrtf(wave_sum(s) * (1.f / D_MODEL) + RMS_EPS);
        GAS v2u* o8 = (GAS v2u*)(XN + (size_t)m * D_MODEL) + lane;
#pragma unroll
        for (int j = 0; j < 4; ++j) { v2u o; o.x = pk2(v[j].x * rstd * gv[j].x, v[j].y * rstd * gv[j].y); o.y = pk2(v[j].z * rstd * gv[j].z, v[j].w * rstd * gv[j].w); o8[64 * j] = o; }
      } }
    { bf16_t* WRhi = (bf16_t*)(ws + WS_WR); bf16_t* WRlo = WRhi + 48 * 1024;
      for (int i = gw * 64 + lane; i < 48 * 1024; i += NGW * 64) { const int c = i >> 10, k = i & 1023;
        const float w = c < 4 ? a->in[IN_WRG][k * 4 + c] : (c < 36 ? a->in[IN_WRE][k * 32 + (c - 4)] : 0.f);
        const unsigned hi = f2bf(w); WRhi[i] = (bf16_t)hi; WRlo[i] = (bf16_t)f2bf(w - bf2f((unsigned short)hi)); } }
}

__device__ __forceinline__ void phase5(KArgs a, LAS unsigned char* lds, int, int, int, int vcu, int G) {
    int tid_ = threadIdx.x; asm volatile("" : "+v"(tid_)); const int lane = tid_ & 63, wave = __builtin_amdgcn_readfirstlane(tid_ >> 6); const int tid = tid_;
    unsigned char* ws = a->ws;
    const float* x1 = a->out; const float* g2 = a->in[IN_NORM_MOE];
    bf16_t* H2 = (bf16_t*)(ws + WS_R1);
    const bf16_t* WRhi = (const bf16_t*)(ws + WS_WR); const bf16_t* WRlo = WRhi + 48 * 1024;
    float* RINV = (float*)(ws + WS_SMALL + SM_RINV); int* EID = (int*)(ws + WS_SMALL + SM_EID); float* GATE = (float*)(ws + WS_SMALL + SM_GATE);
    int* LRANK = (int*)(ws + WS_SMALL + SM_LRANK); int* CNT = (int*)(ws + WS_SMALL + SM_CNT);
    LAS float* PL = (LAS float*)lds;
    LAS float* PS = PL + 2 * 4 * 16 * 49;
    LAS int* EL = (LAS int*)(PS + 2 * 4 * 16);
    const int tg = wave & 3, kh = wave >> 2, r16 = lane & 15, kq = lane >> 4;
    for (int wgi = vcu; wgi < T_TOK / 64; wgi += G) {
        const int row = 64 * wgi + 16 * tg + r16;
        f32x4 acc[3]; acc[0] = acc[1] = acc[2] = (f32x4){0.f, 0.f, 0.f, 0.f};
        float ssq = 0.f;
#pragma unroll 4
        for (int ks = 0; ks < 16; ++ks) {
            const int k0 = kh * 512 + ks * 32 + kq * 8;
            const f32x4 xa = *(const f32x4*)(x1 + (size_t)row * D_MODEL + k0), xb = *(const f32x4*)(x1 + (size_t)row * D_MODEL + k0 + 4);
            const f32x4 ga = *(const f32x4*)(g2 + k0), gb = *(const f32x4*)(g2 + k0 + 4);
            ssq += (xa.x * xa.x + xa.y * xa.y) + (xa.z * xa.z + xa.w * xa.w) + (xb.x * xb.x + xb.y * xb.y) + (xb.z * xb.z + xb.w * xb.w);
            float v[8] = {xa.x * ga.x, xa.y * ga.y, xa.z * ga.z, xa.w * ga.w, xb.x * gb.x, xb.y * gb.y, xb.z * gb.z, xb.w * gb.w};
            unsigned hi[8], lo[8];
#pragma unroll
            for (int i = 0; i < 8; ++i) { hi[i] = f2bf(v[i]); lo[i] = f2bf(v[i] - __uint_as_float(hi[i] << 16)); }
            v4u hw, lw;
            hw.x = hi[0] | (hi[1] << 16); hw.y = hi[2] | (hi[3] << 16); hw.z = hi[4] | (hi[5] << 16); hw.w = hi[6] | (hi[7] << 16);
            lw.x = lo[0] | (lo[1] << 16); lw.y = lo[2] | (lo[3] << 16); lw.z = lo[4] | (lo[5] << 16); lw.w = lo[6] | (lo[7] << 16);
            *(v4u*)(H2 + (size_t)row * D_MODEL + k0) = hw;
            const bf16x8 ahi = __builtin_bit_cast(bf16x8, hw), alo = __builtin_bit_cast(bf16x8, lw);
#pragma unroll
            for (int nt = 0; nt < 3; ++nt) {
                const bf16x8 bh = *(const bf16x8*)(WRhi + (size_t)(nt * 16 + r16) * 1024 + k0), bl = *(const bf16x8*)(WRlo + (size_t)(nt * 16 + r16) * 1024 + k0);
                acc[nt] = __builtin_amdgcn_mfma_f32_16x16x32_bf16(ahi, bh, acc[nt], 0, 0, 0);
                acc[nt] = __builtin_amdgcn_mfma_f32_16x16x32_bf16(ahi, bl, acc[nt], 0, 0, 0);
                acc[nt] = __builtin_amdgcn_mfma_f32_16x16x32_bf16(alo, bh, acc[nt], 0, 0, 0);
            }
        }
        ssq += __shfl_xor(ssq, 16); ssq += __shfl_xor(ssq, 32);
        __syncthreads();
#pragma unroll
        for (int nt = 0; nt < 3; ++nt)
#pragma unroll
            for (int rg = 0; rg < 4; ++rg) PL[((kh * 4 + tg) * 16 + 4 * kq + rg) * 49 + nt * 16 + r16] = acc[nt][rg];
        if (kq == 0) PS[(kh * 4 + tg) * 16 + r16] = ssq;
        __syncthreads();
        if (wave < 4 && lane < 16) {
            const int tl = lane, tok = 64 * wgi + 16 * tg + tl;
            const float ss = PS[(0 * 4 + tg) * 16 + tl] + PS[(1 * 4 + tg) * 16 + tl];
            const float rinv = 1.0f / sqrtf(ss * (1.0f / D_MODEL) + RMS_EPS);
            const LAS float* p0 = PL + ((0 * 4 + tg) * 16 + tl) * 49; const LAS float* p1 = PL + ((1 * 4 + tg) * 16 + tl) * 49;
            float gl[NEG]; float gm = -INFINITY; int gs = 0;
#pragma unroll
            for (int i = 0; i < NEG; ++i) { gl[i] = rinv * (p0[i] + p1[i]) + a->in[IN_BRG][i]; if (gl[i] > gm) { gm = gl[i]; gs = i; } }
            float gsum = 0.f;
#pragma unroll
            for (int i = 0; i < NEG; ++i) gsum += expf(gl[i] - gm);
            const float pg = 1.0f / gsum;
            float el[EPG]; float em = -INFINITY;
#pragma unroll
            for (int i = 0; i < EPG; ++i) { const int c = 4 + gs * EPG + i; el[i] = rinv * (p0[c] + p1[c]) + a->in[IN_BRE][gs * EPG + i]; em = fmaxf(em, el[i]); }
            float esum = 0.f;
#pragma unroll
            for (int i = 0; i < EPG; ++i) esum += expf(el[i] - em);
            int i0 = 0;
#pragma unroll
            for (int i = 1; i < EPG; ++i) if (el[i] > el[i0]) i0 = i;
            int i1 = (i0 == 0) ? 1 : 0;
#pragma unroll
            for (int i = 0; i < EPG; ++i) if (i != i0 && el[i] > el[i1]) i1 = i;
            float e0v = 0.f, e1v = 0.f;
#pragma unroll
            for (int i = 0; i < EPG; ++i) { if (i == i0) e0v = el[i]; if (i == i1) e1v = el[i]; }
            const int ea = gs * EPG + i0, eb = gs * EPG + i1;
            EID[tok * 2] = ea; EID[tok * 2 + 1] = eb;
            GATE[tok * 2] = pg * expf(e0v - em) / esum; GATE[tok * 2 + 1] = pg * expf(e1v - em) / esum;
            RINV[tok] = rinv;
            EL[(16 * tg + tl) * 2] = ea; EL[(16 * tg + tl) * 2 + 1] = eb;
        }
        __syncthreads();
        if (tid < 128) { const int e = EL[tid]; int rk = 0; for (int j = 0; j < tid; ++j) rk += (EL[j] == e) ? 1 : 0; LRANK[wgi * 128 + tid] = rk; }
        else if (tid < 160) { const int e = tid - 128; int c = 0; for (int j = 0; j < 128; ++j) c += (EL[j] == e) ? 1 : 0; CNT[wgi * 32 + e] = c; }
    }
    __syncthreads();
}

__device__ __forceinline__ void phase6(KArgs a, LAS unsigned char* lds, int, int, int, int vcu, int G) {
    int tid_ = threadIdx.x; asm volatile("" : "+v"(tid_)); const int lane = tid_ & 63, wave = __builtin_amdgcn_readfirstlane(tid_ >> 6); const int tid = tid_;
    unsigned char* ws = a->ws;
    const bf16_t* H2 = (const bf16_t*)(ws + WS_R1); bf16_t* ROWS = (bf16_t*)(ws + WS_ROWS);
    const float* RINV = (const float*)(ws + WS_SMALL + SM_RINV); const int* EID = (const int*)(ws + WS_SMALL + SM_EID); const float* GATE = (const float*)(ws + WS_SMALL + SM_GATE);
    const int* LRANK = (const int*)(ws + WS_SMALL + SM_LRANK); const int* CNT = (const int*)(ws + WS_SMALL + SM_CNT);
    int* DEST = (int*)(ws + WS_SMALL + SM_DEST); int* TOKROW = (int*)(ws + WS_SMALL + SM_TOKROW); float* ROWSC = (float*)(ws + WS_SMALL + SM_ROWSC); float* ROWGT = (float*)(ws + WS_SMALL + SM_ROWGT);
    int* TILEE = (int*)(ws + WS_SMALL + SM_TILEE); int* META = (int*)(ws + WS_SMALL + SM_META);
    LAS int* totS = (LAS int*)lds; LAS int* preS = totS + 32; LAS int* pstS = preS + 32; LAS int* dstS = pstS + 32;
    for (int wgi = vcu; wgi < T_TOK / 64; wgi += G) {
        __syncthreads();
        if (tid < 32) { int tot = 0, pre = 0; for (int w = 0; w < T_TOK / 64; ++w) { const int c = CNT[w * 32 + tid]; tot += c; pre += (w < wgi) ? c : 0; } totS[tid] = tot; preS[tid] = pre; }
        __syncthreads();
        if (tid == 0) { int run = 0; for (int e = 0; e < NE; ++e) { pstS[e] = run; run += ((totS[e] + 255) >> 8) << 8; }
            if (wgi == 0) { META[0] = run >> 8; for (int e = 0; e < NE; ++e) { const int t0 = pstS[e] >> 8, nt = (totS[e] + 255) >> 8; for (int j = 0; j < nt; ++j) TILEE[t0 + j] = e; } } }
        __syncthreads();
        if (tid < 128) { const int tok = 64 * wgi + (tid >> 1); const int e = EID[wgi * 128 + tid]; const int dest = pstS[e] + preS[e] + LRANK[wgi * 128 + tid];
            TOKROW[dest] = tok; ROWSC[dest] = RINV[tok]; ROWGT[dest] = GATE[wgi * 128 + tid]; DEST[wgi * 128 + tid] = dest; dstS[tid] = dest; }
        if (wgi == 0) { for (int e = 0; e < NE; ++e) { const int lo = pstS[e] + totS[e], hi = pstS[e] + (((totS[e] + 255) >> 8) << 8); for (int r = lo + tid; r < hi; r += 512) { TOKROW[r] = -1; ROWSC[r] = 0.f; ROWGT[r] = 0.f; } } }
        __syncthreads();
        for (int as = wave; as < 128; as += 8) { const int tok = 64 * wgi + (as >> 1), dest = dstS[as];
            const GAS v4u* src = (const GAS v4u*)(H2 + (size_t)tok * D_MODEL) + lane; GAS v4u* dst = (GAS v4u*)(ROWS + (size_t)dest * D_MODEL) + lane;
            const v4u r0 = src[0], r1 = src[64]; dst[0] = r0; dst[64] = r1; }
    }
    __syncthreads();
}

__device__ __forceinline__ void phase9(KArgs a, int, int, int vcu, int G) {
    int tid_ = threadIdx.x; asm volatile("" : "+v"(tid_)); const int lane = tid_ & 63, wave = __builtin_amdgcn_readfirstlane(tid_ >> 6);
    unsigned char* ws = a->ws; float* out = a->out; const float* gf = a->in[IN_NORM_FINAL];
    const bf16_t* Y = (const bf16_t*)(ws + WS_ROWS); const int* DEST = (const int*)(ws + WS_SMALL + SM_DEST);
    const int gw = vcu * 8 + wave, NGW = G * 8;
    f32x4 gv[4];
#pragma unroll
    for (int j = 0; j < 4; ++j) gv[j] = *(const f32x4*)(gf + 4 * lane + 256 * j);
    for (int m = gw; m < T_TOK; m += NGW) {
        const int d0 = DEST[m * 2], d1 = DEST[m * 2 + 1];
        GAS f32x4* xr = (GAS f32x4*)(out + (size_t)m * D_MODEL) + lane;
        const GAS v2u* y0 = (const GAS v2u*)(Y + (size_t)d0 * D_MODEL) + lane; const GAS v2u* y1 = (const GAS v2u*)(Y + (size_t)d1 * D_MODEL) + lane;
        f32x4 v[4]; float s = 0.f;
#pragma unroll
        for (int j = 0; j < 4; ++j) { v[j] = xr[64 * j]; const v2u p = y0[64 * j], q = y1[64 * j];
            v[j].x += pg8::bf_lo(p.x) + pg8::bf_lo(q.x); v[j].y += pg8::bf_hi(p.x) + pg8::bf_hi(q.x); v[j].z += pg8::bf_lo(p.y) + pg8::bf_lo(q.y); v[j].w += pg8::bf_hi(p.y) + pg8::bf_hi(q.y);
            s += (v[j].x * v[j].x + v[j].y * v[j].y) + (v[j].z * v[j].z + v[j].w * v[j].w); }
        const float rstd = 1.f / sqrtf(wave_sum(s) * (1.f / D_MODEL) + RMS_EPS);
#pragma unroll
        for (int j = 0; j < 4; ++j) xr[64 * j] = v[j] * rstd * gv[j];
    }
}


namespace att {
typedef float f32x16 __attribute__((ext_vector_type(16)));
typedef short s16x4 __attribute__((ext_vector_type(4)));
typedef short v4i16_t __attribute__((ext_vector_type(4)));
constexpr int KBUF = 8192, VBUF = 16384, SLOT = KBUF + VBUF, OST = 2 * SLOT, WSF = OST + 8 * 8192, ATT_LDS = WSF + 8 * 256;
constexpr float THR = 8.0f;
__device__ __forceinline__ int crow(int r, int hi) { return (r & 3) + 8 * (r >> 2) + 4 * hi; }
__device__ __forceinline__ unsigned cvtpk(float lo, float hi) { typedef float f2 __attribute__((ext_vector_type(2))); typedef __bf16 b2 __attribute__((ext_vector_type(2))); f2 v = {lo, hi}; b2 b = __builtin_convertvector(v, b2); return __builtin_bit_cast(unsigned, b); }
__device__ __forceinline__ s16x4 vtr(const LAS unsigned char* p) { return __builtin_bit_cast(s16x4, __builtin_amdgcn_ds_read_tr16_b64_v4i16((LAS v4i16_t*)p)); }
#define MX3(a, b, c) __builtin_fmaxf(__builtin_fmaxf((a), (b)), (c))
__device__ __forceinline__ float rowmax(const f32x16& p0, const f32x16& p1) {
    float a = MX3(p0[0], p0[1], p1[0]), b = MX3(p0[2], p0[3], p1[1]); a = MX3(a, p1[2], p1[3]);
#pragma unroll
    for (int r = 4; r < 16; r += 4) { a = MX3(a, p0[r], p0[r + 1]); b = MX3(b, p0[r + 2], p0[r + 3]); a = MX3(a, p1[r], p1[r + 1]); b = MX3(b, p1[r + 2], p1[r + 3]); }
    float m = __builtin_fmaxf(a, b); auto rr = __builtin_amdgcn_permlane32_swap(__float_as_uint(m), __float_as_uint(m), false, false);
    return __builtin_fmaxf(__uint_as_float(rr[0]), __uint_as_float(rr[1]));
}
#undef MX3

__device__ __forceinline__ void attn_part(int b, int h, int mp, int qb, int t_lo, int t_hi, const bf16_t* __restrict__ Q, const bf16_t* __restrict__ K, const bf16_t* __restrict__ V,
                                          bf16_t* __restrict__ PBs, float* __restrict__ MLs, LAS unsigned char* lds) {
    int tid_ = threadIdx.x; asm volatile("" : "+v"(tid_));
    const int lane = tid_ & 63, wid = __builtin_amdgcn_readfirstlane(tid_ >> 6);
    const int r32 = lane & 31, hi = lane >> 5;
    const int rowbase = b * SEQ, q0 = qb * 256, NT = t_hi - t_lo;
    const int qabs = q0 + wid * 32 + r32;
    const float slope2 = exp2f(-2.0f * (float)(h + 1)) * LOG2E;
    const bf16_t* Qw = Q + (size_t)(rowbase + q0 + wid * 32) * 512 + h * 128 + mp * 64;
    bf16x8 qr[4];
#pragma unroll
    for (int d0 = 0; d0 < 4; ++d0) qr[d0] = *(const bf16x8*)(Qw + (size_t)r32 * 512 + d0 * 16 + hi * 8);
    const bf16_t* ksrc = K + (size_t)(rowbase + lane) * 512 + h * 128 + mp * 64 + wid * 8;
    const int p0i = 2 * wid, p1i = 2 * wid + 1;
    const bf16_t* vsrc0 = V + (size_t)(rowbase + 16 * (p0i & 3) + (lane >> 2)) * 512 + h * 128 + (p0i >> 2) * 32 + (lane & 3) * 8;
    const bf16_t* vsrc1 = V + (size_t)(rowbase + 16 * (p1i & 3) + (lane >> 2)) * 512 + h * 128 + (p1i >> 2) * 32 + (lane & 3) * 8;
#define ATT_DMA(t, slot) do { const size_t go_ = (size_t)(t) * 64 * 512; LAS unsigned char* sl_ = lds + (slot) * SLOT; \
        __builtin_amdgcn_global_load_lds((const unsigned*)(ksrc + go_), (LAS unsigned*)(sl_ + wid * 1024), 16, 0, 0); \
        __builtin_amdgcn_global_load_lds((const unsigned*)(vsrc0 + go_), (LAS unsigned*)(sl_ + KBUF + p0i * 1024), 16, 0, 0); \
        __builtin_amdgcn_global_load_lds((const unsigned*)(vsrc1 + go_), (LAS unsigned*)(sl_ + KBUF + p1i * 1024), 16, 0, 0); } while (0)
    LAS float* wsf = (LAS float*)(lds + WSF) + wid * 64;
    float mref = 0.f, l_reg = 0.f; bool started = false;
    f32x16 o[4];
#pragma unroll
    for (int d = 0; d < 4; ++d) o[d] = (f32x16){};
    ATT_DMA(t_hi - 1, 0);
    VM_WAIT();
    __syncthreads();
    for (int it = 0; it < NT; ++it) {
        const int t = t_hi - 1 - it; const int slot = it & 1;
        if (it + 1 < NT) ATT_DMA(t - 1, slot ^ 1);
        const bool active = (64 * t <= q0 + 32 * wid + 31);
        if (active) {
            const LAS unsigned char* Ks = lds + slot * SLOT; const LAS unsigned char* Vs = Ks + KBUF;
            const float tb = slope2 * (float)(64 * t + 4 * hi - qabs) - (started ? mref : 0.f), tb1 = tb + 32.0f * slope2;
            f32x16 c0, c1;
#pragma unroll
            for (int r = 0; r < 16; ++r) { const float kr_ = (float)((r & 3) + 8 * (r >> 2)); c0[r] = __builtin_fmaf(slope2, kr_, tb); c1[r] = __builtin_fmaf(slope2, kr_, tb1); }
            const LAS unsigned char* kp = Ks + hi * 1024 + r32 * 16;
#pragma unroll
            for (int d0 = 0; d0 < 4; ++d0) {
                const bf16x8 k0 = *(const LAS bf16x8*)(kp + d0 * 2048), k1 = *(const LAS bf16x8*)(kp + d0 * 2048 + 512);
                c0 = __builtin_amdgcn_mfma_f32_32x32x16_bf16(k0, qr[d0], c0, 0, 0, 0);
                c1 = __builtin_amdgcn_mfma_f32_32x32x16_bf16(k1, qr[d0], c1, 0, 0, 0);
            }
            if (64 * t + 63 > q0 + 32 * wid) {
#pragma unroll
                for (int r = 0; r < 16; ++r) { const int kv = 64 * t + crow(r, hi); if (kv > qabs) c0[r] = -INFINITY; if (kv + 32 > qabs) c1[r] = -INFINITY; }
            }
            const float rm = rowmax(c0, c1);
            if (!started) {
                mref = rm;
#pragma unroll
                for (int r = 0; r < 16; ++r) { c0[r] -= rm; c1[r] -= rm; }
                started = true;
            } else if (__any(rm > THR)) {
                const float dl = __builtin_fmaxf(rm, 0.f); mref += dl;
#pragma unroll
                for (int r = 0; r < 16; ++r) { c0[r] -= dl; c1[r] -= dl; }
                const float f = __builtin_amdgcn_exp2f(-dl); l_reg *= f;
                if (hi == 0) wsf[r32] = f;
                float fr[16];
#pragma unroll
                for (int r = 0; r < 16; ++r) fr[r] = wsf[crow(r, hi)];
#pragma unroll
                for (int d = 0; d < 4; ++d)
#pragma unroll
                    for (int r = 0; r < 16; ++r) o[d][r] *= fr[r];
            }
            float sacc = 0.f;
#pragma unroll
            for (int r = 0; r < 16; ++r) { c0[r] = __builtin_amdgcn_exp2f(c0[r]); c1[r] = __builtin_amdgcn_exp2f(c1[r]); sacc += c0[r] + c1[r]; }
            l_reg += sacc;
            v4u pw[4];
#pragma unroll
            for (int i = 0; i < 4; ++i) { pw[0][i] = cvtpk(c0[2 * i], c0[2 * i + 1]); pw[1][i] = cvtpk(c0[8 + 2 * i], c0[8 + 2 * i + 1]); pw[2][i] = cvtpk(c1[2 * i], c1[2 * i + 1]); pw[3][i] = cvtpk(c1[8 + 2 * i], c1[8 + 2 * i + 1]); }
            const LAS unsigned char* vp = Vs + ((lane >> 4) & 1) * 32 + (lane & 3) * 8 + (4 * hi + ((lane & 15) >> 2)) * 64;
#pragma unroll
            for (int d = 0; d < 4; ++d)
#pragma unroll
                for (int ks = 0; ks < 4; ++ks) {
                    const s16x4 lo = vtr(vp + d * 4096 + ks * 1024), hh = vtr(vp + d * 4096 + ks * 1024 + 512);
                    const bf16x8 vf = (bf16x8){lo[0], lo[1], lo[2], lo[3], hh[0], hh[1], hh[2], hh[3]};
                    o[d] = __builtin_amdgcn_mfma_f32_32x32x16_bf16(__builtin_bit_cast(bf16x8, pw[ks]), vf, o[d], 0, 0, 0);
                }
        }
        VM_WAIT();
        __syncthreads();
    }
#undef ATT_DMA
    { auto rr = __builtin_amdgcn_permlane32_swap(__float_as_uint(l_reg), __float_as_uint(l_reg), false, false); l_reg = __uint_as_float(rr[0]) + __uint_as_float(rr[1]); }
    if (hi == 0) { typedef float f2v __attribute__((ext_vector_type(2))); *(f2v*)(MLs + (size_t)(wid * 32 + r32) * 2) = (f2v){started ? mref : -1e30f, l_reg}; }
    LAS bf16_t* stg = (LAS bf16_t*)(lds + OST + wid * 8192);
#pragma unroll
    for (int r = 0; r < 16; ++r)
#pragma unroll
        for (int d = 0; d < 4; d += 1) stg[crow(r, hi) * 128 + d * 32 + r32] = (bf16_t)f2bf(o[d][r]);
    bf16_t* Ow = PBs + (size_t)(wid * 32) * 128;
#pragma unroll
    for (int i = 0; i < 8; ++i) { const int row = 4 * i + (lane >> 4), ch = lane & 15; const v4u v = *(const LAS v4u*)(stg + row * 128 + ch * 8); *(v4u*)(Ow + (size_t)row * 128 + ch * 8) = v; }
    __syncthreads();
}
}

namespace s5 {
typedef float f32x16 __attribute__((ext_vector_type(16)));
typedef short s16x4 __attribute__((ext_vector_type(4)));
typedef short v4i16_t __attribute__((ext_vector_type(4)));
constexpr int ES_OFF = 132096, KAP_OFF = ES_OFF + 4096;
__device__ __forceinline__ s16x4 vtr(const LAS unsigned char* p) { return __builtin_bit_cast(s16x4, __builtin_amdgcn_ds_read_tr16_b64_v4i16((LAS v4i16_t*)p)); }
__device__ __forceinline__ void s5_unit(int b, int g, KArgs a, LAS unsigned char* lds) {
    int tid_ = threadIdx.x; asm volatile("" : "+v"(tid_));
    const int lane = tid_ & 63, wid = __builtin_amdgcn_readfirstlane(tid_ >> 6);
    const bf16_t* U = (const bf16_t*)(a->ws + WS_U); bf16_t* Yg = (bf16_t*)(a->ws + WS_YG);
    const int n = lane, r32 = lane & 31, hi = lane >> 5, r16 = lane & 15, kq = lane >> 4;
    LAS unsigned char* wl = lds + wid * 16384;
    LAS float* es = (LAS float*)(lds + ES_OFF);
    LAS float* kap = (LAS float*)(lds + KAP_OFF) + wid * 128;
    LAS unsigned char* us = lds + 140288 + wid * 1024;
    const double dt = exp((double)a->in[IN_LOG_DT][g]);
    const double lr = a->in[IN_LAM_RE][g * NS + n], li = a->in[IN_LAM_IM][g * NS + n];
    const double mag = exp(lr * dt);
    const double ar_d = mag * cos(li * dt), ai_d = mag * sin(li * dt);
    const double nr = ar_d - 1.0, ni = ai_d, den = lr * lr + li * li;
    const float ar = (float)ar_d, ai = (float)ai_d;
    kap[n] = (float)((nr * lr + ni * li) / den); kap[64 + n] = (float)((ni * lr - nr * li) / den);
    const double magL = exp(lr * dt * 1024.0);
    const float pr = (float)(magL * cos(li * dt * 1024.0)), pim = (float)(magL * sin(li * dt * 1024.0));
    bf16x8 bfrag[4];
#pragma unroll
    for (int nb = 0; nb < 4; ++nb) {
        const int n2 = 32 * (nb & 1) + r32; const float kr2 = kap[n2], ki2 = kap[64 + n2];
        const float* pre = a->in[IN_B_RE] + (size_t)(g * NS + n2) * GC + 8 * hi; const float* pim_ = a->in[IN_B_IM] + (size_t)(g * NS + n2) * GC + 8 * hi;
        float v[8];
#pragma unroll
        for (int j = 0; j < 8; ++j) v[j] = (nb < 2) ? (kr2 * pre[j] - ki2 * pim_[j]) : (kr2 * pim_[j] + ki2 * pre[j]);
        v4u w; w.x = pk2(v[0], v[1]); w.y = pk2(v[2], v[3]); w.z = pk2(v[4], v[5]); w.w = pk2(v[6], v[7]);
        bfrag[nb] = __builtin_bit_cast(bf16x8, w);
    }
    bf16x8 cfrag[4];
#pragma unroll
    for (int ks = 0; ks < 4; ++ks) {
        const int k0 = 32 * (ks & 1) + 8 * kq; const float* src = a->in[ks < 2 ? IN_C_RE : IN_C_IM] + (size_t)(g * GC + r16) * NS + k0; const float sg = ks < 2 ? 1.f : -1.f;
        v4u w; w.x = pk2(sg * src[0], sg * src[1]); w.y = pk2(sg * src[2], sg * src[3]); w.z = pk2(sg * src[4], sg * src[5]); w.w = pk2(sg * src[6], sg * src[7]);
        cfrag[ks] = __builtin_bit_cast(bf16x8, w);
    }
    const float dsk = a->in[IN_SSM_D][g * GC + r16];
    const int tokbase = b * SEQ + wid * 1024;
    const int sw = n & 7;
    float cr_ = 0.f, ci_ = 0.f;
    for (int pass = 0; pass < 2; ++pass) {
        float xr = cr_, xi = ci_;
        bf16x8 unext = *(const bf16x8*)(U + (size_t)(tokbase + r32) * SSM_W + g * GC + 8 * hi);
        for (int ch = 0; ch < 32; ++ch) {
            const int t0 = tokbase + 32 * ch;
            const bf16x8 ufrag = unext;
            if (ch < 31) unext = *(const bf16x8*)(U + (size_t)(t0 + 32 + r32) * SSM_W + g * GC + 8 * hi);
            *(LAS bf16x8*)(us + r32 * 32 + hi * 16) = ufrag;
#pragma unroll
            for (int nb = 0; nb < 4; ++nb) {
                const f32x16 acc = __builtin_amdgcn_mfma_f32_32x32x16_bf16(ufrag, bfrag[nb], (f32x16){}, 0, 0, 0);
                const int col = 32 * nb + r32;
#pragma unroll
                for (int rr = 0; rr < 4; ++rr) *(LAS f32x4*)(wl + col * 128 + (((2 * rr + hi) ^ (col & 7)) * 16)) = (f32x4){acc[4 * rr], acc[4 * rr + 1], acc[4 * rr + 2], acc[4 * rr + 3]};
            }
            f32x4 bur[8], bui[8];
#pragma unroll
            for (int s = 0; s < 8; ++s) { bur[s] = *(const LAS f32x4*)(wl + n * 128 + ((s ^ sw) * 16)); bui[s] = *(const LAS f32x4*)(wl + (64 + n) * 128 + ((s ^ sw) * 16)); }
            unsigned xrp[16], xip[16];
#pragma unroll
            for (int s = 0; s < 8; ++s) {
                float xa[4], xb[4];
#pragma unroll
                for (int i = 0; i < 4; ++i) { const float nxr = ar * xr - ai * xi + bur[s][i], nxi = ar * xi + ai * xr + bui[s][i]; xr = nxr; xi = nxi; xa[i] = xr; xb[i] = xi; }
                xrp[2 * s] = att::cvtpk(xa[0], xa[1]); xrp[2 * s + 1] = att::cvtpk(xa[2], xa[3]); xip[2 * s] = att::cvtpk(xb[0], xb[1]); xip[2 * s + 1] = att::cvtpk(xb[2], xb[3]);
            }
            if (pass == 1) {
#pragma unroll
                for (int s2 = 0; s2 < 4; ++s2) {
                    *(LAS v4u*)(wl + n * 128 + ((s2 ^ (n & 3)) * 16)) = (v4u){xrp[4 * s2], xrp[4 * s2 + 1], xrp[4 * s2 + 2], xrp[4 * s2 + 3]};
                    *(LAS v4u*)(wl + (64 + n) * 128 + ((s2 ^ (n & 3)) * 16)) = (v4u){xip[4 * s2], xip[4 * s2 + 1], xip[4 * s2 + 2], xip[4 * s2 + 3]};
                }
                const int q = r16 >> 2, p = r16 & 3;
#pragma unroll
                for (int tt = 0; tt < 2; ++tt) {
                    f32x4 acc4 = (f32x4){0.f, 0.f, 0.f, 0.f};
                    const int s2 = 2 * tt + (p >> 1);
#pragma unroll
                    for (int ks = 0; ks < 4; ++ks) {
                        const LAS unsigned char* ad = wl + (32 * ks + 8 * kq + q) * 128 + ((s2 ^ q) * 16) + (p & 1) * 8;
                        const s16x4 lo = vtr(ad), hh = vtr(ad + 4 * 128);
                        const bf16x8 af = (bf16x8){lo[0], lo[1], lo[2], lo[3], hh[0], hh[1], hh[2], hh[3]};
                        acc4 = __builtin_amdgcn_mfma_f32_16x16x32_bf16(af, cfrag[ks], acc4, 0, 0, 0);
                    }
#pragma unroll
                    for (int rg = 0; rg < 4; ++rg) {
                        const size_t tk = (size_t)(t0 + 16 * tt + 4 * kq + rg);
                        const float y = acc4[rg] + dsk * bf2f(*(const LAS unsigned short*)(us + (16 * tt + 4 * kq + rg) * 32 + r16 * 2));
                        const float z = 0.7978845608028654f * (y + 0.044715f * y * y * y);
                        Yg[tk * SSM_W + g * GC + r16] = (bf16_t)f2bf(y * pg8::sigmoid_f(2.0f * z));
                    }
                }
            }
        }
        if (pass == 0) {
            es[(wid * 64 + n) * 2] = xr; es[(wid * 64 + n) * 2 + 1] = xi;
            __syncthreads();
            float c_r = 0.f, c_i = 0.f;
            for (int v = 0; v < wid; ++v) { const float er = es[(v * 64 + n) * 2], ei = es[(v * 64 + n) * 2 + 1]; const float t_r = pr * c_r - pim * c_i + er, t_i = pr * c_i + pim * c_r + ei; c_r = t_r; c_i = t_i; }
            cr_ = c_r; ci_ = c_i;
        }
    }
    __syncthreads();
}
}

constexpr int CW_WQ = 2048, CW_NORMS = 2560;
constexpr int TAB_OFF = 148480;
constexpr int MAXSLOTS = 1024;
constexpr size_t SM_UT = 1608 * KiB;
#ifndef ATT_WINDOW
#define ATT_WINDOW 0
#endif
constexpr float T2_SKIP = 40.0f;
__device__ __forceinline__ void unit_decode(int u, int& b, int& h, int& mp, int& qb) { h = 3 - (u >> 7); qb = 31 - ((u & 127) >> 2); b = (u >> 1) & 1; mp = u & 1; }
__device__ __forceinline__ int build_part_table(KArgs a, LAS unsigned char* lds, int tid, int lane, int wave, bool writer) {
    LAS unsigned short* tab = (LAS unsigned short*)(lds + TAB_OFF); LAS unsigned short* u_tl = tab + 2048; LAS unsigned short* u_st = u_tl + 512; LAS unsigned char* u_P = (LAS unsigned char*)(u_st + 512);
    LAS int* scn = (LAS int*)(lds + TAB_OFF + 4096 + 1024 + 1024 + 512);
    int b, h, mp, qb; unit_decode(tid, b, h, mp, qb);
    int t_lo = 0;
#if ATT_WINDOW
    { const unsigned* nq = (const unsigned*)(a->ws + WS_CTL) + CW_NORMS + b * 16 + h * 4 + mp * 2; const unsigned* nk = nq + 32;
      const float bound = __uint_as_float(__hip_atomic_load(nq, __ATOMIC_RELAXED, __HIP_MEMORY_SCOPE_AGENT)) * __uint_as_float(__hip_atomic_load(nk, __ATOMIC_RELAXED, __HIP_MEMORY_SCOPE_AGENT))
                        + __uint_as_float(__hip_atomic_load(nq + 1, __ATOMIC_RELAXED, __HIP_MEMORY_SCOPE_AGENT)) * __uint_as_float(__hip_atomic_load(nk + 1, __ATOMIC_RELAXED, __HIP_MEMORY_SCOPE_AGENT));
      const float slope2 = exp2f(-2.0f * (float)(h + 1)) * LOG2E;
      const float W = fminf((T2_SKIP + 2.0f * bound) / slope2 + 2.0f, 1.0e6f);
      const int kmin = qb * 256 - (int)W; t_lo = kmin <= 0 ? 0 : (kmin >> 6); }
#endif
    const int NT = 4 * qb + 4 - t_lo;
    const int P32 = (NT + 31) / 32, P48 = (NT + 47) / 48;
    int P = P32, tot = 0, incl = 0;
    for (int attempt = 0; attempt < 2; ++attempt) {
        incl = P;
#pragma unroll
        for (int o = 1; o < 64; o <<= 1) { const int v = __shfl_up(incl, o); if (lane >= o) incl += v; }
        __syncthreads();
        if (lane == 63) scn[wave] = incl;
        __syncthreads();
        int base = 0; tot = 0;
        for (int w = 0; w < 8; ++w) { const int c = scn[w]; if (w < wave) base += c; tot += c; }
        incl += base;
        if (tot <= MAXSLOTS) break;
        P = P48;
    }
    const int start = incl - P;
    u_tl[tid] = (unsigned short)t_lo; u_st[tid] = (unsigned short)start; u_P[tid] = (unsigned char)P;
    for (int p = 0; p < P; ++p) tab[start + p] = (unsigned short)(tid | (p << 9));
    if (writer) { int* UT = (int*)(a->ws + WS_SMALL + SM_UT); UT[tid * 2] = start; UT[tid * 2 + 1] = P; }
    __syncthreads();
    return tot;
}
__device__ __forceinline__ void phase2_mixer(KArgs a, LAS unsigned char* lds, int tid, int lane, int wave, int vcu, int G) {
    unsigned char* ws = a->ws;
    unsigned* wq = (unsigned*)(ws + WS_CTL) + CW_WQ + a->bar_region;
    const int NP = build_part_table(a, lds, tid, lane, wave, vcu == 0);
    LAS unsigned short* tab = (LAS unsigned short*)(lds + TAB_OFF); LAS unsigned short* u_tl = tab + 2048; LAS unsigned char* u_P = (LAS unsigned char*)(tab + 2048 + 1024);
    LAS int* nxt = (LAS int*)(lds + TAB_OFF + 4096 + 1024 + 1024 + 512) + 12;
    const int NITEMS = BATCH * NG + NP;
    for (;;) {
        { int t0_ = threadIdx.x; asm volatile("" : "+v"(t0_)); if (t0_ == 0) *nxt = (int)__hip_atomic_fetch_add(wq, 1u, __ATOMIC_RELAXED, __HIP_MEMORY_SCOPE_AGENT); }
        __syncthreads();
        const int idx = __builtin_amdgcn_readfirstlane(*nxt);
        __syncthreads();
        if (idx >= NITEMS) break;
        KArgs kb = a; asm volatile("" : "+s"(kb));
        if (idx < BATCH * NG) { s5::s5_unit(idx / NG, idx % NG, kb, lds); continue; }
        const int slot = idx - BATCH * NG; const int e = __builtin_amdgcn_readfirstlane((int)tab[slot]); const int u = e & 511, p = e >> 9;
        int b, h, mp, qb; unit_decode(u, b, h, mp, qb);
        const int tl = __builtin_amdgcn_readfirstlane((int)u_tl[u]), P = __builtin_amdgcn_readfirstlane((int)u_P[u]), NT = 4 * qb + 4 - tl;
        unsigned char* wsb = kb->ws;
        att::attn_part(b, h, mp, qb, tl + (NT * p) / P, tl + (NT * (p + 1)) / P, (const bf16_t*)(wsb + WS_Q), (const bf16_t*)(wsb + WS_K), (const bf16_t*)(wsb + WS_V),
                       (bf16_t*)kb->out + (size_t)slot * 256 * 128, (float*)(wsb + WS_O1) + (size_t)slot * 512, lds);
    }
}
__device__ __forceinline__ void attn_finish(KArgs a, int, int, int vcu, int G) {
    int tid_ = threadIdx.x; asm volatile("" : "+v"(tid_)); const int lane = tid_ & 63, wave = __builtin_amdgcn_readfirstlane(tid_ >> 6);
    unsigned char* ws = a->ws;
    const bf16_t* PB = (const bf16_t*)a->out; const float* ML = (const float*)(ws + WS_O1); const int* UT = (const int*)(ws + WS_SMALL + SM_UT); bf16_t* CC = (bf16_t*)(ws + WS_R1);
    float s1 = a->in[IN_LQ1][lane] * a->in[IN_LK1][lane], s2 = a->in[IN_LQ2][lane] * a->in[IN_LK2][lane];
    s1 = wave_sum(s1); s2 = wave_sum(s2);
    const float lam = expf(s1) - expf(s2) + LAM_INIT;
    const int h = lane >> 4, dcol = 8 * (lane & 15);
    float gn[8];
#pragma unroll
    for (int i = 0; i < 8; ++i) gn[i] = a->in[IN_SUBLN][dcol + i] * (1.0f - LAM_INIT);
    const int gw = vcu * 8 + wave, NGW = G * 8;
    for (int tok = gw; tok < T_TOK; tok += NGW) {
        const int b = tok >> 13, pos = tok & (SEQ - 1), qb = pos >> 8, row = pos & 255;
        float om[2][8];
#pragma unroll
        for (int mp = 0; mp < 2; ++mp) {
            const int u = ((3 - h) << 7) | ((31 - qb) << 2) | (b << 1) | mp;
            const int st = UT[u * 2], P = UT[u * 2 + 1];
            float M = -1e30f;
            for (int p = 0; p < P; ++p) M = fmaxf(M, ML[(size_t)(st + p) * 512 + row * 2]);
            float L = 0.f, acc[8] = {0.f, 0.f, 0.f, 0.f, 0.f, 0.f, 0.f, 0.f};
            for (int p = 0; p < P; ++p) {
                const float mpv = ML[(size_t)(st + p) * 512 + row * 2], lp = ML[(size_t)(st + p) * 512 + row * 2 + 1];
                const float w = __builtin_amdgcn_exp2f(mpv - M);
                const v4u x = *(const v4u*)(PB + ((size_t)(st + p) * 256 + row) * 128 + dcol);
                L += w * lp;
                acc[0] += w * pg8::bf_lo(x.x); acc[1] += w * pg8::bf_hi(x.x); acc[2] += w * pg8::bf_lo(x.y); acc[3] += w * pg8::bf_hi(x.y);
                acc[4] += w * pg8::bf_lo(x.z); acc[5] += w * pg8::bf_hi(x.z); acc[6] += w * pg8::bf_lo(x.w); acc[7] += w * pg8::bf_hi(x.w);
            }
            const float rl = 1.0f / L;
#pragma unroll
            for (int i = 0; i < 8; ++i) om[mp][i] = acc[i] * rl;
        }
        float v[8]; float ss = 0.f;
#pragma unroll
        for (int i = 0; i < 8; ++i) { v[i] = om[0][i] - lam * om[1][i]; ss += v[i] * v[i]; }
        ss += __shfl_xor(ss, 1); ss += __shfl_xor(ss, 2); ss += __shfl_xor(ss, 4); ss += __shfl_xor(ss, 8);
        const float r = 1.0f / sqrtf(ss * (1.0f / DV) + RMS_EPS);
        v4u w; w.x = pk2(v[0] * r * gn[0], v[1] * r * gn[1]); w.y = pk2(v[2] * r * gn[2], v[3] * r * gn[3]); w.z = pk2(v[4] * r * gn[4], v[5] * r * gn[5]); w.w = pk2(v[6] * r * gn[6], v[7] * r * gn[7]);
        *(v4u*)(CC + (size_t)tok * D_MODEL + 512 + 8 * lane) = w;
    }
}

__global__ void __launch_bounds__(512, 2) mk_fwd(Args args) {
    extern __shared__ __attribute__((aligned(16))) unsigned char lds_raw[];
    LAS unsigned char* lds = (LAS unsigned char*)lds_raw;
    const int tid = threadIdx.x, lane = tid & 63, wave = __builtin_amdgcn_readfirstlane(tid >> 6);
    const int G = gridDim.x; const int bx = blockIdx.x; const int vcu = (G % 8 == 0) ? (bx % 8) * (G / 8) + bx / 8 : bx;
    unsigned char* ws = args.ws;
    const KArgs ka = (KArgs)__builtin_amdgcn_kernarg_segment_ptr();
    volatile LAS unsigned* MISC = (volatile LAS unsigned*)(lds + MISC_OFF);
    for (int u = tid; u < (LDS_BYTES - LDSCTL_OFF) / 4; u += 512) ((LAS unsigned*)(lds + LDSCTL_OFF))[u] = 0u;
    __syncthreads();
    const int lo = args.ph_lo, hi = args.ph_hi;
    unsigned* barw = (unsigned*)(ws + WS_CTL) + CW_BAR + args.bar_region * XCD_BAR_WORDS;
    XcdBarrier bar; bar.bar = barw; bar.x = 0; bar.st = nullptr;
    if (hi - lo > 1) bar = xcd_barrier_post(barw, MISC + 8);
#define IN(k) (lo <= (k) && (k) < hi)
#define SEAM(k) do { if (IN(k) && IN((k) + 1)) xcd_barrier(bar); } while (0)
    if (IN(0)) { phase0(ka, lds, lane, wave, vcu, G); } SEAM(0);
    if (IN(1)) { pg8::Gemm g{(const bf16_t*)(ws + WS_R1), (const bf16_t*)(ws + WS_WTIN), T_TOK, IN_COLS, D_MODEL}; pg8::StaticOrder S; S.init(T_TOK, IN_COLS, G, bx);
        pg8::EpiInProj E{(bf16_t*)(ws + WS_Q), (unsigned*)(ws + WS_CTL) + CW_NORMS};
        pg8::gemm_phase<pg8::EpiInProj, pg8::StaticOrder, true, true>(lds, g, S, E); } SEAM(1);
    if (IN(2)) { phase2_mixer(ka, lds, tid, lane, wave, vcu, G); } SEAM(2);
    if (IN(3)) { pg8::Gemm g{(const bf16_t*)(ws + WS_YG), (const bf16_t*)(ws + WS_WTGLU), T_TOK, SSM_W, SSM_W}; pg8::StaticOrder S; S.init(T_TOK, SSM_W, G, bx);
        pg8::EpiGlu E{(const bf16_t*)(ws + WS_YG), args.in[IN_B_GLU], (bf16_t*)(ws + WS_R1), (float*)(ws + WS_SMALL + SM_SSQP)};
        pg8::gemm_phase<pg8::EpiGlu, pg8::StaticOrder, true, true>(lds, g, S, E); attn_finish(ka, lane, wave, vcu, G); } SEAM(3);
    if (IN(4)) { pg8::Gemm g{(const bf16_t*)(ws + WS_R1), (const bf16_t*)(ws + WS_WTOUT), T_TOK, D_MODEL, D_MODEL}; pg8::StaticOrder S; S.init(T_TOK, D_MODEL, G, bx);
        pg8::EpiOut E{args.in[IN_X], args.out, (const float*)(ws + WS_SMALL + SM_SSQP)};
        pg8::gemm_phase<pg8::EpiOut, pg8::StaticOrder, true, true>(lds, g, S, E); } SEAM(4);
    if (IN(5)) { phase5(ka, lds, tid, lane, wave, vcu, G); } SEAM(5);
    if (IN(6)) { phase6(ka, lds, tid, lane, wave, vcu, G); } SEAM(6);
    if (IN(7)) { const int ntiles = __builtin_amdgcn_readfirstlane(((const int*)(ws + WS_SMALL + SM_META))[0]);
        pg8::Gemm g{(const bf16_t*)(ws + WS_ROWS), (const bf16_t*)(ws + WS_WTGU), ntiles * 256, NE * 1024, D_MODEL}; pg8::MoeOrder S{(const int*)(ws + WS_SMALL + SM_TILEE), ntiles, G, vcu};
        pg8::EpiMoeUp E{(bf16_t*)(ws + WS_HID), (const float*)(ws + WS_SMALL + SM_ROWSC)};
        pg8::gemm_phase<pg8::EpiMoeUp, pg8::MoeOrder, true, true>(lds, g, S, E); } SEAM(7);
    if (IN(8)) { const int ntiles = __builtin_amdgcn_readfirstlane(((const int*)(ws + WS_SMALL + SM_META))[0]);
        pg8::Gemm g{(const bf16_t*)(ws + WS_HID), (const bf16_t*)(ws + WS_WTD), ntiles * 256, NE * 1024, FF}; pg8::MoeOrder S{(const int*)(ws + WS_SMALL + SM_TILEE), ntiles, G, vcu};
        pg8::EpiMoeDown E{(bf16_t*)(ws + WS_ROWS), (const float*)(ws + WS_SMALL + SM_ROWGT)};
        pg8::gemm_phase<pg8::EpiMoeDown, pg8::MoeOrder, true, true>(lds, g, S, E); } SEAM(8);
    if (IN(9)) { phase9(ka, lane, wave, vcu, G); }
#undef IN
#undef SEAM
}

extern "C" void kernel_launch(void* const* d_in, const int* in_sizes, int n_in, void* d_out, int out_size, void* d_ws, size_t ws_size, hipStream_t stream) {
    static int grid = 0;
    if (grid == 0) {
        if (n_in != 29 || out_size != T_TOK * D_MODEL || ws_size < WS_END) { fprintf(stderr, "kernel_launch: unexpected shapes (n_in %d, out %d, ws %zu < %zu)\n", n_in, out_size, ws_size, (size_t)WS_END); grid = -1; return; }
        int dev = 0, cus = 0;
        if (hipGetDevice(&dev) != hipSuccess || hipDeviceGetAttribute(&cus, hipDeviceAttributeMultiprocessorCount, dev) != hipSuccess) { grid = -1; return; }
        if (hipFuncSetAttribute((const void*)mk_fwd, hipFuncAttributeMaxDynamicSharedMemorySize, LDS_BYTES) != hipSuccess) { fprintf(stderr, "kernel_launch: hipFuncSetAttribute failed\n"); grid = -1; return; }
        grid = cus;
    }
    if (grid < 0) return;
    (void)hipMemsetAsync((char*)d_ws + WS_CTL, 0, CTL_ZERO_BYTES, stream);
    Args a{};
    for (int i = 0; i < 29; ++i) a.in[i] = (const float*)d_in[i];
    a.out = (float*)d_out; a.ws = (unsigned char*)d_ws;
    unsigned char* ws = (unsigned char*)d_ws;
#ifndef LAUNCH_PLAN
#define LAUNCH_PLAN {0, 10}
#endif
    static const int plan[] = LAUNCH_PLAN;
    for (int i = 0; i + 1 < (int)(sizeof(plan) / sizeof(int)); i += 2) { a.ph_lo = plan[i]; a.ph_hi = plan[i + 1]; a.bar_region = i / 2;
        hipLaunchKernelGGL(mk_fwd, dim3(grid), dim3(512), LDS_BYTES, stream, a); }
}
```

```cpp
#define ATT_WINDOW 1
#include <hip/hip_runtime.h>
#include <cstdio>
#include <cstdint>
#include <cmath>

constexpr int D_MODEL = 1024, BATCH = 2, SEQ = 8192, T_TOK = BATCH * SEQ;
constexpr int IN_COLS = 2048, ATTN_W = 512, SSM_W = 512, NH = 4, DH = 64, DV = 128;
constexpr int NG = 32, GC = 16, NS = 64;
constexpr int NEG = 4, EPG = 8, NE = 32, FF = 512;
constexpr float RMS_EPS = 1e-6f;
constexpr float LAM_INIT = 0.2f;
constexpr float C2 = 0.125f * 1.4426950408889634f;
constexpr float LOG2E = 1.4426950408889634f;
constexpr int MAXROWS = 2 * T_TOK + NE * 256;

namespace pg8 {
#define PG8_LAS __attribute__((address_space(3)))
typedef unsigned short bf16_t;
typedef short bf16x8 __attribute__((ext_vector_type(8)));
typedef float f32x4 __attribute__((ext_vector_type(4)));
typedef unsigned u32x4 __attribute__((ext_vector_type(4)));
constexpr int BM = 256, BK = 64, HALF = 128, HTB = HALF * BK * 2  , STAGE_BYTES = 8 * HTB, NXCD = 8, WGM = 8;

__host__ __device__ __forceinline__ int lds_byte(int r, int c) { const int st = (r >> 4) * 2 + (c >> 5), rr = r & 15, cc = c & 31, ob = rr * 64 + cc * 2; return st * 1024 + (ob ^ (((ob >> 9) & 1) << 5)); }
__host__ __device__ __forceinline__ void stage_rc(int b, int& R, int& C) { const int st = b / 1024, sb = b % 1024, swz = sb ^ (((sb >> 9) & 1) << 5); R = (st >> 1) * 16 + swz / 64; C = (st & 1) * 32 + (swz % 64) / 2; }
__host__ __device__ __forceinline__ int perm32(int rho) { const int n = rho >> 4, i = rho & 15; return 8 * (i >> 2) + 4 * n + (i & 3); }

struct Unit { int pm, pn; };
struct Gemm { const bf16_t* A; const bf16_t* Bt; int M, N, K; };

struct StaticOrder {
    int nM, nN, nwg, G, c;
    __host__ __device__ void init(int M, int N, int G_, int c_) { nM = M / BM; nN = N / BM; nwg = nM * nN; G = G_; c = c_; }
    __host__ __device__ bool next(int i, Unit& u) const {
        const long L = (long)i * G + c; if (L >= nwg) return false;
        int wgid = (int)L; { const int q = nwg / NXCD, r = nwg % NXCD, xcd = wgid % NXCD, off = wgid / NXCD; wgid = (xcd < r ? xcd * (q + 1) : r * (q + 1) + (xcd - r) * q) + off; }
        const int nig = WGM * nN, gid = wgid / nig, fm = gid * WGM, gsz = (nM - fm) < WGM ? (nM - fm) : WGM;
        u.pm = fm + ((wgid % nig) % gsz); u.pn = (wgid % nig) / gsz; return true;
    }
    __device__ __forceinline__ void a_ready(const Unit&) const {}
    __device__ __forceinline__ void done(const Unit&) const {}
};

typedef unsigned u32x4 __attribute__((ext_vector_type(4)));
__device__ __forceinline__ unsigned cvt_pk_bf16(float lo, float hi) { unsigned r; asm volatile("v_cvt_pk_bf16_f32 %0, %1, %2" : "=v"(r) : "v"(lo), "v"(hi)); return r; }
__device__ __forceinline__ float bf_lo(unsigned w) { return __uint_as_float(w << 16); }
__device__ __forceinline__ float bf_hi(unsigned w) { return __uint_as_float(w & 0xffff0000u); }
__device__ __forceinline__ float sigmoid_f(float v) { return __builtin_amdgcn_rcpf(1.0f + __builtin_amdgcn_exp2f(-1.4426950408889634f * v)); }

struct EpiInProj {
    static constexpr bool PERM = true, AFTER_DRAIN = false, MIDK = false;
    bf16_t* O; unsigned* NORMS;
    __device__ __forceinline__ void operator()(const f32x4 (&acc)[2][2][4][2], const Unit& u, int wr, int wc, int fr, int fq) const {
        const int row0 = u.pm * BM + wr * 64 + fr; int colt = u.pn * BM; const int t = colt >> 9; colt -= t << 9;
        bf16_t* base = O + (size_t)t * ((size_t)16384 * 512); const float sc = (t == 0) ? (0.125f * 1.4426950408889634f) : 1.f;
        const int col0 = colt + wc * 32 + 8 * fq;
#pragma unroll
        for (int ai = 0; ai < 2; ++ai)
#pragma unroll
            for (int m = 0; m < 4; ++m) { bf16_t* rowp = base + (size_t)(row0 + ai * HALF + m * 16) * 512 + col0;
#pragma unroll
                for (int bj = 0; bj < 2; ++bj) { const f32x4 v0 = acc[ai][bj][m][0] * sc, v1 = acc[ai][bj][m][1] * sc;
                    u32x4 w; w.x = cvt_pk_bf16(v0[0], v0[1]); w.y = cvt_pk_bf16(v0[2], v0[3]); w.z = cvt_pk_bf16(v1[0], v1[1]); w.w = cvt_pk_bf16(v1[2], v1[3]);
                    *(u32x4*)(rowp + bj * HALF) = w; } }
        if (t < 2) {
#pragma unroll
            for (int bj = 0; bj < 2; ++bj) { float mx = 0.f;
#pragma unroll
                for (int ai = 0; ai < 2; ++ai)
#pragma unroll
                    for (int m = 0; m < 4; ++m) { const f32x4 v0 = acc[ai][bj][m][0] * sc, v1 = acc[ai][bj][m][1] * sc;
                        float ss = (v0[0] * v0[0] + v0[1] * v0[1]) + (v0[2] * v0[2] + v0[3] * v0[3]) + (v1[0] * v1[0] + v1[1] * v1[1]) + (v1[2] * v1[2] + v1[3] * v1[3]);
                        ss += __shfl_xor(ss, 16); ss += __shfl_xor(ss, 32); mx = fmaxf(mx, ss); }
                mx = fmaxf(mx, __shfl_xor(mx, 1)); mx = fmaxf(mx, __shfl_xor(mx, 2)); mx = fmaxf(mx, __shfl_xor(mx, 4)); mx = fmaxf(mx, __shfl_xor(mx, 8));
                if (fr == 0 && fq == 0) atomicMax(NORMS + t * 32 + (u.pm >> 5) * 16 + ((colt + bj * HALF + wc * 32) >> 5), __float_as_uint(sqrtf(mx) * 1.001f)); }
        }
    }
};
struct EpiGlu {
    static constexpr bool PERM = true, AFTER_DRAIN = false, MIDK = false;
    const bf16_t* Yg; const float* bias; bf16_t* CC; float* SSQP;
    __device__ __forceinline__ void operator()(const f32x4 (&acc)[2][2][4][2], const Unit& u, int wr, int wc, int fr, int fq) const {
        const int row0 = u.pm * BM + wr * 64 + fr, col0 = u.pn * BM + wc * 32 + 8 * fq;
        f32x4 bv[2][2];
#pragma unroll
        for (int bj = 0; bj < 2; ++bj)
#pragma unroll
            for (int n = 0; n < 2; ++n) bv[bj][n] = *(const f32x4*)(bias + col0 + bj * HALF + 4 * n);
#pragma unroll
        for (int ai = 0; ai < 2; ++ai)
#pragma unroll
            for (int m = 0; m < 4; ++m) { const int row = row0 + ai * HALF + m * 16; float ss = 0.f;
#pragma unroll
                for (int bj = 0; bj < 2; ++bj) { const int col = col0 + bj * HALF;
                    const u32x4 y8 = *(const u32x4*)(Yg + (size_t)row * 512 + col);
                    const f32x4 a0 = acc[ai][bj][m][0] + bv[bj][0], a1 = acc[ai][bj][m][1] + bv[bj][1];
                    float z[8];
                    z[0] = bf_lo(y8.x) * sigmoid_f(a0[0]); z[1] = bf_hi(y8.x) * sigmoid_f(a0[1]); z[2] = bf_lo(y8.y) * sigmoid_f(a0[2]); z[3] = bf_hi(y8.y) * sigmoid_f(a0[3]);
                    z[4] = bf_lo(y8.z) * sigmoid_f(a1[0]); z[5] = bf_hi(y8.z) * sigmoid_f(a1[1]); z[6] = bf_lo(y8.w) * sigmoid_f(a1[2]); z[7] = bf_hi(y8.w) * sigmoid_f(a1[3]);
#pragma unroll
                    for (int i = 0; i < 8; ++i) ss += z[i] * z[i];
                    u32x4 w; w.x = cvt_pk_bf16(z[0], z[1]); w.y = cvt_pk_bf16(z[2], z[3]); w.z = cvt_pk_bf16(z[4], z[5]); w.w = cvt_pk_bf16(z[6], z[7]);
                    *(u32x4*)(CC + (size_t)row * 1024 + col) = w; }
                ss += __shfl_xor(ss, 16); ss += __shfl_xor(ss, 32);
                if (fq == 0) SSQP[(size_t)row * 8 + u.pn * 4 + wc] = ss; }
    }
};
struct EpiOut {
    static constexpr bool PERM = false, AFTER_DRAIN = false, MIDK = true;
    const float* x; float* out; const float* SSQP;
    __device__ __forceinline__ void midk(f32x4 (&acc)[2][2][4][2], const Unit& u, int wr, int wc, int fr, int fq) const {
#pragma unroll
        for (int ai = 0; ai < 2; ++ai)
#pragma unroll
            for (int m = 0; m < 4; ++m) { const int row = u.pm * BM + ai * HALF + wr * 64 + m * 16 + fr;
                const f32x4 s0 = *(const f32x4*)(SSQP + (size_t)row * 8), s1 = *(const f32x4*)(SSQP + (size_t)row * 8 + 4);
                const float s = ((s0[0] + s0[1]) + (s0[2] + s0[3])) + ((s1[0] + s1[1]) + (s1[2] + s1[3]));
                const float r = __builtin_amdgcn_rsqf(s * (1.0f / 512.0f) + 1e-6f);
#pragma unroll
                for (int bj = 0; bj < 2; ++bj)
#pragma unroll
                    for (int n = 0; n < 2; ++n) acc[ai][bj][m][n] *= r; }
    }
    __device__ __forceinline__ void operator()(const f32x4 (&acc)[2][2][4][2], const Unit& u, int wr, int wc, int fr, int fq) const {
        const int col0 = u.pn * BM + wc * 32 + 4 * fq;
#pragma unroll
        for (int ai = 0; ai < 2; ++ai)
#pragma unroll
            for (int m = 0; m < 4; ++m) { const size_t off = (size_t)(u.pm * BM + ai * HALF + wr * 64 + m * 16 + fr) * 1024 + col0;
#pragma unroll
                for (int bj = 0; bj < 2; ++bj)
#pragma unroll
                    for (int n = 0; n < 2; ++n) { const f32x4 bs = *(const f32x4*)(x + off + bj * HALF + n * 16); *(f32x4*)(out + off + bj * HALF + n * 16) = bs + acc[ai][bj][m][n]; } }
    }
};
struct EpiMoeUp {
    static constexpr bool PERM = true, AFTER_DRAIN = false, MIDK = false;
    bf16_t* HID; const float* ROWSC;
    __device__ __forceinline__ void operator()(const f32x4 (&acc)[2][2][4][2], const Unit& u, int wr, int wc, int fr, int fq) const {
        const int row0 = u.pm * BM + wr * 64 + fr, j0 = (u.pn & 3) * HALF + wc * 32 + 8 * fq;
#pragma unroll
        for (int ai = 0; ai < 2; ++ai)
#pragma unroll
            for (int m = 0; m < 4; ++m) { const int row = row0 + ai * HALF + m * 16; const float rs = ROWSC[row];
                float h[8];
#pragma unroll
                for (int n = 0; n < 2; ++n)
#pragma unroll
                    for (int i = 0; i < 4; ++i) { const float g = acc[ai][0][m][n][i] * rs, up = acc[ai][1][m][n][i] * rs; h[n * 4 + i] = g * sigmoid_f(g) * up; }
                u32x4 w; w.x = cvt_pk_bf16(h[0], h[1]); w.y = cvt_pk_bf16(h[2], h[3]); w.z = cvt_pk_bf16(h[4], h[5]); w.w = cvt_pk_bf16(h[6], h[7]);
                *(u32x4*)(HID + (size_t)row * 512 + j0) = w; }
    }
};
struct EpiMoeDown {
    static constexpr bool PERM = true, AFTER_DRAIN = false, MIDK = false;
    bf16_t* Y; const float* ROWGT;
    __device__ __forceinline__ void operator()(const f32x4 (&acc)[2][2][4][2], const Unit& u, int wr, int wc, int fr, int fq) const {
        const int row0 = u.pm * BM + wr * 64 + fr, col0 = (u.pn & 3) * BM + wc * 32 + 8 * fq;
#pragma unroll
        for (int ai = 0; ai < 2; ++ai)
#pragma unroll
            for (int m = 0; m < 4; ++m) { const int row = row0 + ai * HALF + m * 16; const float gt = ROWGT[row];
#pragma unroll
                for (int bj = 0; bj < 2; ++bj) { const f32x4 v0 = acc[ai][bj][m][0] * gt, v1 = acc[ai][bj][m][1] * gt;
                    u32x4 w; w.x = cvt_pk_bf16(v0[0], v0[1]); w.y = cvt_pk_bf16(v0[2], v0[3]); w.z = cvt_pk_bf16(v1[0], v1[1]); w.w = cvt_pk_bf16(v1[2], v1[3]);
                    *(u32x4*)(Y + (size_t)row * 1024 + col0 + bj * HALF) = w; } }
    }
};
struct MoeOrder {
    const int* tile_e; int ntiles, G, c;
    __device__ __forceinline__ bool next(int i, Unit& u) const {
        const int L = i * G + c; if (L >= ntiles * 4) return false;
        u.pm = L >> 2; const int e = __builtin_amdgcn_readfirstlane(tile_e[u.pm]); u.pn = e * 4 + (L & 3); return true;
    }
    __device__ __forceinline__ void a_ready(const Unit&) const {}
    __device__ __forceinline__ void done(const Unit&) const {}
};
template <class Epi, class Sched, bool ALIGN_EPI = false, bool SP2 = false>
__device__ __forceinline__ void gemm_phase(PG8_LAS unsigned char* lds, const Gemm g, const Sched& S, const Epi& E) {
    const int tid = threadIdx.x, wid = __builtin_amdgcn_readfirstlane(tid >> 6), lane = tid & 63, wr = wid >> 2, wc = wid & 3, fr = lane & 15, fq = lane >> 4;
    const int K = g.K, nt = K / BK;
    unsigned voffA[2], voffB[2];
#pragma unroll
    for (int i = 0; i < 2; ++i) { int R, C; stage_rc(tid * 16 + i * 8192, R, C); const int Rb = Epi::PERM ? ((R & ~31) + perm32(R & 31)) : R;
        voffA[i] = (unsigned)(R * K + C) * 2u; voffB[i] = (unsigned)(Rb * K + C) * 2u; }
    const size_t kstep = (size_t)(BK * 2);
    const size_t hstep = (size_t)HALF * K * 2;
    const size_t tstep = 2 * hstep;
    const unsigned ldsw = (unsigned)wid * 1024u;
    const int aoff = lds_byte(wr * 64 + fr, fq * 8), boff = lds_byte(wc * 32 + fr, fq * 8);
#define PG8_SA(b, h) (((b) * 2 + (h)) * HTB)
#define PG8_SB(b, h) ((4 + (b) * 2 + (h)) * HTB)
#define PG8_STAGE(bufoff, gbase, voff) do { _Pragma("unroll") for (int _i = 0; _i < 2; ++_i) \
        __builtin_amdgcn_global_load_lds((const unsigned*)((const char*)(gbase) + (voff)[_i]), (PG8_LAS unsigned*)(lds + (bufoff) + ldsw + _i * 8192), 16, 0, 0); } while (0)
#define PG8_LDA(dst, b, h) do { _Pragma("unroll") for (int m = 0; m < 4; ++m) _Pragma("unroll") for (int k = 0; k < 2; ++k) dst[m][k] = *(const PG8_LAS bf16x8*)(lds + PG8_SA(b, h) + aoff + m * 2048 + k * 1024); } while (0)
#define PG8_LDB(dst, b, h) do { _Pragma("unroll") for (int n = 0; n < 2; ++n) _Pragma("unroll") for (int k = 0; k < 2; ++k) dst[n][k] = *(const PG8_LAS bf16x8*)(lds + PG8_SB(b, h) + boff + n * 2048 + k * 1024); } while (0)
#define PG8_MMA(ai, bj, At, Bt) do { __builtin_amdgcn_s_setprio(1); _Pragma("unroll") for (int m = 0; m < 4; ++m) _Pragma("unroll") for (int n = 0; n < 2; ++n) _Pragma("unroll") for (int k = 0; k < 2; ++k) \
        acc[ai][bj][m][n] = __builtin_amdgcn_mfma_f32_16x16x32_bf16(Bt[n][k], At[m][k], acc[ai][bj][m][n], 0, 0, 0); __builtin_amdgcn_s_setprio(0); } while (0)
#define PG8_WAIT_V(n) asm volatile("s_waitcnt vmcnt(" #n ")" ::: "memory")
#define PG8_WAIT_L(n) asm volatile("s_waitcnt lgkmcnt(" #n ")" ::: "memory")
#define PG8_BAR __builtin_amdgcn_s_barrier()
#define PG8_SCHED __builtin_amdgcn_sched_barrier(0)
    Unit cur, nxt; int ui = 0;
    if (!S.next(0, cur)) return;
    f32x4 acc[2][2][4][2];
#pragma unroll
    for (int a = 0; a < 2; ++a)
#pragma unroll
        for (int b = 0; b < 2; ++b)
#pragma unroll
            for (int m = 0; m < 4; ++m)
#pragma unroll
                for (int n = 0; n < 2; ++n) acc[a][b][m][n] = (f32x4){0.f, 0.f, 0.f, 0.f};
    bf16x8 At[4][2], B0[2][2], B1[2][2];
    const char* cA = (const char*)g.A + (size_t)cur.pm * tstep; const char* cB = (const char*)g.Bt + (size_t)cur.pn * tstep;
    S.a_ready(cur);
    if constexpr (SP2) {
        PG8_STAGE(PG8_SB(0, 0), cB, voffB); PG8_STAGE(PG8_SB(0, 1), cB + hstep, voffB); PG8_STAGE(PG8_SA(0, 0), cA, voffA); PG8_STAGE(PG8_SA(0, 1), cA + hstep, voffA);
        if (wr == 1) PG8_BAR;
        PG8_WAIT_V(2); PG8_BAR;
        PG8_STAGE(PG8_SB(1, 0), cB + kstep, voffB); PG8_STAGE(PG8_SA(1, 0), cA + kstep, voffA); PG8_STAGE(PG8_SB(1, 1), cB + hstep + kstep, voffB);
        PG8_WAIT_V(6); PG8_BAR;
    } else {
        PG8_STAGE(PG8_SB(0, 0), cB, voffB); PG8_STAGE(PG8_SA(0, 0), cA, voffA); PG8_STAGE(PG8_SB(0, 1), cB + hstep, voffB); PG8_STAGE(PG8_SA(0, 1), cA + hstep, voffA);
        if (wr == 1) PG8_BAR;
        PG8_WAIT_V(4); PG8_BAR;
        PG8_STAGE(PG8_SB(1, 0), cB + kstep, voffB); PG8_STAGE(PG8_SA(1, 0), cA + kstep, voffA); PG8_STAGE(PG8_SB(1, 1), cB + hstep + kstep, voffB);
        PG8_WAIT_V(6); PG8_BAR;
    }
    for (;;) {
        const bool has_next = S.next(ui + 1, nxt);
        const char* nA = has_next ? (const char*)g.A + (size_t)nxt.pm * tstep : cA; const char* nB = has_next ? (const char*)g.Bt + (size_t)nxt.pn * tstep : cB;
        for (int t = 0; t < nt; t += 2) {
            if constexpr (Epi::MIDK) { if (t == (nt >> 1)) E.midk(acc, cur, wr, wc, fr, fq); }
            const bool last = (t == nt - 2);
            const char* a1 = cA + (size_t)(t + 1) * kstep;
            const char* a2 = last ? nA : cA + (size_t)(t + 2) * kstep; const char* b2 = last ? nB : cB + (size_t)(t + 2) * kstep;
            const char* a3 = a2 + kstep; const char* b3 = b2 + kstep;
            if (last && has_next) S.a_ready(nxt);
            if constexpr (SP2) {
            PG8_LDB(B0, 0, 0); PG8_LDB(B1, 0, 1); PG8_SCHED; PG8_LDA(At, 0, 0); PG8_STAGE(PG8_SA(1, 1), a1 + hstep, voffA);
            PG8_WAIT_V(8); PG8_WAIT_L(0); PG8_BAR; PG8_MMA(0, 0, At, B0); PG8_MMA(0, 1, At, B1); PG8_BAR; PG8_SCHED;
            PG8_LDA(At, 0, 1); PG8_STAGE(PG8_SB(0, 0), b2, voffB); PG8_STAGE(PG8_SB(0, 1), b2 + hstep, voffB); PG8_STAGE(PG8_SA(0, 0), a2, voffA);
            PG8_WAIT_V(8); PG8_WAIT_L(0); PG8_BAR; PG8_MMA(1, 0, At, B0); PG8_MMA(1, 1, At, B1); PG8_BAR; PG8_SCHED;
            PG8_LDB(B0, 1, 0); PG8_LDB(B1, 1, 1); PG8_SCHED; PG8_LDA(At, 1, 0); PG8_STAGE(PG8_SA(0, 1), a2 + hstep, voffA);
            PG8_WAIT_V(8); PG8_WAIT_L(0); PG8_BAR; PG8_MMA(0, 0, At, B0); PG8_MMA(0, 1, At, B1); PG8_BAR; PG8_SCHED;
            PG8_LDA(At, 1, 1); PG8_STAGE(PG8_SB(1, 0), b3, voffB); PG8_STAGE(PG8_SB(1, 1), b3 + hstep, voffB); PG8_STAGE(PG8_SA(1, 0), a3, voffA);
            PG8_WAIT_V(8); PG8_WAIT_L(0); PG8_BAR; PG8_MMA(1, 0, At, B0); PG8_MMA(1, 1, At, B1); PG8_BAR; PG8_SCHED;
            } else {
            PG8_LDB(B0, 0, 0); PG8_SCHED; PG8_LDA(At, 0, 0); PG8_STAGE(PG8_SA(1, 1), a1 + hstep, voffA);
            PG8_WAIT_L(8); PG8_BAR; PG8_WAIT_L(0); PG8_MMA(0, 0, At, B0); PG8_BAR; PG8_SCHED;
            PG8_LDB(B1, 0, 1); PG8_STAGE(PG8_SB(0, 0), b2, voffB);
            PG8_BAR; PG8_WAIT_L(0); PG8_MMA(0, 1, At, B1); PG8_BAR;
            PG8_LDA(At, 0, 1); PG8_STAGE(PG8_SA(0, 0), a2, voffA);
            PG8_BAR; PG8_WAIT_L(0); PG8_MMA(1, 0, At, B0); PG8_BAR; PG8_SCHED;
            PG8_STAGE(PG8_SB(0, 1), b2 + hstep, voffB);
            PG8_WAIT_V(6); PG8_BAR; PG8_MMA(1, 1, At, B1); PG8_BAR;
            PG8_LDB(B0, 1, 0); PG8_SCHED; PG8_LDA(At, 1, 0); PG8_STAGE(PG8_SA(0, 1), a2 + hstep, voffA);
            PG8_WAIT_L(8); PG8_BAR; PG8_WAIT_L(0); PG8_MMA(0, 0, At, B0); PG8_BAR; PG8_SCHED;
            PG8_LDB(B1, 1, 1); PG8_STAGE(PG8_SB(1, 0), b3, voffB);
            PG8_BAR; PG8_WAIT_L(0); PG8_MMA(0, 1, At, B1); PG8_BAR;
            PG8_LDA(At, 1, 1); PG8_STAGE(PG8_SA(1, 0), a3, voffA);
            PG8_BAR; PG8_WAIT_L(0); PG8_MMA(1, 0, At, B0); PG8_BAR; PG8_SCHED;
            PG8_STAGE(PG8_SB(1, 1), b3 + hstep, voffB);
            PG8_WAIT_V(6); PG8_BAR; PG8_MMA(1, 1, At, B1); PG8_BAR;
            }
        }
        if constexpr (ALIGN_EPI) { if (wr == 0) PG8_BAR; }
        if constexpr (!Epi::AFTER_DRAIN) { E(acc, cur, wr, wc, fr, fq); S.done(cur); }
        if (!has_next) break;
#pragma unroll
        for (int a = 0; a < 2; ++a)
#pragma unroll
            for (int b = 0; b < 2; ++b)
#pragma unroll
                for (int m = 0; m < 4; ++m)
#pragma unroll
                    for (int n = 0; n < 2; ++n) acc[a][b][m][n] = (f32x4){0.f, 0.f, 0.f, 0.f};
        cur = nxt; cA = nA; cB = nB; ++ui;
        if constexpr (ALIGN_EPI) { if (wr == 1) PG8_BAR; }
    }
    PG8_WAIT_V(0);
    if constexpr (!ALIGN_EPI) { if (wr == 0) PG8_BAR; }
    PG8_BAR;
    if constexpr (Epi::AFTER_DRAIN) { E.fused(acc, cur, wr, wc, fr, fq, lds, wid, lane); S.done(cur); }
#undef PG8_SA
#undef PG8_SB
#undef PG8_STAGE
#undef PG8_LDA
#undef PG8_LDB
#undef PG8_MMA
#undef PG8_WAIT_V
#undef PG8_WAIT_L
#undef PG8_BAR
#undef PG8_SCHED
}
}
using pg8::bf16_t;
constexpr size_t MiB = 1u << 20, KiB = 1u << 10;
constexpr size_t WS_CTL = 0, CTL_ZERO_BYTES = 1 * MiB;
constexpr size_t WS_SMALL = 1 * MiB;
constexpr size_t WS_WTIN = 4 * MiB, WS_WTOUT = 8 * MiB, WS_WTGLU = 10 * MiB, WS_WR = 10 * MiB + 512 * KiB, WS_WTGU = 11 * MiB, WS_WTD = 75 * MiB;
constexpr size_t WS_R1 = 107 * MiB;
constexpr size_t WS_BIG = 139 * MiB;
constexpr size_t WS_Q = WS_BIG, WS_K = WS_BIG + 16 * MiB, WS_V = WS_BIG + 32 * MiB, WS_U = WS_BIG + 48 * MiB, WS_O1 = WS_BIG + 64 * MiB, WS_O2 = WS_BIG + 80 * MiB, WS_YG = WS_BIG + 96 * MiB;
constexpr size_t WS_ROWS = WS_BIG, WS_HID = WS_BIG + 80 * MiB;
constexpr size_t WS_END = WS_BIG + 120 * MiB;
static_assert((size_t)MAXROWS * 1024 * 2 == 80 * MiB && (size_t)MAXROWS * 512 * 2 == 40 * MiB, "moe buffers");
constexpr size_t SM_SSQP = 0, SM_RINV = 512 * KiB, SM_EID = 576 * KiB, SM_GATE = 704 * KiB, SM_DEST = 832 * KiB, SM_LRANK = 960 * KiB, SM_TOKROW = 1088 * KiB,
                 SM_ROWSC = 1248 * KiB, SM_ROWGT = 1408 * KiB, SM_TILEE = 1568 * KiB, SM_CNT = 1572 * KiB, SM_META = 1604 * KiB;
constexpr int CW_BAR = 4096;

constexpr int RING_BYTES = 131072, LDSCTL_OFF = RING_BYTES, MISC_OFF = LDSCTL_OFF + 320, LDS_BYTES = 156672;

#define GAS __attribute__((address_space(1)))
#define LAS __attribute__((address_space(3)))
typedef unsigned v4u __attribute__((ext_vector_type(4)));
typedef unsigned v2u __attribute__((ext_vector_type(2)));
typedef float f32x4 __attribute__((ext_vector_type(4)));
typedef short bf16x8 __attribute__((ext_vector_type(8)));
#define LDS_WAIT() asm volatile("s_waitcnt lgkmcnt(0)" ::: "memory")
#define VM_WAIT() asm volatile("s_waitcnt vmcnt(0)" ::: "memory")
__device__ __forceinline__ unsigned f2bf(float f) { unsigned u = __builtin_bit_cast(unsigned, f); return (u + 0x7fffu + ((u >> 16) & 1u)) >> 16; }
__device__ __forceinline__ unsigned pk2(float lo, float hi) { return f2bf(lo) | (f2bf(hi) << 16); }
__device__ __forceinline__ float bf2f(unsigned short h) { return __uint_as_float(((unsigned)h) << 16); }
__device__ __forceinline__ float wave_sum(float v) {
#pragma unroll
    for (int o = 1; o < 64; o <<= 1) v += __shfl_xor(v, o);
    return v;
}
__device__ __forceinline__ float wave_max(float v) {
#pragma unroll
    for (int o = 1; o < 64; o <<= 1) v = fmaxf(v, __shfl_xor(v, o));
    return v;
}
#define XB_TMO      128
#define XB_XCNT(j)  (256  + 64 * (j))
#define XB_XSUB(j)  (1280 + 64 * (j))
#define XB_XGEN(j)  (2304 + 64 * (j))
#define XB_TOP      3328
#define XB_TOPGEN   3392
#define XCD_BAR_WORDS 3456
#define XB_SPIN_CAP (1u << 18)

__device__ __forceinline__ unsigned xb_ld(unsigned* p)              { return __hip_atomic_load(p, __ATOMIC_RELAXED, __HIP_MEMORY_SCOPE_AGENT); }
__device__ __forceinline__ unsigned xb_add(unsigned* p, unsigned v) { return __hip_atomic_fetch_add(p, v, __ATOMIC_RELAXED, __HIP_MEMORY_SCOPE_AGENT); }
__device__ __forceinline__ unsigned xb_xcc_id() { return (unsigned)__builtin_amdgcn_s_getreg((3 << 11) | 20) & 0xFu; }
#define XB_SPIN(cond, bar) do { unsigned _sp = 0; while (cond) { __builtin_amdgcn_s_sleep(1); \
    if ((++_sp & 255u) == 0u) { if (xb_ld(&(bar)[XB_TMO])) break; if (_sp > XB_SPIN_CAP) { atomicAdd(&(bar)[XB_TMO], 1u); break; } } } } while (0)

struct XcdBarrier {
    unsigned* bar; unsigned x;
    volatile LAS unsigned* st;
};

__device__ __forceinline__ XcdBarrier xcd_barrier_post(unsigned* bar, volatile LAS unsigned* st) {
    XcdBarrier b; b.bar = bar; b.x = xb_xcc_id(); b.st = st;
    if (threadIdx.x == 0) (void)xb_add(&bar[XB_XCNT(b.x)], 1u);
    return b;
}
__device__ __forceinline__ void xcd_barrier_complete(unsigned* bar, unsigned x, unsigned& nloc, unsigned& nx) {
    const unsigned G = gridDim.x * gridDim.y * gridDim.z;
    unsigned sum, cnt, mine, sp = 0u;
    for (;;) {
        sum = 0u; cnt = 0u; mine = 0u;
#pragma unroll
        for (unsigned j = 0; j < 16; ++j) { const unsigned c = xb_ld(&bar[XB_XCNT(j)]); sum += c; cnt += (c > 0u) ? 1u : 0u; mine = (j == x) ? c : mine; }
        if (sum == G) break;
        __builtin_amdgcn_s_sleep(1);
        if ((++sp & 255u) == 0u) { if (xb_ld(&bar[XB_TMO])) break; if (sp > XB_SPIN_CAP) { atomicAdd(&bar[XB_TMO], 1u); break; } }
    }
    nloc = mine > 0u ? mine : 1u; nx = cnt > 0u ? cnt : 1u;
}

__device__ __forceinline__ void xcd_barrier(const XcdBarrier& b) {
    asm volatile("s_waitcnt vmcnt(0)" ::: "memory");
    __syncthreads();
    if (threadIdx.x == 0) {
        unsigned* bar = b.bar;
        __builtin_amdgcn_s_waitcnt(0);
        unsigned nloc = b.st[0], nx = b.st[1];
        if (nloc == 0u) { xcd_barrier_complete(bar, b.x, nloc, nx); b.st[0] = nloc; b.st[1] = nx; }
        const unsigned old = xb_add(&bar[XB_XSUB(b.x)], 1u);
        const unsigned gen = old / nloc;
        if (old + 1u == (gen + 1u) * nloc) {
            __builtin_amdgcn_fence(__ATOMIC_RELEASE, "agent");
            asm volatile("s_waitcnt vmcnt(0)" ::: "memory");
            const unsigned og = xb_add(&bar[XB_TOP], 1u);
            const unsigned tg = og / nx;
            if (og + 1u == (tg + 1u) * nx) xb_add(&bar[XB_TOPGEN], 1u);
            else XB_SPIN(xb_ld(&bar[XB_TOPGEN]) == tg, bar);
            __builtin_amdgcn_fence(__ATOMIC_ACQUIRE, "agent");
            xb_add(&bar[XB_XGEN(b.x)], 1u);
            asm volatile("s_waitcnt vmcnt(0)" ::: "memory");
        } else {
            XB_SPIN(xb_ld(&bar[XB_XGEN(b.x)]) == gen, bar);
            __builtin_amdgcn_fence(__ATOMIC_ACQUIRE, "agent");
            asm volatile("s_waitcnt vmcnt(0)" ::: "memory");
        }
    }
    __syncthreads();
}

struct Args { const float* in[29]; float* out; unsigned char* ws; int ph_lo, ph_hi, bar_region, pad; };
typedef const __attribute__((address_space(4))) Args* KArgs;
enum { IN_X = 0, IN_NORM_ATTN, IN_W_IN, IN_LQ1, IN_LK1, IN_LQ2, IN_LK2, IN_SUBLN, IN_LAM_RE, IN_LAM_IM, IN_LOG_DT, IN_B_RE, IN_B_IM, IN_C_RE, IN_C_IM, IN_SSM_D,
       IN_W_GLU, IN_B_GLU, IN_SSM_NORM, IN_W_OUT, IN_NORM_MOE, IN_WRG, IN_BRG, IN_WRE, IN_BRE, IN_W_GATE, IN_W_UP, IN_W_DOWN, IN_NORM_FINAL };

__device__ __forceinline__ void tr_item(const float* __restrict__ W, int ldw, int ks0, int ns0, bf16_t* WT, int ldt, int rd0, int kd0, const float* kscale, LAS float* scr, int lane) {
    const int nn = 4 * (lane & 15);
#pragma unroll 8
    for (int i = 0; i < 16; ++i) { const int kk = 4 * i + (lane >> 4); f32x4 v = *(const f32x4*)(W + (size_t)(ks0 + kk) * ldw + ns0 + nn); if (kscale) v = v * kscale[kk];
        LAS float* d = scr + kk * 65 + nn; d[0] = v.x; d[1] = v.y; d[2] = v.z; d[3] = v.w; }
    LDS_WAIT(); asm volatile("" ::: "memory");
    const int c = lane & 7;
#pragma unroll
    for (int j = 0; j < 8; ++j) { const int n = (lane >> 3) + 8 * j; const LAS float* s = scr + (8 * c) * 65 + n;
        v4u o; o.x = pk2(s[0 * 65], s[1 * 65]); o.y = pk2(s[2 * 65], s[3 * 65]); o.z = pk2(s[4 * 65], s[5 * 65]); o.w = pk2(s[6 * 65], s[7 * 65]);
        *(GAS v4u*)(WT + (size_t)(rd0 + n) * ldt + kd0 + 8 * c) = o; }
    LDS_WAIT(); asm volatile("" ::: "memory");
}
__device__ __forceinline__ void phase0(KArgs a, LAS unsigned char* lds, int, int, int vcu, int G) {
    int tid_ = threadIdx.x; asm volatile("" : "+v"(tid_)); const int lane = tid_ & 63, wave = __builtin_amdgcn_readfirstlane(tid_ >> 6);
    LAS float* scr = (LAS float*)(lds + (wave < 7 ? wave * 16640 : 136192));
    const int gw = vcu * 8 + wave, NGW = G * 8;
    unsigned char* ws = a->ws;
    bf16_t* WT_in = (bf16_t*)(ws + WS_WTIN); bf16_t* WT_out = (bf16_t*)(ws + WS_WTOUT); bf16_t* WT_glu = (bf16_t*)(ws + WS_WTGLU);
    bf16_t* WT_gu = (bf16_t*)(ws + WS_WTGU); bf16_t* WT_d = (bf16_t*)(ws + WS_WTD);
    constexpr int I_IN = 16 * 32, I_OUT = 16 * 16, I_GLU = 8 * 8, I_E = 384, NITEMS = I_IN + I_OUT + I_GLU + NE * I_E;
    for (int it = gw; it < NITEMS; it += NGW) {
        int r = it;
        if (r < I_IN) { const int kb = r >> 5, nb = r & 31; tr_item(a->in[IN_W_IN], IN_COLS, 64 * kb, 64 * nb, WT_in, 1024, 64 * nb, 64 * kb, nullptr, scr, lane); continue; } r -= I_IN;
        if (r < I_OUT) { const int kb = r >> 4, nb = r & 15, ks0 = 64 * kb;
            tr_item(a->in[IN_W_OUT], 1024, ks0, 64 * nb, WT_out, 1024, 64 * nb, (ks0 + 512) & 1023, ks0 >= 512 ? a->in[IN_SSM_NORM] + (ks0 - 512) : nullptr, scr, lane); continue; } r -= I_OUT;
        if (r < I_GLU) { const int kb = r >> 3, nb = r & 7; tr_item(a->in[IN_W_GLU], 512, 64 * kb, 64 * nb, WT_glu, 512, 64 * nb, 64 * kb, nullptr, scr, lane); continue; } r -= I_GLU;
        const int e = r / I_E; r -= e * I_E;
        if (r < 256) { const int up = r >> 7; r &= 127; const int kb = r >> 3, nb = r & 7, n0 = 64 * nb;
            tr_item(a->in[up ? IN_W_UP : IN_W_GATE] + (size_t)e * 1024 * 512, 512, 64 * kb, n0, WT_gu, 1024, e * 1024 + (n0 >> 7) * 256 + up * 128 + (n0 & 127), 64 * kb, nullptr, scr, lane); continue; }
        r -= 256; { const int kb = r >> 4, nb = r & 15; tr_item(a->in[IN_W_DOWN] + (size_t)e * 512 * 1024, 1024, 64 * kb, 64 * nb, WT_d, 512, e * 1024 + 64 * nb, 64 * kb, nullptr, scr, lane); }
    }
    { const float* x = a->in[IN_X]; const float* g = a->in[IN_NORM_ATTN]; bf16_t* XN = (bf16_t*)(ws + WS_R1);
      f32x4 gv[4];
#pragma unroll
      for (int j = 0; j < 4; ++j) gv[j] = *(const f32x4*)(g + 4 * lane + 256 * j);
      for (int m = gw; m < T_TOK; m += NGW) {
        const GAS f32x4* xr = (const GAS f32x4*)(x + (size_t)m * D_MODEL) + lane;
        f32x4 v[4]; float s = 0.f;
#pragma unroll
        for (int j = 0; j < 4; ++j) { v[j] = xr[64 * j]; s += (v[j].x * v[j].x + v[j].y * v[j].y) + (v[j].z * v[j].z + v[j].w * v[j].w); }
        const float rstd = 1.f / sqrtf(wave_sum(s) * (1.f / D_MODEL) + RMS_EPS);
        GAS v2u* o8 = (GAS v2u*)(XN + (size_t)m * D_MODEL) + lane;
#pragma unroll
        for (int j = 0; j < 4; ++j) { v2u o; o.x = pk2(v[j].x * rstd * gv[j].x, v[j].y * rstd * gv[j].y); o.y = pk2(v[j].z * rstd * gv[j].z, v[j].w * rstd * gv[j].w); o8[64 * j] = o; }
      } }
    { bf16_t* WRhi = (bf16_t*)(ws + WS_WR); bf16_t* WRlo = WRhi + 48 * 1024;
      for (int i = gw * 64 + lane; i < 48 * 1024; i += NGW * 64) { const int c = i >> 10, k = i & 1023;
        const float w = c < 4 ? a->in[IN_WRG][k * 4 + c] : (c < 36 ? a->in[IN_WRE][k * 32 + (c - 4)] : 0.f);
        const unsigned hi = f2bf(w); WRhi[i] = (bf16_t)hi; WRlo[i] = (bf16_t)f2bf(w - bf2f((unsigned short)hi)); } }
}

__device__ __forceinline__ void phase5(KArgs a, LAS unsigned char* lds, int, int, int, int vcu, int G) {
    int tid_ = threadIdx.x; asm volatile("" : "+v"(tid_)); const int lane = tid_ & 63, wave = __builtin_amdgcn_readfirstlane(tid_ >> 6); const int tid = tid_;
    unsigned char* ws = a->ws;
    const float* x1 = a->out; const float* g2 = a->in[IN_NORM_MOE];
    bf16_t* H2 = (bf16_t*)(ws + WS_R1);
    const bf16_t* WRhi = (const bf16_t*)(ws + WS_WR); const bf16_t* WRlo = WRhi + 48 * 1024;
    float* RINV = (float*)(ws + WS_SMALL + SM_RINV); int* EID = (int*)(ws + WS_SMALL + SM_EID); float* GATE = (float*)(ws + WS_SMALL + SM_GATE);
    int* LRANK = (int*)(ws + WS_SMALL + SM_LRANK); int* CNT = (int*)(ws + WS_SMALL + SM_CNT);
    LAS float* PL = (LAS float*)lds;
    LAS float* PS = PL + 2 * 4 * 16 * 49;
    LAS int* EL = (LAS int*)(PS + 2 * 4 * 16);
    const int tg = wave & 3, kh = wave >> 2, r16 = lane & 15, kq = lane >> 4;
    for (int wgi = vcu; wgi < T_TOK / 64; wgi += G) {
        const int row = 64 * wgi + 16 * tg + r16;
        f32x4 acc[3]; acc[0] = acc[1] = acc[2] = (f32x4){0.f, 0.f, 0.f, 0.f};
        float ssq = 0.f;
#pragma unroll 4
        for (int ks = 0; ks < 16; ++ks) {
            const int k0 = kh * 512 + ks * 32 + kq * 8;
            const f32x4 xa = *(const f32x4*)(x1 + (size_t)row * D_MODEL + k0), xb = *(const f32x4*)(x1 + (size_t)row * D_MODEL + k0 + 4);
            const f32x4 ga = *(const f32x4*)(g2 + k0), gb = *(const f32x4*)(g2 + k0 + 4);
            ssq += (xa.x * xa.x + xa.y * xa.y) + (xa.z * xa.z + xa.w * xa.w) + (xb.x * xb.x + xb.y * xb.y) + (xb.z * xb.z + xb.w * xb.w);
            float v[8] = {xa.x * ga.x, xa.y * ga.y, xa.z * ga.z, xa.w * ga.w, xb.x * gb.x, xb.y * gb.y, xb.z * gb.z, xb.w * gb.w};
            unsigned hi[8], lo[8];
#pragma unroll
            for (int i = 0; i < 8; ++i) { hi[i] = f2bf(v[i]); lo[i] = f2bf(v[i] - __uint_as_float(hi[i] << 16)); }
            v4u hw, lw;
            hw.x = hi[0] | (hi[1] << 16); hw.y = hi[2] | (hi[3] << 16); hw.z = hi[4] | (hi[5] << 16); hw.w = hi[6] | (hi[7] << 16);
            lw.x = lo[0] | (lo[1] << 16); lw.y = lo[2] | (lo[3] << 16); lw.z = lo[4] | (lo[5] << 16); lw.w = lo[6] | (lo[7] << 16);
            *(v4u*)(H2 + (size_t)row * D_MODEL + k0) = hw;
            const bf16x8 ahi = __builtin_bit_cast(bf16x8, hw), alo = __builtin_bit_cast(bf16x8, lw);
#pragma unroll
            for (int nt = 0; nt < 3; ++nt) {
                const bf16x8 bh = *(const bf16x8*)(WRhi + (size_t)(nt * 16 + r16) * 1024 + k0), bl = *(const bf16x8*)(WRlo + (size_t)(nt * 16 + r16) * 1024 + k0);
                acc[nt] = __builtin_amdgcn_mfma_f32_16x16x32_bf16(ahi, bh, acc[nt], 0, 0, 0);
                acc[nt] = __builtin_amdgcn_mfma_f32_16x16x32_bf16(ahi, bl, acc[nt], 0, 0, 0);
                acc[nt] = __builtin_amdgcn_mfma_f32_16x16x32_bf16(alo, bh, acc[nt], 0, 0, 0);
            }
        }
        ssq += __shfl_xor(ssq, 16); ssq += __shfl_xor(ssq, 32);
        __syncthreads();
#pragma unroll
        for (int nt = 0; nt < 3; ++nt)
#pragma unroll
            for (int rg = 0; rg < 4; ++rg) PL[((kh * 4 + tg) * 16 + 4 * kq + rg) * 49 + nt * 16 + r16] = acc[nt][rg];
        if (kq == 0) PS[(kh * 4 + tg) * 16 + r16] = ssq;
        __syncthreads();
        if (wave < 4 && lane < 16) {
            const int tl = lane, tok = 64 * wgi + 16 * tg + tl;
            const float ss = PS[(0 * 4 + tg) * 16 + tl] + PS[(1 * 4 + tg) * 16 + tl];
            const float rinv = 1.0f / sqrtf(ss * (1.0f / D_MODEL) + RMS_EPS);
            const LAS float* p0 = PL + ((0 * 4 + tg) * 16 + tl) * 49; const LAS float* p1 = PL + ((1 * 4 + tg) * 16 + tl) * 49;
            float gl[NEG]; float gm = -INFINITY; int gs = 0;
#pragma unroll
            for (int i = 0; i < NEG; ++i) { gl[i] = rinv * (p0[i] + p1[i]) + a->in[IN_BRG][i]; if (gl[i] > gm) { gm = gl[i]; gs = i; } }
            float gsum = 0.f;
#pragma unroll
            for (int i = 0; i < NEG; ++i) gsum += expf(gl[i] - gm);
            const float pg = 1.0f / gsum;
            float el[EPG]; float em = -INFINITY;
#pragma unroll
            for (int i = 0; i < EPG; ++i) { const int c = 4 + gs * EPG + i; el[i] = rinv * (p0[c] + p1[c]) + a->in[IN_BRE][gs * EPG + i]; em = fmaxf(em, el[i]); }
            float esum = 0.f;
#pragma unroll
            for (int i = 0; i < EPG; ++i) esum += expf(el[i] - em);
            int i0 = 0;
#pragma unroll
            for (int i = 1; i < EPG; ++i) if (el[i] > el[i0]) i0 = i;
            int i1 = (i0 == 0) ? 1 : 0;
#pragma unroll
            for (int i = 0; i < EPG; ++i) if (i != i0 && el[i] > el[i1]) i1 = i;
            float e0v = 0.f, e1v = 0.f;
#pragma unroll
            for (int i = 0; i < EPG; ++i) { if (i == i0) e0v = el[i]; if (i == i1) e1v = el[i]; }
            const int ea = gs * EPG + i0, eb = gs * EPG + i1;
            EID[tok * 2] = ea; EID[tok * 2 + 1] = eb;
            GATE[tok * 2] = pg * expf(e0v - em) / esum; GATE[tok * 2 + 1] = pg * expf(e1v - em) / esum;
            RINV[tok] = rinv;
            EL[(16 * tg + tl) * 2] = ea; EL[(16 * tg + tl) * 2 + 1] = eb;
        }
        __syncthreads();
        if (tid < 128) { const int e = EL[tid]; int rk = 0; for (int j = 0; j < tid; ++j) rk += (EL[j] == e) ? 1 : 0; LRANK[wgi * 128 + tid] = rk; }
        else if (tid < 160) { const int e = tid - 128; int c = 0; for (int j = 0; j < 128; ++j) c += (EL[j] == e) ? 1 : 0; CNT[wgi * 32 + e] = c; }
    }
    __syncthreads();
}

__device__ __forceinline__ void phase6(KArgs a, LAS unsigned char* lds, int, int, int, int vcu, int G) {
    int tid_ = threadIdx.x; asm volatile("" : "+v"(tid_)); const int lane = tid_ & 63, wave = __builtin_amdgcn_readfirstlane(tid_ >> 6); const int tid = tid_;
    unsigned char* ws = a->ws;
    const bf16_t* H2 = (const bf16_t*)(ws + WS_R1); bf16_t* ROWS = (bf16_t*)(ws + WS_ROWS);
    const float* RINV = (const float*)(ws + WS_SMALL + SM_RINV); const int* EID = (const int*)(ws + WS_SMALL + SM_EID); const float* GATE = (const float*)(ws + WS_SMALL + SM_GATE);
    const int* LRANK = (const int*)(ws + WS_SMALL + SM_LRANK); const int* CNT = (const int*)(ws + WS_SMALL + SM_CNT);
    int* DEST = (int*)(ws + WS_SMALL + SM_DEST); int* TOKROW = (int*)(ws + WS_SMALL + SM_TOKROW); float* ROWSC = (float*)(ws + WS_SMALL + SM_ROWSC); float* ROWGT = (float*)(ws + WS_SMALL + SM_ROWGT);
    int* TILEE = (int*)(ws + WS_SMALL + SM_TILEE); int* META = (int*)(ws + WS_SMALL + SM_META);
    LAS int* totS = (LAS int*)lds; LAS int* preS = totS + 32; LAS int* pstS = preS + 32; LAS int* dstS = pstS + 32;
    for (int wgi = vcu; wgi < T_TOK / 64; wgi += G) {
        __syncthreads();
        if (tid < 32) { int tot = 0, pre = 0; for (int w = 0; w < T_TOK / 64; ++w) { const int c = CNT[w * 32 + tid]; tot += c; pre += (w < wgi) ? c : 0; } totS[tid] = tot; preS[tid] = pre; }
        __syncthreads();
        if (tid == 0) { int run = 0; for (int e = 0; e < NE; ++e) { pstS[e] = run; run += ((totS[e] + 255) >> 8) << 8; }
            if (wgi == 0) { META[0] = run >> 8; for (int e = 0; e < NE; ++e) { const int t0 = pstS[e] >> 8, nt = (totS[e] + 255) >> 8; for (int j = 0; j < nt; ++j) TILEE[t0 + j] = e; } } }
        __syncthreads();
        if (tid < 128) { const int tok = 64 * wgi + (tid >> 1); const int e = EID[wgi * 128 + tid]; const int dest = pstS[e] + preS[e] + LRANK[wgi * 128 + tid];
            TOKROW[dest] = tok; ROWSC[dest] = RINV[tok]; ROWGT[dest] = GATE[wgi * 128 + tid]; DEST[wgi * 128 + tid] = dest; dstS[tid] = dest; }
        if (wgi == 0) { for (int e = 0; e < NE; ++e) { const int lo = pstS[e] + totS[e], hi = pstS[e] + (((totS[e] + 255) >> 8) << 8); for (int r = lo + tid; r < hi; r += 512) { TOKROW[r] = -1; ROWSC[r] = 0.f; ROWGT[r] = 0.f; } } }
        __syncthreads();
        for (int as = wave; as < 128; as += 8) { const int tok = 64 * wgi + (as >> 1), dest = dstS[as];
            const GAS v4u* src = (const GAS v4u*)(H2 + (size_t)tok * D_MODEL) + lane; GAS v4u* dst = (GAS v4u*)(ROWS + (size_t)dest * D_MODEL) + lane;
            const v4u r0 = src[0], r1 = src[64]; dst[0] = r0; dst[64] = r1; }
    }
    __syncthreads();
}

__device__ __forceinline__ void phase9(KArgs a, int, int, int vcu, int G) {
    int tid_ = threadIdx.x; asm volatile("" : "+v"(tid_)); const int lane = tid_ & 63, wave = __builtin_amdgcn_readfirstlane(tid_ >> 6);
    unsigned char* ws = a->ws; float* out = a->out; const float* gf = a->in[IN_NORM_FINAL];
    const bf16_t* Y = (const bf16_t*)(ws + WS_ROWS); const int* DEST = (const int*)(ws + WS_SMALL + SM_DEST);
    const int gw = vcu * 8 + wave, NGW = G * 8;
    f32x4 gv[4];
#pragma unroll
    for (int j = 0; j < 4; ++j) gv[j] = *(const f32x4*)(gf + 4 * lane + 256 * j);
    for (int m = gw; m < T_TOK; m += NGW) {
        const int d0 = DEST[m * 2], d1 = DEST[m * 2 + 1];
        GAS f32x4* xr = (GAS f32x4*)(out + (size_t)m * D_MODEL) + lane;
        const GAS v2u* y0 = (const GAS v2u*)(Y + (size_t)d0 * D_MODEL) + lane; const GAS v2u* y1 = (const GAS v2u*)(Y + (size_t)d1 * D_MODEL) + lane;
        f32x4 v[4]; float s = 0.f;
#pragma unroll
        for (int j = 0; j < 4; ++j) { v[j] = xr[64 * j]; const v2u p = y0[64 * j], q = y1[64 * j];
            v[j].x += pg8::bf_lo(p.x) + pg8::bf_lo(q.x); v[j].y += pg8::bf_hi(p.x) + pg8::bf_hi(q.x); v[j].z += pg8::bf_lo(p.y) + pg8::bf_lo(q.y); v[j].w += pg8::bf_hi(p.y) + pg8::bf_hi(q.y);
            s += (v[j].x * v[j].x + v[j].y * v[j].y) + (v[j].z * v[j].z + v[j].w * v[j].w); }
        const float rstd = 1.f / sqrtf(wave_sum(s) * (1.f / D_MODEL) + RMS_EPS);
#pragma unroll
        for (int j = 0; j < 4; ++j) xr[64 * j] = v[j] * rstd * gv[j];
    }
}


namespace att {
typedef float f32x16 __attribute__((ext_vector_type(16)));
typedef short s16x4 __attribute__((ext_vector_type(4)));
typedef short v4i16_t __attribute__((ext_vector_type(4)));
constexpr int KBUF = 8192, VBUF = 16384, SLOT = KBUF + VBUF, OST = 2 * SLOT, WSF = OST + 8 * 8192, ATT_LDS = WSF + 8 * 256;
constexpr float THR = 8.0f;
__device__ __forceinline__ int crow(int r, int hi) { return (r & 3) + 8 * (r >> 2) + 4 * hi; }
__device__ __forceinline__ unsigned cvtpk(float lo, float hi) { typedef float f2 __attribute__((ext_vector_type(2))); typedef __bf16 b2 __attribute__((ext_vector_type(2))); f2 v = {lo, hi}; b2 b = __builtin_convertvector(v, b2); return __builtin_bit_cast(unsigned, b); }
__device__ __forceinline__ s16x4 vtr(const LAS unsigned char* p) { return __builtin_bit_cast(s16x4, __builtin_amdgcn_ds_read_tr16_b64_v4i16((LAS v4i16_t*)p)); }
#define MX3(a, b, c) __builtin_fmaxf(__builtin_fmaxf((a), (b)), (c))
__device__ __forceinline__ float rowmax(const f32x16& p0, const f32x16& p1) {
    float a = MX3(p0[0], p0[1], p1[0]), b = MX3(p0[2], p0[3], p1[1]); a = MX3(a, p1[2], p1[3]);
#pragma unroll
    for (int r = 4; r < 16; r += 4) { a = MX3(a, p0[r], p0[r + 1]); b = MX3(b, p0[r + 2], p0[r + 3]); a = MX3(a, p1[r], p1[r + 1]); b = MX3(b, p1[r + 2], p1[r + 3]); }
    float m = __builtin_fmaxf(a, b); auto rr = __builtin_amdgcn_permlane32_swap(__float_as_uint(m), __float_as_uint(m), false, false);
    return __builtin_fmaxf(__uint_as_float(rr[0]), __uint_as_float(rr[1]));
}
#undef MX3

__device__ __forceinline__ void attn_part(int b, int h, int mp, int qb, int t_lo, int t_hi, const bf16_t* __restrict__ Q, const bf16_t* __restrict__ K, const bf16_t* __restrict__ V,
                                          bf16_t* __restrict__ PBs, float* __restrict__ MLs, LAS unsigned char* lds) {
    int tid_ = threadIdx.x; asm volatile("" : "+v"(tid_));
    const int lane = tid_ & 63, wid = __builtin_amdgcn_readfirstlane(tid_ >> 6);
    const int r32 = lane & 31, hi = lane >> 5;
    const int rowbase = b * SEQ, q0 = qb * 256, NT = t_hi - t_lo;
    const int qabs = q0 + wid * 32 + r32;
    const float slope2 = exp2f(-2.0f * (float)(h + 1)) * LOG2E;
    const bf16_t* Qw = Q + (size_t)(rowbase + q0 + wid * 32) * 512 + h * 128 + mp * 64;
    bf16x8 qr[4];
#pragma unroll
    for (int d0 = 0; d0 < 4; ++d0) qr[d0] = *(const bf16x8*)(Qw + (size_t)r32 * 512 + d0 * 16 + hi * 8);
    const bf16_t* ksrc = K + (size_t)(rowbase + lane) * 512 + h * 128 + mp * 64 + wid * 8;
    const int p0i = 2 * wid, p1i = 2 * wid + 1;
    const bf16_t* vsrc0 = V + (size_t)(rowbase + 16 * (p0i & 3) + (lane >> 2)) * 512 + h * 128 + (p0i >> 2) * 32 + (lane & 3) * 8;
    const bf16_t* vsrc1 = V + (size_t)(rowbase + 16 * (p1i & 3) + (lane >> 2)) * 512 + h * 128 + (p1i >> 2) * 32 + (lane & 3) * 8;
#define ATT_DMA(t, kso, vso) do { const size_t go_ = (size_t)(t) * 64 * 512; \
        __builtin_amdgcn_global_load_lds((const unsigned*)(ksrc + go_), (LAS unsigned*)(lds + (kso) + wid * 1024), 16, 0, 0); \
        __builtin_amdgcn_global_load_lds((const unsigned*)(vsrc0 + go_), (LAS unsigned*)(lds + (vso) + p0i * 1024), 16, 0, 0); \
        __builtin_amdgcn_global_load_lds((const unsigned*)(vsrc1 + go_), (LAS unsigned*)(lds + (vso) + p1i * 1024), 16, 0, 0); } while (0)
    LAS float* wsf = (LAS float*)(lds + 65536 + wid * 8192);
    float mref = 0.f, l_reg = 0.f; bool started = false;
    f32x16 o[4];
#pragma unroll
    for (int d = 0; d < 4; ++d) o[d] = (f32x16){};
    const int voff_lane = ((lane >> 4) & 1) * 32 + (lane & 3) * 8 + (4 * hi + ((lane & 15) >> 2)) * 64;
    s16x4 va[8], vb[8];
#define VLOAD(dst, vp, d) do { _Pragma("unroll") for (int ks_ = 0; ks_ < 4; ++ks_) { dst[2 * ks_] = vtr((vp) + (d) * 4096 + ks_ * 1024); dst[2 * ks_ + 1] = vtr((vp) + (d) * 4096 + ks_ * 1024 + 512); } } while (0)
#define VMMA(src, pw_, d) do { _Pragma("unroll") for (int ks_ = 0; ks_ < 4; ++ks_) { const bf16x8 vf_ = (bf16x8){src[2 * ks_][0], src[2 * ks_][1], src[2 * ks_][2], src[2 * ks_][3], src[2 * ks_ + 1][0], src[2 * ks_ + 1][1], src[2 * ks_ + 1][2], src[2 * ks_ + 1][3]}; \
        o[d] = __builtin_amdgcn_mfma_f32_32x32x16_bf16(__builtin_bit_cast(bf16x8, pw_[ks_]), vf_, o[d], 0, 0, 0); } } while (0)
#define QKT(t, kso) do { const float tb_ = slope2 * (float)(64 * (t) + 4 * hi - qabs) - (started ? mref : 0.f), tb1_ = tb_ + 32.0f * slope2; \
        _Pragma("unroll") for (int r = 0; r < 16; ++r) { const float kr_ = (float)((r & 3) + 8 * (r >> 2)); c0[r] = __builtin_fmaf(slope2, kr_, tb_); c1[r] = __builtin_fmaf(slope2, kr_, tb1_); } \
        const LAS unsigned char* kp_ = lds + (kso) + hi * 1024 + r32 * 16; bf16x8 kf_[8]; \
        _Pragma("unroll") for (int d0 = 0; d0 < 4; ++d0) { kf_[2 * d0] = *(const LAS bf16x8*)(kp_ + d0 * 2048); kf_[2 * d0 + 1] = *(const LAS bf16x8*)(kp_ + d0 * 2048 + 512); } \
        __builtin_amdgcn_sched_barrier(0); \
        _Pragma("unroll") for (int d0 = 0; d0 < 4; ++d0) { c0 = __builtin_amdgcn_mfma_f32_32x32x16_bf16(kf_[2 * d0], qr[d0], c0, 0, 0, 0); c1 = __builtin_amdgcn_mfma_f32_32x32x16_bf16(kf_[2 * d0 + 1], qr[d0], c1, 0, 0, 0); } } while (0)
#define DECIDE(resc_) do { const float rm_ = rowmax(c0, c1); resc_ = false; \
        if (!started) { mref = rm_; _Pragma("unroll") for (int r = 0; r < 16; ++r) { c0[r] -= rm_; c1[r] -= rm_; } started = true; } \
        else if (__any(rm_ > THR)) { const float dl_ = __builtin_fmaxf(rm_, 0.f); mref += dl_; _Pragma("unroll") for (int r = 0; r < 16; ++r) { c0[r] -= dl_; c1[r] -= dl_; } \
            const float f_ = __builtin_amdgcn_exp2f(-dl_); l_reg *= f_; if (hi == 0) wsf[r32] = f_; resc_ = true; } } while (0)
#define ORESC() do { float fr_[16]; _Pragma("unroll") for (int r = 0; r < 16; ++r) fr_[r] = wsf[crow(r, hi)]; \
        _Pragma("unroll") for (int d = 0; d < 4; ++d) _Pragma("unroll") for (int r = 0; r < 16; ++r) o[d][r] *= fr_[r]; } while (0)
#define EXPPACK(cc, base, pwout) do { float s_ = 0.f; _Pragma("unroll") for (int r = 0; r < 8; ++r) { cc[(base) + r] = __builtin_amdgcn_exp2f(cc[(base) + r]); s_ += cc[(base) + r]; } l_reg += s_; \
        _Pragma("unroll") for (int i_ = 0; i_ < 4; ++i_) pwout[i_] = cvtpk(cc[(base) + 2 * i_], cc[(base) + 2 * i_ + 1]); } while (0)
    int kso_c = 0, vso_c = 16384;
    ATT_DMA(t_hi - 1, kso_c, vso_c);
    VM_WAIT();
    __syncthreads();
    const int n_simple = (t_hi == 4 * qb + 4) ? (NT < 4 ? NT : 4) : 1;
    int it = 0;
    for (; it < n_simple; ++it) {
        const int t = t_hi - 1 - it;
        const int kso_n = kso_c ^ 8192, vso_n = (vso_c == 16384 + 2 * 16384) ? 16384 : vso_c + 16384;
        if (it + 1 < NT) ATT_DMA(t - 1, kso_n, vso_n);
        const bool active = (64 * t <= q0 + 32 * wid + 31);
        if (active) {
            f32x16 c0, c1;
            QKT(t, kso_c);
            const LAS unsigned char* vp = lds + vso_c + voff_lane;
            __builtin_amdgcn_sched_barrier(0);
            VLOAD(va, vp, 0); VLOAD(vb, vp, 1);
            __builtin_amdgcn_sched_barrier(0);
            if (64 * t + 63 > q0 + 32 * wid) {
#pragma unroll
                for (int r = 0; r < 16; ++r) { const int kv = 64 * t + crow(r, hi); if (kv > qabs) c0[r] = -INFINITY; if (kv + 32 > qabs) c1[r] = -INFINITY; }
            }
            bool resc; DECIDE(resc); if (resc) ORESC();
            v4u pw[4];
            EXPPACK(c0, 0, pw[0]); EXPPACK(c0, 8, pw[1]); EXPPACK(c1, 0, pw[2]); EXPPACK(c1, 8, pw[3]);
            VMMA(va, pw, 0); __builtin_amdgcn_sched_barrier(0);
            VLOAD(va, vp, 2); __builtin_amdgcn_sched_barrier(0);
            VMMA(vb, pw, 1); __builtin_amdgcn_sched_barrier(0);
            VLOAD(vb, vp, 3); __builtin_amdgcn_sched_barrier(0);
            VMMA(va, pw, 2); VMMA(vb, pw, 3);
        }
        VM_WAIT();
        __syncthreads();
        kso_c = kso_n; vso_c = vso_n;
    }
    if (it < NT) {
        v4u pwp[4];
        int vso_p;
        {
            const int t = t_hi - 1 - it;
            const int kso_n = kso_c ^ 8192, vso_n = (vso_c == 16384 + 2 * 16384) ? 16384 : vso_c + 16384;
            if (it + 1 < NT) ATT_DMA(t - 1, kso_n, vso_n);
            f32x16 c0, c1;
            QKT(t, kso_c);
            bool resc; DECIDE(resc); if (resc) ORESC();
            EXPPACK(c0, 0, pwp[0]); EXPPACK(c0, 8, pwp[1]); EXPPACK(c1, 0, pwp[2]); EXPPACK(c1, 8, pwp[3]);
            VM_WAIT();
            __syncthreads();
            vso_p = vso_c; kso_c = kso_n; vso_c = vso_n; ++it;
        }
        for (; it < NT; ++it) {
            const int t = t_hi - 1 - it;
            const int kso_n = kso_c ^ 8192, vso_n = (vso_c == 16384 + 2 * 16384) ? 16384 : vso_c + 16384;
            if (it + 1 < NT) ATT_DMA(t - 1, kso_n, vso_n);
            f32x16 c0, c1;
            QKT(t, kso_c);
            const LAS unsigned char* vp = lds + vso_p + voff_lane;
            __builtin_amdgcn_sched_barrier(0);
            VLOAD(va, vp, 0); VLOAD(vb, vp, 1);
            __builtin_amdgcn_sched_barrier(0);
            bool resc; DECIDE(resc);
            __builtin_amdgcn_sched_barrier(0);
            v4u pwc[4];
            VMMA(va, pwp, 0); EXPPACK(c0, 0, pwc[0]); __builtin_amdgcn_sched_barrier(0);
            VLOAD(va, vp, 2); VMMA(vb, pwp, 1); EXPPACK(c0, 8, pwc[1]); __builtin_amdgcn_sched_barrier(0);
            VLOAD(vb, vp, 3); VMMA(va, pwp, 2); EXPPACK(c1, 0, pwc[2]); __builtin_amdgcn_sched_barrier(0);
            VMMA(vb, pwp, 3); EXPPACK(c1, 8, pwc[3]); __builtin_amdgcn_sched_barrier(0);
            if (resc) ORESC();
#pragma unroll
            for (int k_ = 0; k_ < 4; ++k_) pwp[k_] = pwc[k_];
            VM_WAIT();
            __syncthreads();
            vso_p = vso_c; kso_c = kso_n; vso_c = vso_n;
        }
        {
            const LAS unsigned char* vp = lds + vso_p + voff_lane;
            VLOAD(va, vp, 0); VLOAD(vb, vp, 1);
            VMMA(va, pwp, 0); __builtin_amdgcn_sched_barrier(0);
            VLOAD(va, vp, 2); __builtin_amdgcn_sched_barrier(0);
            VMMA(vb, pwp, 1); __builtin_amdgcn_sched_barrier(0);
            VLOAD(vb, vp, 3); __builtin_amdgcn_sched_barrier(0);
            VMMA(va, pwp, 2); VMMA(vb, pwp, 3);
        }
        __syncthreads();
    }
#undef ATT_DMA
#undef VLOAD
#undef VMMA
#undef QKT
#undef DECIDE
#undef ORESC
#undef EXPPACK
    { auto rr = __builtin_amdgcn_permlane32_swap(__float_as_uint(l_reg), __float_as_uint(l_reg), false, false); l_reg = __uint_as_float(rr[0]) + __uint_as_float(rr[1]); }
    if (hi == 0) { typedef float f2v __attribute__((ext_vector_type(2))); *(f2v*)(MLs + (size_t)(wid * 32 + r32) * 2) = (f2v){started ? mref : -1e30f, l_reg}; }
    LAS bf16_t* stg = (LAS bf16_t*)(lds + 65536 + wid * 8192);
#pragma unroll
    for (int r = 0; r < 16; ++r)
#pragma unroll
        for (int d = 0; d < 4; d += 1) stg[crow(r, hi) * 128 + d * 32 + r32] = (bf16_t)f2bf(o[d][r]);
    bf16_t* Ow = PBs + (size_t)(wid * 32) * 128;
#pragma unroll
    for (int i = 0; i < 8; ++i) { const int row = 4 * i + (lane >> 4), ch = lane & 15; const v4u v = *(const LAS v4u*)(stg + row * 128 + ch * 8); *(v4u*)(Ow + (size_t)row * 128 + ch * 8) = v; }
    __syncthreads();
}
}

namespace s5 {
typedef float f32x16 __attribute__((ext_vector_type(16)));
typedef short s16x4 __attribute__((ext_vector_type(4)));
typedef short v4i16_t __attribute__((ext_vector_type(4)));
constexpr int ES_OFF = 132096, KAP_OFF = ES_OFF + 4096;
__device__ __forceinline__ s16x4 vtr(const LAS unsigned char* p) { return __builtin_bit_cast(s16x4, __builtin_amdgcn_ds_read_tr16_b64_v4i16((LAS v4i16_t*)p)); }
__device__ __forceinline__ void s5_unit(int b, int g, KArgs a, LAS unsigned char* lds) {
    int tid_ = threadIdx.x; asm volatile("" : "+v"(tid_));
    const int lane = tid_ & 63, wid = __builtin_amdgcn_readfirstlane(tid_ >> 6);
    const bf16_t* U = (const bf16_t*)(a->ws + WS_U); bf16_t* Yg = (bf16_t*)(a->ws + WS_YG);
    const int n = lane, r32 = lane & 31, hi = lane >> 5, r16 = lane & 15, kq = lane >> 4;
    LAS unsigned char* wl = lds + wid * 16384;
    LAS float* es = (LAS float*)(lds + ES_OFF);
    LAS float* kap = (LAS float*)(lds + KAP_OFF) + wid * 128;
    LAS unsigned char* us = lds + 140288 + wid * 1024;
    const double dt = exp((double)a->in[IN_LOG_DT][g]);
    const double lr = a->in[IN_LAM_RE][g * NS + n], li = a->in[IN_LAM_IM][g * NS + n];
    const double mag = exp(lr * dt);
    const double ar_d = mag * cos(li * dt), ai_d = mag * sin(li * dt);
    const double nr = ar_d - 1.0, ni = ai_d, den = lr * lr + li * li;
    const float ar = (float)ar_d, ai = (float)ai_d;
    kap[n] = (float)((nr * lr + ni * li) / den); kap[64 + n] = (float)((ni * lr - nr * li) / den);
    const double magL = exp(lr * dt * 1024.0);
    const float pr = (float)(magL * cos(li * dt * 1024.0)), pim = (float)(magL * sin(li * dt * 1024.0));
    bf16x8 bfrag[4];
#pragma unroll
    for (int nb = 0; nb < 4; ++nb) {
        const int n2 = 32 * (nb & 1) + r32; const float kr2 = kap[n2], ki2 = kap[64 + n2];
        const float* pre = a->in[IN_B_RE] + (size_t)(g * NS + n2) * GC + 8 * hi; const float* pim_ = a->in[IN_B_IM] + (size_t)(g * NS + n2) * GC + 8 * hi;
        float v[8];
#pragma unroll
        for (int j = 0; j < 8; ++j) v[j] = (nb < 2) ? (kr2 * pre[j] - ki2 * pim_[j]) : (kr2 * pim_[j] + ki2 * pre[j]);
        v4u w; w.x = pk2(v[0], v[1]); w.y = pk2(v[2], v[3]); w.z = pk2(v[4], v[5]); w.w = pk2(v[6], v[7]);
        bfrag[nb] = __builtin_bit_cast(bf16x8, w);
    }
    bf16x8 cfrag[4];
#pragma unroll
    for (int ks = 0; ks < 4; ++ks) {
        const int k0 = 32 * (ks & 1) + 8 * kq; const float* src = a->in[ks < 2 ? IN_C_RE : IN_C_IM] + (size_t)(g * GC + r16) * NS + k0; const float sg = ks < 2 ? 1.f : -1.f;
        v4u w; w.x = pk2(sg * src[0], sg * src[1]); w.y = pk2(sg * src[2], sg * src[3]); w.z = pk2(sg * src[4], sg * src[5]); w.w = pk2(sg * src[6], sg * src[7]);
        cfrag[ks] = __builtin_bit_cast(bf16x8, w);
    }
    const float dsk = a->in[IN_SSM_D][g * GC + r16];
    const int tokbase = b * SEQ + wid * 1024;
    const int sw = n & 7;
    float cr_ = 0.f, ci_ = 0.f;
    for (int pass = 0; pass < 2; ++pass) {
        float xr = cr_, xi = ci_;
        bf16x8 unext = *(const bf16x8*)(U + (size_t)(tokbase + r32) * SSM_W + g * GC + 8 * hi);
        for (int ch = 0; ch < 32; ++ch) {
            const int t0 = tokbase + 32 * ch;
            const bf16x8 ufrag = unext;
            if (ch < 31) unext = *(const bf16x8*)(U + (size_t)(t0 + 32 + r32) * SSM_W + g * GC + 8 * hi);
            *(LAS bf16x8*)(us + r32 * 32 + hi * 16) = ufrag;
#pragma unroll
            for (int nb = 0; nb < 4; ++nb) {
                const f32x16 acc = __builtin_amdgcn_mfma_f32_32x32x16_bf16(ufrag, bfrag[nb], (f32x16){}, 0, 0, 0);
                const int col = 32 * nb + r32;
#pragma unroll
                for (int rr = 0; rr < 4; ++rr) *(LAS f32x4*)(wl + col * 128 + (((2 * rr + hi) ^ (col & 7)) * 16)) = (f32x4){acc[4 * rr], acc[4 * rr + 1], acc[4 * rr + 2], acc[4 * rr + 3]};
            }
            f32x4 bur[8], bui[8];
#pragma unroll
            for (int s = 0; s < 8; ++s) { bur[s] = *(const LAS f32x4*)(wl + n * 128 + ((s ^ sw) * 16)); bui[s] = *(const LAS f32x4*)(wl + (64 + n) * 128 + ((s ^ sw) * 16)); }
            unsigned xrp[16], xip[16];
#pragma unroll
            for (int s = 0; s < 8; ++s) {
                float xa[4], xb[4];
#pragma unroll
                for (int i = 0; i < 4; ++i) { const float nxr = ar * xr - ai * xi + bur[s][i], nxi = ar * xi + ai * xr + bui[s][i]; xr = nxr; xi = nxi; xa[i] = xr; xb[i] = xi; }
                xrp[2 * s] = att::cvtpk(xa[0], xa[1]); xrp[2 * s + 1] = att::cvtpk(xa[2], xa[3]); xip[2 * s] = att::cvtpk(xb[0], xb[1]); xip[2 * s + 1] = att::cvtpk(xb[2], xb[3]);
            }
            if (pass == 1) {
#pragma unroll
                for (int s2 = 0; s2 < 4; ++s2) {
                    *(LAS v4u*)(wl + n * 128 + ((s2 ^ (n & 3)) * 16)) = (v4u){xrp[4 * s2], xrp[4 * s2 + 1], xrp[4 * s2 + 2], xrp[4 * s2 + 3]};
                    *(LAS v4u*)(wl + (64 + n) * 128 + ((s2 ^ (n & 3)) * 16)) = (v4u){xip[4 * s2], xip[4 * s2 + 1], xip[4 * s2 + 2], xip[4 * s2 + 3]};
                }
                const int q = r16 >> 2, p = r16 & 3;
#pragma unroll
                for (int tt = 0; tt < 2; ++tt) {
                    f32x4 acc4 = (f32x4){0.f, 0.f, 0.f, 0.f};
                    const int s2 = 2 * tt + (p >> 1);
#pragma unroll
                    for (int ks = 0; ks < 4; ++ks) {
                        const LAS unsigned char* ad = wl + (32 * ks + 8 * kq + q) * 128 + ((s2 ^ q) * 16) + (p & 1) * 8;
                        const s16x4 lo = vtr(ad), hh = vtr(ad + 4 * 128);
                        const bf16x8 af = (bf16x8){lo[0], lo[1], lo[2], lo[3], hh[0], hh[1], hh[2], hh[3]};
                        acc4 = __builtin_amdgcn_mfma_f32_16x16x32_bf16(af, cfrag[ks], acc4, 0, 0, 0);
                    }
#pragma unroll
                    for (int rg = 0; rg < 4; ++rg) {
                        const size_t tk = (size_t)(t0 + 16 * tt + 4 * kq + rg);
                        const float y = acc4[rg] + dsk * bf2f(*(const LAS unsigned short*)(us + (16 * tt + 4 * kq + rg) * 32 + r16 * 2));
                        const float z = 0.7978845608028654f * (y + 0.044715f * y * y * y);
                        Yg[tk * SSM_W + g * GC + r16] = (bf16_t)f2bf(y * pg8::sigmoid_f(2.0f * z));
                    }
                }
            }
        }
        if (pass == 0) {
            es[(wid * 64 + n) * 2] = xr; es[(wid * 64 + n) * 2 + 1] = xi;
            __syncthreads();
            float c_r = 0.f, c_i = 0.f;
            for (int v = 0; v < wid; ++v) { const float er = es[(v * 64 + n) * 2], ei = es[(v * 64 + n) * 2 + 1]; const float t_r = pr * c_r - pim * c_i + er, t_i = pr * c_i + pim * c_r + ei; c_r = t_r; c_i = t_i; }
            cr_ = c_r; ci_ = c_i;
        }
    }
    __syncthreads();
}
}

constexpr int CW_WQ = 2048, CW_NORMS = 2560;
constexpr int TAB_OFF = 148480;
constexpr int MAXSLOTS = 1024;
constexpr size_t SM_UT = 1608 * KiB;
#ifndef ATT_WINDOW
#define ATT_WINDOW 0
#endif
constexpr float T2_SKIP = 40.0f;
__device__ __forceinline__ void unit_decode(int u, int& b, int& h, int& mp, int& qb) { h = 3 - (u >> 7); qb = 31 - ((u & 127) >> 2); b = (u >> 1) & 1; mp = u & 1; }
__device__ __forceinline__ int build_part_table(KArgs a, LAS unsigned char* lds, int tid, int lane, int wave, bool writer) {
    LAS unsigned short* tab = (LAS unsigned short*)(lds + TAB_OFF); LAS unsigned short* u_tl = tab + 2048; LAS unsigned short* u_st = u_tl + 512; LAS unsigned char* u_P = (LAS unsigned char*)(u_st + 512);
    LAS int* scn = (LAS int*)(lds + TAB_OFF + 4096 + 1024 + 1024 + 512);
    int b, h, mp, qb; unit_decode(tid, b, h, mp, qb);
    int t_lo = 0;
#if ATT_WINDOW
    { const unsigned* nq = (const unsigned*)(a->ws + WS_CTL) + CW_NORMS + b * 16 + h * 4 + mp * 2; const unsigned* nk = nq + 32;
      const float bound = __uint_as_float(__hip_atomic_load(nq, __ATOMIC_RELAXED, __HIP_MEMORY_SCOPE_AGENT)) * __uint_as_float(__hip_atomic_load(nk, __ATOMIC_RELAXED, __HIP_MEMORY_SCOPE_AGENT))
                        + __uint_as_float(__hip_atomic_load(nq + 1, __ATOMIC_RELAXED, __HIP_MEMORY_SCOPE_AGENT)) * __uint_as_float(__hip_atomic_load(nk + 1, __ATOMIC_RELAXED, __HIP_MEMORY_SCOPE_AGENT));
      const float slope2 = exp2f(-2.0f * (float)(h + 1)) * LOG2E;
      const float W = fminf((T2_SKIP + 2.0f * bound) / slope2 + 2.0f, 1.0e6f);
      const int kmin = qb * 256 - (int)W; t_lo = kmin <= 0 ? 0 : (kmin >> 6); }
#endif
    const int NT = 4 * qb + 4 - t_lo;
    const int P32 = (NT + 31) / 32, P48 = (NT + 47) / 48;
    int P = P32, tot = 0, incl = 0;
    for (int attempt = 0; attempt < 2; ++attempt) {
        incl = P;
#pragma unroll
        for (int o = 1; o < 64; o <<= 1) { const int v = __shfl_up(incl, o); if (lane >= o) incl += v; }
        __syncthreads();
        if (lane == 63) scn[wave] = incl;
        __syncthreads();
        int base = 0; tot = 0;
        for (int w = 0; w < 8; ++w) { const int c = scn[w]; if (w < wave) base += c; tot += c; }
        incl += base;
        if (tot <= MAXSLOTS) break;
        P = P48;
    }
    const int start = incl - P;
    u_tl[tid] = (unsigned short)t_lo; u_st[tid] = (unsigned short)start; u_P[tid] = (unsigned char)P;
    for (int p = 0; p < P; ++p) tab[start + p] = (unsigned short)(tid | (p << 9));
    if (writer) { int* UT = (int*)(a->ws + WS_SMALL + SM_UT); UT[tid * 2] = start; UT[tid * 2 + 1] = P; }
    __syncthreads();
    return tot;
}
__device__ __forceinline__ void phase2_mixer(KArgs a, LAS unsigned char* lds, int tid, int lane, int wave, int vcu, int G) {
    unsigned char* ws = a->ws;
    unsigned* wq = (unsigned*)(ws + WS_CTL) + CW_WQ + a->bar_region;
    const int NP = build_part_table(a, lds, tid, lane, wave, vcu == 0);
    LAS unsigned short* tab = (LAS unsigned short*)(lds + TAB_OFF); LAS unsigned short* u_tl = tab + 2048; LAS unsigned char* u_P = (LAS unsigned char*)(tab + 2048 + 1024);
    LAS int* nxt = (LAS int*)(lds + TAB_OFF + 4096 + 1024 + 1024 + 512) + 12;
    const int NITEMS = BATCH * NG + NP;
    for (;;) {
        { int t0_ = threadIdx.x; asm volatile("" : "+v"(t0_)); if (t0_ == 0) *nxt = (int)__hip_atomic_fetch_add(wq, 1u, __ATOMIC_RELAXED, __HIP_MEMORY_SCOPE_AGENT); }
        __syncthreads();
        const int idx = __builtin_amdgcn_readfirstlane(*nxt);
        __syncthreads();
        if (idx >= NITEMS) break;
        KArgs kb = a; asm volatile("" : "+s"(kb));
        if (idx < BATCH * NG) { s5::s5_unit(idx / NG, idx % NG, kb, lds); continue; }
        const int slot = idx - BATCH * NG; const int e = __builtin_amdgcn_readfirstlane((int)tab[slot]); const int u = e & 511, p = e >> 9;
        int b, h, mp, qb; unit_decode(u, b, h, mp, qb);
        const int tl = __builtin_amdgcn_readfirstlane((int)u_tl[u]), P = __builtin_amdgcn_readfirstlane((int)u_P[u]), NT = 4 * qb + 4 - tl;
        unsigned char* wsb = kb->ws;
        att::attn_part(b, h, mp, qb, tl + (NT * p) / P, tl + (NT * (p + 1)) / P, (const bf16_t*)(wsb + WS_Q), (const bf16_t*)(wsb + WS_K), (const bf16_t*)(wsb + WS_V),
                       (bf16_t*)kb->out + (size_t)slot * 256 * 128, (float*)(wsb + WS_O1) + (size_t)slot * 512, lds);
    }
}
__device__ __forceinline__ void attn_finish(KArgs a, int, int, int vcu, int G) {
    int tid_ = threadIdx.x; asm volatile("" : "+v"(tid_)); const int lane = tid_ & 63, wave = __builtin_amdgcn_readfirstlane(tid_ >> 6);
    unsigned char* ws = a->ws;
    const bf16_t* PB = (const bf16_t*)a->out; const float* ML = (const float*)(ws + WS_O1); const int* UT = (const int*)(ws + WS_SMALL + SM_UT); bf16_t* CC = (bf16_t*)(ws + WS_R1);
    float s1 = a->in[IN_LQ1][lane] * a->in[IN_LK1][lane], s2 = a->in[IN_LQ2][lane] * a->in[IN_LK2][lane];
    s1 = wave_sum(s1); s2 = wave_sum(s2);
    const float lam = expf(s1) - expf(s2) + LAM_INIT;
    const int h = lane >> 4, dcol = 8 * (lane & 15);
    float gn[8];
#pragma unroll
    for (int i = 0; i < 8; ++i) gn[i] = a->in[IN_SUBLN][dcol + i] * (1.0f - LAM_INIT);
    const int gw = vcu * 8 + wave, NGW = G * 8;
    typedef float f2v __attribute__((ext_vector_type(2)));
    for (int blk = gw; blk < T_TOK / 4; blk += NGW) {
        const int tok0 = blk * 4, b = tok0 >> 13, pos0 = tok0 & (SEQ - 1), qb = pos0 >> 8, row0 = pos0 & 255;
        int st[2], Pn[2];
#pragma unroll
        for (int mp = 0; mp < 2; ++mp) { const int u = ((3 - h) << 7) | ((31 - qb) << 2) | (b << 1) | mp; st[mp] = UT[u * 2]; Pn[mp] = UT[u * 2 + 1]; }
        float om[2][4][8];
#pragma unroll
        for (int mp = 0; mp < 2; ++mp) {
            f2v ml[4][4];
#pragma unroll
            for (int p = 0; p < 4; ++p)
#pragma unroll
                for (int j = 0; j < 4; ++j) { const int sp = st[mp] + (p < Pn[mp] ? p : 0); f2v t = *(const f2v*)(ML + ((size_t)sp * 256 + row0 + j) * 2); if (p >= Pn[mp]) t = (f2v){-1e30f, 0.f}; ml[p][j] = t; }
            v4u xv[4][4];
#pragma unroll
            for (int p = 0; p < 4; ++p)
#pragma unroll
                for (int j = 0; j < 4; ++j) { const int sp = st[mp] + (p < Pn[mp] ? p : 0); xv[p][j] = *(const v4u*)(PB + ((size_t)sp * 256 + row0 + j) * 128 + dcol); }
#pragma unroll
            for (int j = 0; j < 4; ++j) {
                const float M = fmaxf(fmaxf(ml[0][j].x, ml[1][j].x), fmaxf(ml[2][j].x, ml[3][j].x));
                float L = 0.f, acc[8] = {0.f, 0.f, 0.f, 0.f, 0.f, 0.f, 0.f, 0.f};
#pragma unroll
                for (int p = 0; p < 4; ++p) { const float w = __builtin_amdgcn_exp2f(ml[p][j].x - M); L += w * ml[p][j].y; const v4u x = xv[p][j];
                    acc[0] += w * pg8::bf_lo(x.x); acc[1] += w * pg8::bf_hi(x.x); acc[2] += w * pg8::bf_lo(x.y); acc[3] += w * pg8::bf_hi(x.y);
                    acc[4] += w * pg8::bf_lo(x.z); acc[5] += w * pg8::bf_hi(x.z); acc[6] += w * pg8::bf_lo(x.w); acc[7] += w * pg8::bf_hi(x.w); }
                const float rl = 1.0f / L;
#pragma unroll
                for (int i = 0; i < 8; ++i) om[mp][j][i] = acc[i] * rl;
            }
        }
#pragma unroll
        for (int j = 0; j < 4; ++j) {
            float v[8]; float ss = 0.f;
#pragma unroll
            for (int i = 0; i < 8; ++i) { v[i] = om[0][j][i] - lam * om[1][j][i]; ss += v[i] * v[i]; }
            ss += __shfl_xor(ss, 1); ss += __shfl_xor(ss, 2); ss += __shfl_xor(ss, 4); ss += __shfl_xor(ss, 8);
            const float r = 1.0f / sqrtf(ss * (1.0f / DV) + RMS_EPS);
            v4u w; w.x = pk2(v[0] * r * gn[0], v[1] * r * gn[1]); w.y = pk2(v[2] * r * gn[2], v[3] * r * gn[3]); w.z = pk2(v[4] * r * gn[4], v[5] * r * gn[5]); w.w = pk2(v[6] * r * gn[6], v[7] * r * gn[7]);
            *(v4u*)(CC + (size_t)(tok0 + j) * D_MODEL + 512 + 8 * lane) = w;
        }
    }
}

__global__ void __launch_bounds__(512, 2) mk_fwd(Args args) {
    extern __shared__ __attribute__((aligned(16))) unsigned char lds_raw[];
    LAS unsigned char* lds = (LAS unsigned char*)lds_raw;
    const int tid = threadIdx.x, lane = tid & 63, wave = __builtin_amdgcn_readfirstlane(tid >> 6);
    const int G = gridDim.x; const int bx = blockIdx.x; const int vcu = (G % 8 == 0) ? (bx % 8) * (G / 8) + bx / 8 : bx;
    unsigned char* ws = args.ws;
    const KArgs ka = (KArgs)__builtin_amdgcn_kernarg_segment_ptr();
    volatile LAS unsigned* MISC = (volatile LAS unsigned*)(lds + MISC_OFF);
    for (int u = tid; u < (LDS_BYTES - LDSCTL_OFF) / 4; u += 512) ((LAS unsigned*)(lds + LDSCTL_OFF))[u] = 0u;
    __syncthreads();
    const int lo = args.ph_lo, hi = args.ph_hi;
    unsigned* barw = (unsigned*)(ws + WS_CTL) + CW_BAR + args.bar_region * XCD_BAR_WORDS;
    XcdBarrier bar; bar.bar = barw; bar.x = 0; bar.st = nullptr;
    if (hi - lo > 1) bar = xcd_barrier_post(barw, MISC + 8);
#define IN(k) (lo <= (k) && (k) < hi)
#define SEAM(k) do { if (IN(k) && IN((k) + 1)) xcd_barrier(bar); } while (0)
    if (IN(0)) { phase0(ka, lds, lane, wave, vcu, G); } SEAM(0);
    if (IN(1)) { pg8::Gemm g{(const bf16_t*)(ws + WS_R1), (const bf16_t*)(ws + WS_WTIN), T_TOK, IN_COLS, D_MODEL}; pg8::StaticOrder S; S.init(T_TOK, IN_COLS, G, bx);
        pg8::EpiInProj E{(bf16_t*)(ws + WS_Q), (unsigned*)(ws + WS_CTL) + CW_NORMS};
        pg8::gemm_phase<pg8::EpiInProj, pg8::StaticOrder, true, true>(lds, g, S, E); } SEAM(1);
    if (IN(2)) { phase2_mixer(ka, lds, tid, lane, wave, vcu, G); } SEAM(2);
    if (IN(3)) { pg8::Gemm g{(const bf16_t*)(ws + WS_YG), (const bf16_t*)(ws + WS_WTGLU), T_TOK, SSM_W, SSM_W}; pg8::StaticOrder S; S.init(T_TOK, SSM_W, G, bx);
        pg8::EpiGlu E{(const bf16_t*)(ws + WS_YG), args.in[IN_B_GLU], (bf16_t*)(ws + WS_R1), (float*)(ws + WS_SMALL + SM_SSQP)};
        pg8::gemm_phase<pg8::EpiGlu, pg8::StaticOrder, true, true>(lds, g, S, E); attn_finish(ka, lane, wave, vcu, G); } SEAM(3);
    if (IN(4)) { pg8::Gemm g{(const bf16_t*)(ws + WS_R1), (const bf16_t*)(ws + WS_WTOUT), T_TOK, D_MODEL, D_MODEL}; pg8::StaticOrder S; S.init(T_TOK, D_MODEL, G, bx);
        pg8::EpiOut E{args.in[IN_X], args.out, (const float*)(ws + WS_SMALL + SM_SSQP)};
        pg8::gemm_phase<pg8::EpiOut, pg8::StaticOrder, true, true>(lds, g, S, E); } SEAM(4);
    if (IN(5)) { phase5(ka, lds, tid, lane, wave, vcu, G); } SEAM(5);
    if (IN(6)) { phase6(ka, lds, tid, lane, wave, vcu, G); } SEAM(6);
    if (IN(7)) { const int ntiles = __builtin_amdgcn_readfirstlane(((const int*)(ws + WS_SMALL + SM_META))[0]);
        pg8::Gemm g{(const bf16_t*)(ws + WS_ROWS), (const bf16_t*)(ws + WS_WTGU), ntiles * 256, NE * 1024, D_MODEL}; pg8::MoeOrder S{(const int*)(ws + WS_SMALL + SM_TILEE), ntiles, G, vcu};
        pg8::EpiMoeUp E{(bf16_t*)(ws + WS_HID), (const float*)(ws + WS_SMALL + SM_ROWSC)};
        pg8::gemm_phase<pg8::EpiMoeUp, pg8::MoeOrder, true, true>(lds, g, S, E); } SEAM(7);
    if (IN(8)) { const int ntiles = __builtin_amdgcn_readfirstlane(((const int*)(ws + WS_SMALL + SM_META))[0]);
        pg8::Gemm g{(const bf16_t*)(ws + WS_HID), (const bf16_t*)(ws + WS_WTD), ntiles * 256, NE * 1024, FF}; pg8::MoeOrder S{(const int*)(ws + WS_SMALL + SM_TILEE), ntiles, G, vcu};
        pg8::EpiMoeDown E{(bf16_t*)(ws + WS_ROWS), (const float*)(ws + WS_SMALL + SM_ROWGT)};
        pg8::gemm_phase<pg8::EpiMoeDown, pg8::MoeOrder, true, true>(lds, g, S, E); } SEAM(8);
    if (IN(9)) { phase9(ka, lane, wave, vcu, G); }
#undef IN
#undef SEAM
}

extern "C" void kernel_launch(void* const* d_in, const int* in_sizes, int n_in, void* d_out, int out_size, void* d_ws, size_t ws_size, hipStream_t stream) {
    static int grid = 0;
    if (grid == 0) {
        if (n_in != 29 || out_size != T_TOK * D_MODEL || ws_size < WS_END) { fprintf(stderr, "kernel_launch: unexpected shapes (n_in %d, out %d, ws %zu < %zu)\n", n_in, out_size, ws_size, (size_t)WS_END); grid = -1; return; }
        int dev = 0, cus = 0;
        if (hipGetDevice(&dev) != hipSuccess || hipDeviceGetAttribute(&cus, hipDeviceAttributeMultiprocessorCount, dev) != hipSuccess) { grid = -1; return; }
        if (hipFuncSetAttribute((const void*)mk_fwd, hipFuncAttributeMaxDynamicSharedMemorySize, LDS_BYTES) != hipSuccess) { fprintf(stderr, "kernel_launch: hipFuncSetAttribute failed\n"); grid = -1; return; }
        grid = cus;
    }
    if (grid < 0) return;
    (void)hipMemsetAsync((char*)d_ws + WS_CTL, 0, CTL_ZERO_BYTES, stream);
    Args a{};
    for (int i = 0; i < 29; ++i) a.in[i] = (const float*)d_in[i];
    a.out = (float*)d_out; a.ws = (unsigned char*)d_ws;
    unsigned char* ws = (unsigned char*)d_ws;
#ifndef LAUNCH_PLAN
#define LAUNCH_PLAN {0, 10}
#endif
    static const int plan[] = LAUNCH_PLAN;
    for (int i = 0; i + 1 < (int)(sizeof(plan) / sizeof(int)); i += 2) { a.ph_lo = plan[i]; a.ph_hi = plan[i + 1]; a.bar_region = i / 2;
        hipLaunchKernelGGL(mk_fwd, dim3(grid), dim3(512), LDS_BYTES, stream, a); }
}
```

```cpp
#define ATT_WINDOW 1
#include <hip/hip_runtime.h>
#include <cstdio>
#include <cstdint>
#include <cmath>

constexpr int D_MODEL = 1024, BATCH = 2, SEQ = 8192, T_TOK = BATCH * SEQ;
constexpr int IN_COLS = 2048, ATTN_W = 512, SSM_W = 512, NH = 4, DH = 64, DV = 128;
constexpr int NG = 32, GC = 16, NS = 64;
constexpr int NEG = 4, EPG = 8, NE = 32, FF = 512;
constexpr float RMS_EPS = 1e-6f;
constexpr float LAM_INIT = 0.2f;
constexpr float C2 = 0.125f * 1.4426950408889634f;
constexpr float LOG2E = 1.4426950408889634f;
constexpr int MAXROWS = 2 * T_TOK + NE * 256;

namespace pg8 {
#define PG8_LAS __attribute__((address_space(3)))
typedef unsigned short bf16_t;
typedef short bf16x8 __attribute__((ext_vector_type(8)));
typedef float f32x4 __attribute__((ext_vector_type(4)));
typedef unsigned u32x4 __attribute__((ext_vector_type(4)));
constexpr int BM = 256, BK = 64, HALF = 128, HTB = HALF * BK * 2  , STAGE_BYTES = 8 * HTB, NXCD = 8, WGM = 8;

__host__ __device__ __forceinline__ int lds_byte(int r, int c) { const int st = (r >> 4) * 2 + (c >> 5), rr = r & 15, cc = c & 31, ob = rr * 64 + cc * 2; return st * 1024 + (ob ^ (((ob >> 9) & 1) << 5)); }
__host__ __device__ __forceinline__ void stage_rc(int b, int& R, int& C) { const int st = b / 1024, sb = b % 1024, swz = sb ^ (((sb >> 9) & 1) << 5); R = (st >> 1) * 16 + swz / 64; C = (st & 1) * 32 + (swz % 64) / 2; }
__host__ __device__ __forceinline__ int perm32(int rho) { const int n = rho >> 4, i = rho & 15; return 8 * (i >> 2) + 4 * n + (i & 3); }

struct Unit { int pm, pn; };
struct Gemm { const bf16_t* A; const bf16_t* Bt; int M, N, K; };

struct StaticOrder {
    int nM, nN, nwg, G, c;
    __host__ __device__ void init(int M, int N, int G_, int c_) { nM = M / BM; nN = N / BM; nwg = nM * nN; G = G_; c = c_; }
    __host__ __device__ bool next(int i, Unit& u) const {
        const long L = (long)i * G + c; if (L >= nwg) return false;
        int wgid = (int)L; { const int q = nwg / NXCD, r = nwg % NXCD, xcd = wgid % NXCD, off = wgid / NXCD; wgid = (xcd < r ? xcd * (q + 1) : r * (q + 1) + (xcd - r) * q) + off; }
        const int nig = WGM * nN, gid = wgid / nig, fm = gid * WGM, gsz = (nM - fm) < WGM ? (nM - fm) : WGM;
        u.pm = fm + ((wgid % nig) % gsz); u.pn = (wgid % nig) / gsz; return true;
    }
    __device__ __forceinline__ void a_ready(const Unit&) const {}
    __device__ __forceinline__ void done(const Unit&) const {}
};

typedef unsigned u32x4 __attribute__((ext_vector_type(4)));
__device__ __forceinline__ unsigned cvt_pk_bf16(float lo, float hi) { unsigned r; asm volatile("v_cvt_pk_bf16_f32 %0, %1, %2" : "=v"(r) : "v"(lo), "v"(hi)); return r; }
__device__ __forceinline__ float bf_lo(unsigned w) { return __uint_as_float(w << 16); }
__device__ __forceinline__ float bf_hi(unsigned w) { return __uint_as_float(w & 0xffff0000u); }
__device__ __forceinline__ float sigmoid_f(float v) { return __builtin_amdgcn_rcpf(1.0f + __builtin_amdgcn_exp2f(-1.4426950408889634f * v)); }

struct EpiInProj {
    static constexpr bool PERM = true, AFTER_DRAIN = false, MIDK = false;
    bf16_t* O; unsigned* NORMS;
    __device__ __forceinline__ void operator()(const f32x4 (&acc)[2][2][4][2], const Unit& u, int wr, int wc, int fr, int fq) const {
        const int row0 = u.pm * BM + wr * 64 + fr; int colt = u.pn * BM; const int t = colt >> 9; colt -= t << 9;
        bf16_t* base = O + (size_t)t * ((size_t)16384 * 512); const float sc = (t == 0) ? (0.125f * 1.4426950408889634f) : 1.f;
        const int col0 = colt + wc * 32 + 8 * fq;
#pragma unroll
        for (int ai = 0; ai < 2; ++ai)
#pragma unroll
            for (int m = 0; m < 4; ++m) { bf16_t* rowp = base + (size_t)(row0 + ai * HALF + m * 16) * 512 + col0;
#pragma unroll
                for (int bj = 0; bj < 2; ++bj) { const f32x4 v0 = acc[ai][bj][m][0] * sc, v1 = acc[ai][bj][m][1] * sc;
                    u32x4 w; w.x = cvt_pk_bf16(v0[0], v0[1]); w.y = cvt_pk_bf16(v0[2], v0[3]); w.z = cvt_pk_bf16(v1[0], v1[1]); w.w = cvt_pk_bf16(v1[2], v1[3]);
                    *(u32x4*)(rowp + bj * HALF) = w; } }
        if (t < 2) {
#pragma unroll
            for (int bj = 0; bj < 2; ++bj) { float mx = 0.f;
#pragma unroll
                for (int ai = 0; ai < 2; ++ai)
#pragma unroll
                    for (int m = 0; m < 4; ++m) { const f32x4 v0 = acc[ai][bj][m][0] * sc, v1 = acc[ai][bj][m][1] * sc;
                        float ss = (v0[0] * v0[0] + v0[1] * v0[1]) + (v0[2] * v0[2] + v0[3] * v0[3]) + (v1[0] * v1[0] + v1[1] * v1[1]) + (v1[2] * v1[2] + v1[3] * v1[3]);
                        ss += __shfl_xor(ss, 16); ss += __shfl_xor(ss, 32); mx = fmaxf(mx, ss); }
                mx = fmaxf(mx, __shfl_xor(mx, 1)); mx = fmaxf(mx, __shfl_xor(mx, 2)); mx = fmaxf(mx, __shfl_xor(mx, 4)); mx = fmaxf(mx, __shfl_xor(mx, 8));
                if (fr == 0 && fq == 0) atomicMax(NORMS + t * 32 + (u.pm >> 5) * 16 + ((colt + bj * HALF + wc * 32) >> 5), __float_as_uint(sqrtf(mx) * 1.001f)); }
        }
    }
};
struct EpiGlu {
    static constexpr bool PERM = true, AFTER_DRAIN = false, MIDK = false;
    const bf16_t* Yg; const float* bias; bf16_t* CC; float* SSQP;
    __device__ __forceinline__ void operator()(const f32x4 (&acc)[2][2][4][2], const Unit& u, int wr, int wc, int fr, int fq) const {
        const int row0 = u.pm * BM + wr * 64 + fr, col0 = u.pn * BM + wc * 32 + 8 * fq;
        f32x4 bv[2][2];
#pragma unroll
        for (int bj = 0; bj < 2; ++bj)
#pragma unroll
            for (int n = 0; n < 2; ++n) bv[bj][n] = *(const f32x4*)(bias + col0 + bj * HALF + 4 * n);
#pragma unroll
        for (int ai = 0; ai < 2; ++ai)
#pragma unroll
            for (int m = 0; m < 4; ++m) { const int row = row0 + ai * HALF + m * 16; float ss = 0.f;
#pragma unroll
                for (int bj = 0; bj < 2; ++bj) { const int col = col0 + bj * HALF;
                    const u32x4 y8 = *(const u32x4*)(Yg + (size_t)row * 512 + col);
                    const f32x4 a0 = acc[ai][bj][m][0] + bv[bj][0], a1 = acc[ai][bj][m][1] + bv[bj][1];
                    float z[8];
                    z[0] = bf_lo(y8.x) * sigmoid_f(a0[0]); z[1] = bf_hi(y8.x) * sigmoid_f(a0[1]); z[2] = bf_lo(y8.y) * sigmoid_f(a0[2]); z[3] = bf_hi(y8.y) * sigmoid_f(a0[3]);
                    z[4] = bf_lo(y8.z) * sigmoid_f(a1[0]); z[5] = bf_hi(y8.z) * sigmoid_f(a1[1]); z[6] = bf_lo(y8.w) * sigmoid_f(a1[2]); z[7] = bf_hi(y8.w) * sigmoid_f(a1[3]);
#pragma unroll
                    for (int i = 0; i < 8; ++i) ss += z[i] * z[i];
                    u32x4 w; w.x = cvt_pk_bf16(z[0], z[1]); w.y = cvt_pk_bf16(z[2], z[3]); w.z = cvt_pk_bf16(z[4], z[5]); w.w = cvt_pk_bf16(z[6], z[7]);
                    *(u32x4*)(CC + (size_t)row * 1024 + col) = w; }
                ss += __shfl_xor(ss, 16); ss += __shfl_xor(ss, 32);
                if (fq == 0) SSQP[(size_t)row * 8 + u.pn * 4 + wc] = ss; }
    }
};
struct EpiOut {
    static constexpr bool PERM = false, AFTER_DRAIN = false, MIDK = true;
    const float* x; float* out; const float* SSQP;
    __device__ __forceinline__ void midk(f32x4 (&acc)[2][2][4][2], const Unit& u, int wr, int wc, int fr, int fq) const {
#pragma unroll
        for (int ai = 0; ai < 2; ++ai)
#pragma unroll
            for (int m = 0; m < 4; ++m) { const int row = u.pm * BM + ai * HALF + wr * 64 + m * 16 + fr;
                const f32x4 s0 = *(const f32x4*)(SSQP + (size_t)row * 8), s1 = *(const f32x4*)(SSQP + (size_t)row * 8 + 4);
                const float s = ((s0[0] + s0[1]) + (s0[2] + s0[3])) + ((s1[0] + s1[1]) + (s1[2] + s1[3]));
                const float r = __builtin_amdgcn_rsqf(s * (1.0f / 512.0f) + 1e-6f);
#pragma unroll
                for (int bj = 0; bj < 2; ++bj)
#pragma unroll
                    for (int n = 0; n < 2; ++n) acc[ai][bj][m][n] *= r; }
    }
    __device__ __forceinline__ void operator()(const f32x4 (&acc)[2][2][4][2], const Unit& u, int wr, int wc, int fr, int fq) const {
        const int col0 = u.pn * BM + wc * 32 + 4 * fq;
#pragma unroll
        for (int ai = 0; ai < 2; ++ai)
#pragma unroll
            for (int m = 0; m < 4; ++m) { const size_t off = (size_t)(u.pm * BM + ai * HALF + wr * 64 + m * 16 + fr) * 1024 + col0;
#pragma unroll
                for (int bj = 0; bj < 2; ++bj)
#pragma unroll
                    for (int n = 0; n < 2; ++n) { const f32x4 bs = *(const f32x4*)(x + off + bj * HALF + n * 16); *(f32x4*)(out + off + bj * HALF + n * 16) = bs + acc[ai][bj][m][n]; } }
    }
};
struct EpiMoeUp {
    static constexpr bool PERM = true, AFTER_DRAIN = false, MIDK = false;
    bf16_t* HID; const float* ROWSC;
    __device__ __forceinline__ void operator()(const f32x4 (&acc)[2][2][4][2], const Unit& u, int wr, int wc, int fr, int fq) const {
        const int row0 = u.pm * BM + wr * 64 + fr, j0 = (u.pn & 3) * HALF + wc * 32 + 8 * fq;
#pragma unroll
        for (int ai = 0; ai < 2; ++ai)
#pragma unroll
            for (int m = 0; m < 4; ++m) { const int row = row0 + ai * HALF + m * 16; const float rs = ROWSC[row];
                float h[8];
#pragma unroll
                for (int n = 0; n < 2; ++n)
#pragma unroll
                    for (int i = 0; i < 4; ++i) { const float g = acc[ai][0][m][n][i] * rs, up = acc[ai][1][m][n][i] * rs; h[n * 4 + i] = g * sigmoid_f(g) * up; }
                u32x4 w; w.x = cvt_pk_bf16(h[0], h[1]); w.y = cvt_pk_bf16(h[2], h[3]); w.z = cvt_pk_bf16(h[4], h[5]); w.w = cvt_pk_bf16(h[6], h[7]);
                *(u32x4*)(HID + (size_t)row * 512 + j0) = w; }
    }
};
struct EpiMoeDown {
    static constexpr bool PERM = true, AFTER_DRAIN = false, MIDK = false;
    bf16_t* Y; const float* ROWGT;
    __device__ __forceinline__ void operator()(const f32x4 (&acc)[2][2][4][2], const Unit& u, int wr, int wc, int fr, int fq) const {
        const int row0 = u.pm * BM + wr * 64 + fr, col0 = (u.pn & 3) * BM + wc * 32 + 8 * fq;
#pragma unroll
        for (int ai = 0; ai < 2; ++ai)
#pragma unroll
            for (int m = 0; m < 4; ++m) { const int row = row0 + ai * HALF + m * 16; const float gt = ROWGT[row];
#pragma unroll
                for (int bj = 0; bj < 2; ++bj) { const f32x4 v0 = acc[ai][bj][m][0] * gt, v1 = acc[ai][bj][m][1] * gt;
                    u32x4 w; w.x = cvt_pk_bf16(v0[0], v0[1]); w.y = cvt_pk_bf16(v0[2], v0[3]); w.z = cvt_pk_bf16(v1[0], v1[1]); w.w = cvt_pk_bf16(v1[2], v1[3]);
                    *(u32x4*)(Y + (size_t)row * 1024 + col0 + bj * HALF) = w; } }
    }
};
struct MoeOrder {
    const int* tile_e; int ntiles, G, c;
    __device__ __forceinline__ bool next(int i, Unit& u) const {
        const int L = i * G + c; if (L >= ntiles * 4) return false;
        u.pm = L >> 2; const int e = __builtin_amdgcn_readfirstlane(tile_e[u.pm]); u.pn = e * 4 + (L & 3); return true;
    }
    __device__ __forceinline__ void a_ready(const Unit&) const {}
    __device__ __forceinline__ void done(const Unit&) const {}
};
template <class Epi, class Sched, bool ALIGN_EPI = false, bool SP2 = false>
__device__ __forceinline__ void gemm_phase(PG8_LAS unsigned char* lds, const Gemm g, const Sched& S, const Epi& E) {
    const int tid = threadIdx.x, wid = __builtin_amdgcn_readfirstlane(tid >> 6), lane = tid & 63, wr = wid >> 2, wc = wid & 3, fr = lane & 15, fq = lane >> 4;
    const int K = g.K, nt = K / BK;
    unsigned voffA[2], voffB[2];
#pragma unroll
    for (int i = 0; i < 2; ++i) { int R, C; stage_rc(tid * 16 + i * 8192, R, C); const int Rb = Epi::PERM ? ((R & ~31) + perm32(R & 31)) : R;
        voffA[i] = (unsigned)(R * K + C) * 2u; voffB[i] = (unsigned)(Rb * K + C) * 2u; }
    const size_t kstep = (size_t)(BK * 2);
    const size_t hstep = (size_t)HALF * K * 2;
    const size_t tstep = 2 * hstep;
    const unsigned ldsw = (unsigned)wid * 1024u;
    const int aoff = lds_byte(wr * 64 + fr, fq * 8), boff = lds_byte(wc * 32 + fr, fq * 8);
#define PG8_SA(b, h) (((b) * 2 + (h)) * HTB)
#define PG8_SB(b, h) ((4 + (b) * 2 + (h)) * HTB)
#define PG8_STAGE(bufoff, gbase, voff) do { _Pragma("unroll") for (int _i = 0; _i < 2; ++_i) \
        __builtin_amdgcn_global_load_lds((const unsigned*)((const char*)(gbase) + (voff)[_i]), (PG8_LAS unsigned*)(lds + (bufoff) + ldsw + _i * 8192), 16, 0, 0); } while (0)
#define PG8_LDA(dst, b, h) do { _Pragma("unroll") for (int m = 0; m < 4; ++m) _Pragma("unroll") for (int k = 0; k < 2; ++k) dst[m][k] = *(const PG8_LAS bf16x8*)(lds + PG8_SA(b, h) + aoff + m * 2048 + k * 1024); } while (0)
#define PG8_LDB(dst, b, h) do { _Pragma("unroll") for (int n = 0; n < 2; ++n) _Pragma("unroll") for (int k = 0; k < 2; ++k) dst[n][k] = *(const PG8_LAS bf16x8*)(lds + PG8_SB(b, h) + boff + n * 2048 + k * 1024); } while (0)
#define PG8_MMA(ai, bj, At, Bt) do { __builtin_amdgcn_s_setprio(1); _Pragma("unroll") for (int m = 0; m < 4; ++m) _Pragma("unroll") for (int n = 0; n < 2; ++n) _Pragma("unroll") for (int k = 0; k < 2; ++k) \
        acc[ai][bj][m][n] = __builtin_amdgcn_mfma_f32_16x16x32_bf16(Bt[n][k], At[m][k], acc[ai][bj][m][n], 0, 0, 0); __builtin_amdgcn_s_setprio(0); } while (0)
#define PG8_WAIT_V(n) asm volatile("s_waitcnt vmcnt(" #n ")" ::: "memory")
#define PG8_WAIT_L(n) asm volatile("s_waitcnt lgkmcnt(" #n ")" ::: "memory")
#define PG8_BAR __builtin_amdgcn_s_barrier()
#define PG8_SCHED __builtin_amdgcn_sched_barrier(0)
    Unit cur, nxt; int ui = 0;
    if (!S.next(0, cur)) return;
    f32x4 acc[2][2][4][2];
#pragma unroll
    for (int a = 0; a < 2; ++a)
#pragma unroll
        for (int b = 0; b < 2; ++b)
#pragma unroll
            for (int m = 0; m < 4; ++m)
#pragma unroll
                for (int n = 0; n < 2; ++n) acc[a][b][m][n] = (f32x4){0.f, 0.f, 0.f, 0.f};
    bf16x8 At[4][2], B0[2][2], B1[2][2];
    const char* cA = (const char*)g.A + (size_t)cur.pm * tstep; const char* cB = (const char*)g.Bt + (size_t)cur.pn * tstep;
    S.a_ready(cur);
    if constexpr (SP2) {
        PG8_STAGE(PG8_SB(0, 0), cB, voffB); PG8_STAGE(PG8_SB(0, 1), cB + hstep, voffB); PG8_STAGE(PG8_SA(0, 0), cA, voffA); PG8_STAGE(PG8_SA(0, 1), cA + hstep, voffA);
        if (wr == 1) PG8_BAR;
        PG8_WAIT_V(2); PG8_BAR;
        PG8_STAGE(PG8_SB(1, 0), cB + kstep, voffB); PG8_STAGE(PG8_SA(1, 0), cA + kstep, voffA); PG8_STAGE(PG8_SB(1, 1), cB + hstep + kstep, voffB);
        PG8_WAIT_V(6); PG8_BAR;
    } else {
        PG8_STAGE(PG8_SB(0, 0), cB, voffB); PG8_STAGE(PG8_SA(0, 0), cA, voffA); PG8_STAGE(PG8_SB(0, 1), cB + hstep, voffB); PG8_STAGE(PG8_SA(0, 1), cA + hstep, voffA);
        if (wr == 1) PG8_BAR;
        PG8_WAIT_V(4); PG8_BAR;
        PG8_STAGE(PG8_SB(1, 0), cB + kstep, voffB); PG8_STAGE(PG8_SA(1, 0), cA + kstep, voffA); PG8_STAGE(PG8_SB(1, 1), cB + hstep + kstep, voffB);
        PG8_WAIT_V(6); PG8_BAR;
    }
    for (;;) {
        const bool has_next = S.next(ui + 1, nxt);
        const char* nA = has_next ? (const char*)g.A + (size_t)nxt.pm * tstep : cA; const char* nB = has_next ? (const char*)g.Bt + (size_t)nxt.pn * tstep : cB;
        for (int t = 0; t < nt; t += 2) {
            if constexpr (Epi::MIDK) { if (t == (nt >> 1)) E.midk(acc, cur, wr, wc, fr, fq); }
            const bool last = (t == nt - 2);
            const char* a1 = cA + (size_t)(t + 1) * kstep;
            const char* a2 = last ? nA : cA + (size_t)(t + 2) * kstep; const char* b2 = last ? nB : cB + (size_t)(t + 2) * kstep;
            const char* a3 = a2 + kstep; const char* b3 = b2 + kstep;
            if (last && has_next) S.a_ready(nxt);
            if constexpr (SP2) {
            PG8_LDB(B0, 0, 0); PG8_LDB(B1, 0, 1); PG8_SCHED; PG8_LDA(At, 0, 0); PG8_STAGE(PG8_SA(1, 1), a1 + hstep, voffA);
            PG8_WAIT_V(8); PG8_WAIT_L(0); PG8_BAR; PG8_MMA(0, 0, At, B0); PG8_MMA(0, 1, At, B1); PG8_BAR; PG8_SCHED;
            PG8_LDA(At, 0, 1); PG8_STAGE(PG8_SB(0, 0), b2, voffB); PG8_STAGE(PG8_SB(0, 1), b2 + hstep, voffB); PG8_STAGE(PG8_SA(0, 0), a2, voffA);
            PG8_WAIT_V(8); PG8_WAIT_L(0); PG8_BAR; PG8_MMA(1, 0, At, B0); PG8_MMA(1, 1, At, B1); PG8_BAR; PG8_SCHED;
            PG8_LDB(B0, 1, 0); PG8_LDB(B1, 1, 1); PG8_SCHED; PG8_LDA(At, 1, 0); PG8_STAGE(PG8_SA(0, 1), a2 + hstep, voffA);
            PG8_WAIT_V(8); PG8_WAIT_L(0); PG8_BAR; PG8_MMA(0, 0, At, B0); PG8_MMA(0, 1, At, B1); PG8_BAR; PG8_SCHED;
            PG8_LDA(At, 1, 1); PG8_STAGE(PG8_SB(1, 0), b3, voffB); PG8_STAGE(PG8_SB(1, 1), b3 + hstep, voffB); PG8_STAGE(PG8_SA(1, 0), a3, voffA);
            PG8_WAIT_V(8); PG8_WAIT_L(0); PG8_BAR; PG8_MMA(1, 0, At, B0); PG8_MMA(1, 1, At, B1); PG8_BAR; PG8_SCHED;
            } else {
            PG8_LDB(B0, 0, 0); PG8_SCHED; PG8_LDA(At, 0, 0); PG8_STAGE(PG8_SA(1, 1), a1 + hstep, voffA);
            PG8_WAIT_L(8); PG8_BAR; PG8_WAIT_L(0); PG8_MMA(0, 0, At, B0); PG8_BAR; PG8_SCHED;
            PG8_LDB(B1, 0, 1); PG8_STAGE(PG8_SB(0, 0), b2, voffB);
            PG8_BAR; PG8_WAIT_L(0); PG8_MMA(0, 1, At, B1); PG8_BAR;
            PG8_LDA(At, 0, 1); PG8_STAGE(PG8_SA(0, 0), a2, voffA);
            PG8_BAR; PG8_WAIT_L(0); PG8_MMA(1, 0, At, B0); PG8_BAR; PG8_SCHED;
            PG8_STAGE(PG8_SB(0, 1), b2 + hstep, voffB);
            PG8_WAIT_V(6); PG8_BAR; PG8_MMA(1, 1, At, B1); PG8_BAR;
            PG8_LDB(B0, 1, 0); PG8_SCHED; PG8_LDA(At, 1, 0); PG8_STAGE(PG8_SA(0, 1), a2 + hstep, voffA);
            PG8_WAIT_L(8); PG8_BAR; PG8_WAIT_L(0); PG8_MMA(0, 0, At, B0); PG8_BAR; PG8_SCHED;
            PG8_LDB(B1, 1, 1); PG8_STAGE(PG8_SB(1, 0), b3, voffB);
            PG8_BAR; PG8_WAIT_L(0); PG8_MMA(0, 1, At, B1); PG8_BAR;
            PG8_LDA(At, 1, 1); PG8_STAGE(PG8_SA(1, 0), a3, voffA);
            PG8_BAR; PG8_WAIT_L(0); PG8_MMA(1, 0, At, B0); PG8_BAR; PG8_SCHED;
            PG8_STAGE(PG8_SB(1, 1), b3 + hstep, voffB);
            PG8_WAIT_V(6); PG8_BAR; PG8_MMA(1, 1, At, B1); PG8_BAR;
            }
        }
        if constexpr (ALIGN_EPI) { if (wr == 0) PG8_BAR; }
        if constexpr (!Epi::AFTER_DRAIN) { E(acc, cur, wr, wc, fr, fq); S.done(cur); }
        if (!has_next) break;
#pragma unroll
        for (int a = 0; a < 2; ++a)
#pragma unroll
            for (int b = 0; b < 2; ++b)
#pragma unroll
                for (int m = 0; m < 4; ++m)
#pragma unroll
                    for (int n = 0; n < 2; ++n) acc[a][b][m][n] = (f32x4){0.f, 0.f, 0.f, 0.f};
        cur = nxt; cA = nA; cB = nB; ++ui;
        if constexpr (ALIGN_EPI) { if (wr == 1) PG8_BAR; }
    }
    PG8_WAIT_V(0);
    if constexpr (!ALIGN_EPI) { if (wr == 0) PG8_BAR; }
    PG8_BAR;
    if constexpr (Epi::AFTER_DRAIN) { E.fused(acc, cur, wr, wc, fr, fq, lds, wid, lane); S.done(cur); }
#undef PG8_SA
#undef PG8_SB
#undef PG8_STAGE
#undef PG8_LDA
#undef PG8_LDB
#undef PG8_MMA
#undef PG8_WAIT_V
#undef PG8_WAIT_L
#undef PG8_BAR
#undef PG8_SCHED
}
}
using pg8::bf16_t;
constexpr size_t MiB = 1u << 20, KiB = 1u << 10;
constexpr size_t WS_CTL = 0, CTL_ZERO_BYTES = 1 * MiB;
constexpr size_t WS_SMALL = 1 * MiB;
constexpr size_t WS_WTIN = 4 * MiB, WS_WTOUT = 8 * MiB, WS_WTGLU = 10 * MiB, WS_WR = 10 * MiB + 512 * KiB, WS_WTGU = 11 * MiB, WS_WTD = 75 * MiB;
constexpr size_t WS_R1 = 107 * MiB;
constexpr size_t WS_BIG = 139 * MiB;
constexpr size_t WS_Q = WS_BIG, WS_K = WS_BIG + 16 * MiB, WS_V = WS_BIG + 32 * MiB, WS_U = WS_BIG + 48 * MiB, WS_O1 = WS_BIG + 64 * MiB, WS_O2 = WS_BIG + 80 * MiB, WS_YG = WS_BIG + 96 * MiB;
constexpr size_t WS_ROWS = WS_BIG, WS_HID = WS_BIG + 80 * MiB;
constexpr size_t WS_END = WS_BIG + 120 * MiB;
static_assert((size_t)MAXROWS * 1024 * 2 == 80 * MiB && (size_t)MAXROWS * 512 * 2 == 40 * MiB, "moe buffers");
constexpr size_t SM_SSQP = 0, SM_RINV = 512 * KiB, SM_EID = 576 * KiB, SM_GATE = 704 * KiB, SM_DEST = 832 * KiB, SM_LRANK = 960 * KiB, SM_TOKROW = 1088 * KiB,
                 SM_ROWSC = 1248 * KiB, SM_ROWGT = 1408 * KiB, SM_TILEE = 1568 * KiB, SM_CNT = 1572 * KiB, SM_META = 1604 * KiB;
constexpr int CW_BAR = 4096;

constexpr int RING_BYTES = 131072, LDSCTL_OFF = RING_BYTES, MISC_OFF = LDSCTL_OFF + 320, LDS_BYTES = 156672;

#define GAS __attribute__((address_space(1)))
#define LAS __attribute__((address_space(3)))
typedef unsigned v4u __attribute__((ext_vector_type(4)));
typedef unsigned v2u __attribute__((ext_vector_type(2)));
typedef float f32x4 __attribute__((ext_vector_type(4)));
typedef short bf16x8 __attribute__((ext_vector_type(8)));
#define LDS_WAIT() asm volatile("s_waitcnt lgkmcnt(0)" ::: "memory")
#define VM_WAIT() asm volatile("s_waitcnt vmcnt(0)" ::: "memory")
__device__ __forceinline__ unsigned f2bf(float f) { unsigned u = __builtin_bit_cast(unsigned, f); return (u + 0x7fffu + ((u >> 16) & 1u)) >> 16; }
__device__ __forceinline__ unsigned pk2(float lo, float hi) { return f2bf(lo) | (f2bf(hi) << 16); }
__device__ __forceinline__ float bf2f(unsigned short h) { return __uint_as_float(((unsigned)h) << 16); }
__device__ __forceinline__ float wave_sum(float v) {
#pragma unroll
    for (int o = 1; o < 64; o <<= 1) v += __shfl_xor(v, o);
    return v;
}
__device__ __forceinline__ float wave_max(float v) {
#pragma unroll
    for (int o = 1; o < 64; o <<= 1) v = fmaxf(v, __shfl_xor(v, o));
    return v;
}
#define XB_TMO      128
#define XB_XCNT(j)  (256  + 64 * (j))
#define XB_XSUB(j)  (1280 + 64 * (j))
#define XB_XGEN(j)  (2304 + 64 * (j))
#define XB_TOP      3328
#define XB_TOPGEN   3392
#define XCD_BAR_WORDS 3456
#define XB_SPIN_CAP (1u << 18)

__device__ __forceinline__ unsigned xb_ld(unsigned* p)              { return __hip_atomic_load(p, __ATOMIC_RELAXED, __HIP_MEMORY_SCOPE_AGENT); }
__device__ __forceinline__ unsigned xb_add(unsigned* p, unsigned v) { return __hip_atomic_fetch_add(p, v, __ATOMIC_RELAXED, __HIP_MEMORY_SCOPE_AGENT); }
__device__ __forceinline__ unsigned xb_xcc_id() { return (unsigned)__builtin_amdgcn_s_getreg((3 << 11) | 20) & 0xFu; }
#define XB_SPIN(cond, bar) do { unsigned _sp = 0; while (cond) { __builtin_amdgcn_s_sleep(1); \
    if ((++_sp & 255u) == 0u) { if (xb_ld(&(bar)[XB_TMO])) break; if (_sp > XB_SPIN_CAP) { atomicAdd(&(bar)[XB_TMO], 1u); break; } } } } while (0)

struct XcdBarrier {
    unsigned* bar; unsigned x;
    volatile LAS unsigned* st;
};

__device__ __forceinline__ XcdBarrier xcd_barrier_post(unsigned* bar, volatile LAS unsigned* st) {
    XcdBarrier b; b.bar = bar; b.x = xb_xcc_id(); b.st = st;
    if (threadIdx.x == 0) (void)xb_add(&bar[XB_XCNT(b.x)], 1u);
    return b;
}
__device__ __forceinline__ void xcd_barrier_complete(unsigned* bar, unsigned x, unsigned& nloc, unsigned& nx) {
    const unsigned G = gridDim.x * gridDim.y * gridDim.z;
    unsigned sum, cnt, mine, sp = 0u;
    for (;;) {
        sum = 0u; cnt = 0u; mine = 0u;
#pragma unroll
        for (unsigned j = 0; j < 16; ++j) { const unsigned c = xb_ld(&bar[XB_XCNT(j)]); sum += c; cnt += (c > 0u) ? 1u : 0u; mine = (j == x) ? c : mine; }
        if (sum == G) break;
        __builtin_amdgcn_s_sleep(1);
        if ((++sp & 255u) == 0u) { if (xb_ld(&bar[XB_TMO])) break; if (sp > XB_SPIN_CAP) { atomicAdd(&bar[XB_TMO], 1u); break; } }
    }
    nloc = mine > 0u ? mine : 1u; nx = cnt > 0u ? cnt : 1u;
}

__device__ __forceinline__ void xcd_barrier(const XcdBarrier& b) {
    asm volatile("s_waitcnt vmcnt(0)" ::: "memory");
    __syncthreads();
    if (threadIdx.x == 0) {
        unsigned* bar = b.bar;
        __builtin_amdgcn_s_waitcnt(0);
        unsigned nloc = b.st[0], nx = b.st[1];
        if (nloc == 0u) { xcd_barrier_complete(bar, b.x, nloc, nx); b.st[0] = nloc; b.st[1] = nx; }
        const unsigned old = xb_add(&bar[XB_XSUB(b.x)], 1u);
        const unsigned gen = old / nloc;
        if (old + 1u == (gen + 1u) * nloc) {
            __builtin_amdgcn_fence(__ATOMIC_RELEASE, "agent");
            asm volatile("s_waitcnt vmcnt(0)" ::: "memory");
            const unsigned og = xb_add(&bar[XB_TOP], 1u);
            const unsigned tg = og / nx;
            if (og + 1u == (tg + 1u) * nx) xb_add(&bar[XB_TOPGEN], 1u);
            else XB_SPIN(xb_ld(&bar[XB_TOPGEN]) == tg, bar);
            __builtin_amdgcn_fence(__ATOMIC_ACQUIRE, "agent");
            xb_add(&bar[XB_XGEN(b.x)], 1u);
            asm volatile("s_waitcnt vmcnt(0)" ::: "memory");
        } else {
            XB_SPIN(xb_ld(&bar[XB_XGEN(b.x)]) == gen, bar);
            __builtin_amdgcn_fence(__ATOMIC_ACQUIRE, "agent");
            asm volatile("s_waitcnt vmcnt(0)" ::: "memory");
        }
    }
    __syncthreads();
}

struct Args { const float* in[29]; float* out; unsigned char* ws; int ph_lo, ph_hi, bar_region, pad; };
typedef const __attribute__((address_space(4))) Args* KArgs;
enum { IN_X = 0, IN_NORM_ATTN, IN_W_IN, IN_LQ1, IN_LK1, IN_LQ2, IN_LK2, IN_SUBLN, IN_LAM_RE, IN_LAM_IM, IN_LOG_DT, IN_B_RE, IN_B_IM, IN_C_RE, IN_C_IM, IN_SSM_D,
       IN_W_GLU, IN_B_GLU, IN_SSM_NORM, IN_W_OUT, IN_NORM_MOE, IN_WRG, IN_BRG, IN_WRE, IN_BRE, IN_W_GATE, IN_W_UP, IN_W_DOWN, IN_NORM_FINAL };

__device__ __forceinline__ void tr_item(const float* __restrict__ W, int ldw, int ks0, int ns0, bf16_t* WT, int ldt, int rd0, int kd0, const float* kscale, LAS float* scr, int lane) {
    const int nn = 4 * (lane & 15);
    f32x4 vv[16];
#pragma unroll
    for (int i = 0; i < 16; ++i) vv[i] = *(const f32x4*)(W + (size_t)(ks0 + 4 * i + (lane >> 4)) * ldw + ns0 + nn);
#pragma unroll
    for (int i = 0; i < 16; ++i) { const int kk = 4 * i + (lane >> 4); f32x4 v = vv[i]; if (kscale) v = v * kscale[kk];
        LAS float* d = scr + kk * 65 + nn; d[0] = v.x; d[1] = v.y; d[2] = v.z; d[3] = v.w; }
    LDS_WAIT(); asm volatile("" ::: "memory");
    const int c = lane & 7;
#pragma unroll
    for (int j = 0; j < 8; ++j) { const int n = (lane >> 3) + 8 * j; const LAS float* s = scr + (8 * c) * 65 + n;
        v4u o; o.x = pk2(s[0 * 65], s[1 * 65]); o.y = pk2(s[2 * 65], s[3 * 65]); o.z = pk2(s[4 * 65], s[5 * 65]); o.w = pk2(s[6 * 65], s[7 * 65]);
        *(GAS v4u*)(WT + (size_t)(rd0 + n) * ldt + kd0 + 8 * c) = o; }
    LDS_WAIT(); asm volatile("" ::: "memory");
}
__device__ __forceinline__ void phase0(KArgs a, LAS unsigned char* lds, int, int, int vcu, int G) {
    int tid_ = threadIdx.x; asm volatile("" : "+v"(tid_)); const int lane = tid_ & 63, wave = __builtin_amdgcn_readfirstlane(tid_ >> 6);
    LAS float* scr = (LAS float*)(lds + (wave < 7 ? wave * 16640 : 136192));
    const int gw = vcu * 8 + wave, NGW = G * 8;
    unsigned char* ws = a->ws;
    bf16_t* WT_in = (bf16_t*)(ws + WS_WTIN); bf16_t* WT_out = (bf16_t*)(ws + WS_WTOUT); bf16_t* WT_glu = (bf16_t*)(ws + WS_WTGLU);
    constexpr int I_IN = 16 * 32, I_OUT = 16 * 16, I_GLU = 8 * 8, NITEMS = I_IN + I_OUT + I_GLU;
    for (int it = gw; it < NITEMS; it += NGW) {
        int r = it;
        if (r < I_IN) { const int kb = r >> 5, nb = r & 31; tr_item(a->in[IN_W_IN], IN_COLS, 64 * kb, 64 * nb, WT_in, 1024, 64 * nb, 64 * kb, nullptr, scr, lane); continue; } r -= I_IN;
        if (r < I_OUT) { const int kb = r >> 4, nb = r & 15, ks0 = 64 * kb;
            tr_item(a->in[IN_W_OUT], 1024, ks0, 64 * nb, WT_out, 1024, 64 * nb, (ks0 + 512) & 1023, ks0 >= 512 ? a->in[IN_SSM_NORM] + (ks0 - 512) : nullptr, scr, lane); continue; } r -= I_OUT;
        { const int kb = r >> 3, nb = r & 7; tr_item(a->in[IN_W_GLU], 512, 64 * kb, 64 * nb, WT_glu, 512, 64 * nb, 64 * kb, nullptr, scr, lane); }
    }
    { const float* x = a->in[IN_X]; const float* g = a->in[IN_NORM_ATTN]; bf16_t* XN = (bf16_t*)(ws + WS_R1);
      f32x4 gv[4];
#pragma unroll
      for (int j = 0; j < 4; ++j) gv[j] = *(const f32x4*)(g + 4 * lane + 256 * j);
      for (int m0 = gw * 4; m0 < T_TOK; m0 += NGW * 4) {
        f32x4 v[4][4];
#pragma unroll
        for (int j = 0; j < 4; ++j) { const GAS f32x4* xr = (const GAS f32x4*)(x + (size_t)(m0 + j) * D_MODEL) + lane;
#pragma unroll
            for (int i = 0; i < 4; ++i) v[j][i] = xr[64 * i]; }
#pragma unroll
        for (int j = 0; j < 4; ++j) { float s = 0.f;
#pragma unroll
            for (int i = 0; i < 4; ++i) s += (v[j][i].x * v[j][i].x + v[j][i].y * v[j][i].y) + (v[j][i].z * v[j][i].z + v[j][i].w * v[j][i].w);
            const float rstd = 1.f / sqrtf(wave_sum(s) * (1.f / D_MODEL) + RMS_EPS);
            GAS v2u* o8 = (GAS v2u*)(XN + (size_t)(m0 + j) * D_MODEL) + lane;
#pragma unroll
            for (int i = 0; i < 4; ++i) { v2u o; o.x = pk2(v[j][i].x * rstd * gv[i].x, v[j][i].y * rstd * gv[i].y); o.y = pk2(v[j][i].z * rstd * gv[i].z, v[j][i].w * rstd * gv[i].w); o8[64 * i] = o; } }
      } }
    { bf16_t* WRhi = (bf16_t*)(ws + WS_WR); bf16_t* WRlo = WRhi + 48 * 1024;
      for (int i = gw * 64 + lane; i < 48 * 1024; i += NGW * 64) { const int c = i >> 10, k = i & 1023;
        const float w = c < 4 ? a->in[IN_WRG][k * 4 + c] : (c < 36 ? a->in[IN_WRE][k * 32 + (c - 4)] : 0.f);
        const unsigned hi = f2bf(w); WRhi[i] = (bf16_t)hi; WRlo[i] = (bf16_t)f2bf(w - bf2f((unsigned short)hi)); } }
}

__device__ __forceinline__ void conv_moe_block(KArgs a, int r, LAS float* scr, int lane) {
    bf16_t* WT_gu = (bf16_t*)(a->ws + WS_WTGU); bf16_t* WT_d = (bf16_t*)(a->ws + WS_WTD);
    const int e = r / 384; r -= e * 384;
    if (r < 256) { const int up = r >> 7; r &= 127; const int kb = r >> 3, nb = r & 7, n0 = 64 * nb;
        tr_item(a->in[up ? IN_W_UP : IN_W_GATE] + (size_t)e * 1024 * 512, 512, 64 * kb, n0, WT_gu, 1024, e * 1024 + (n0 >> 7) * 256 + up * 128 + (n0 & 127), 64 * kb, nullptr, scr, lane); return; }
    r -= 256; { const int kb = r >> 4, nb = r & 15; tr_item(a->in[IN_W_DOWN] + (size_t)e * 512 * 1024, 1024, 64 * kb, 64 * nb, WT_d, 512, e * 1024 + 64 * nb, 64 * kb, nullptr, scr, lane); }
}
constexpr int CONV_PER_ITEM = 48, NCONV = NE * 384 / CONV_PER_ITEM;
__device__ __forceinline__ void conv_moe_item(KArgs a, int c, LAS unsigned char* lds) {
    int tid_ = threadIdx.x; asm volatile("" : "+v"(tid_)); const int lane = tid_ & 63, wave = __builtin_amdgcn_readfirstlane(tid_ >> 6);
    LAS float* scr = (LAS float*)(lds + (wave < 7 ? wave * 16640 : 131584));
    for (int i = 0; i < CONV_PER_ITEM / 8; ++i) conv_moe_block(a, c * CONV_PER_ITEM + i * 8 + wave, scr, lane);
    __syncthreads();
}

__device__ __forceinline__ void phase5(KArgs a, LAS unsigned char* lds, int, int, int, int vcu, int G) {
    int tid_ = threadIdx.x; asm volatile("" : "+v"(tid_)); const int lane = tid_ & 63, wave = __builtin_amdgcn_readfirstlane(tid_ >> 6); const int tid = tid_;
    unsigned char* ws = a->ws;
    const float* x1 = a->out; const float* g2 = a->in[IN_NORM_MOE];
    bf16_t* H2 = (bf16_t*)(ws + WS_R1);
    const bf16_t* WRhi = (const bf16_t*)(ws + WS_WR); const bf16_t* WRlo = WRhi + 48 * 1024;
    float* RINV = (float*)(ws + WS_SMALL + SM_RINV); int* EID = (int*)(ws + WS_SMALL + SM_EID); float* GATE = (float*)(ws + WS_SMALL + SM_GATE);
    int* LRANK = (int*)(ws + WS_SMALL + SM_LRANK); int* CNT = (int*)(ws + WS_SMALL + SM_CNT);
    LAS float* PL = (LAS float*)lds;
    LAS float* PS = PL + 8 * 64 * 49;
    LAS float* LG = PS + 8 * 64;
    LAS float* SQ = LG + 64 * 49;
    LAS int* EL = (LAS int*)(SQ + 64);
    for (int wgi = vcu; wgi < T_TOK / 64; wgi += G) {
        int l_ = lane; asm volatile("" : "+v"(l_));
        const int r16 = l_ & 15, kq = l_ >> 4;
        f32x4 xq[2][4][2];
#define P5_LOAD(buf, ks) do { const int k0_ = wave * 128 + (ks) * 32 + kq * 8; \
            _Pragma("unroll") for (int mt = 0; mt < 4; ++mt) { const float* xr_ = x1 + (size_t)(64 * wgi + 16 * mt + r16) * D_MODEL + k0_; xq[buf][mt][0] = *(const f32x4*)xr_; xq[buf][mt][1] = *(const f32x4*)(xr_ + 4); } } while (0)
        f32x4 acc[4][3]; float ssq[4];
#pragma unroll
        for (int mt = 0; mt < 4; ++mt) { acc[mt][0] = acc[mt][1] = acc[mt][2] = (f32x4){0.f, 0.f, 0.f, 0.f}; ssq[mt] = 0.f; }
        P5_LOAD(0, 0);
#pragma unroll
        for (int ks = 0; ks < 4; ++ks) {
            const int cb = ks & 1;
            __builtin_amdgcn_sched_barrier(0);
            if (ks < 3) P5_LOAD(cb ^ 1, ks + 1);
            const int k0 = wave * 128 + ks * 32 + kq * 8;
            bf16x8 bhq[3], blq[3];
#pragma unroll
            for (int nt = 0; nt < 3; ++nt) { const size_t o_ = (size_t)(nt * 16 + r16) * 1024 + k0; bhq[nt] = *(const bf16x8*)(WRhi + o_); blq[nt] = *(const bf16x8*)(WRlo + o_); }
            const f32x4 g0_ = *(const f32x4*)(g2 + k0), g1_ = *(const f32x4*)(g2 + k0 + 4);
#pragma unroll
            for (int mt = 0; mt < 4; ++mt) {
                const int row = 64 * wgi + 16 * mt + r16;
                const f32x4 xa = xq[cb][mt][0], xb = xq[cb][mt][1];
                ssq[mt] += (xa.x * xa.x + xa.y * xa.y) + (xa.z * xa.z + xa.w * xa.w) + (xb.x * xb.x + xb.y * xb.y) + (xb.z * xb.z + xb.w * xb.w);
                const f32x4 va_ = xa * g0_, vb_ = xb * g1_;
                float v[8] = {va_.x, va_.y, va_.z, va_.w, vb_.x, vb_.y, vb_.z, vb_.w};
                unsigned hi[8], lo[8];
#pragma unroll
                for (int i = 0; i < 8; ++i) { hi[i] = f2bf(v[i]); lo[i] = f2bf(v[i] - __uint_as_float(hi[i] << 16)); }
                v4u hw, lw;
                hw.x = hi[0] | (hi[1] << 16); hw.y = hi[2] | (hi[3] << 16); hw.z = hi[4] | (hi[5] << 16); hw.w = hi[6] | (hi[7] << 16);
                lw.x = lo[0] | (lo[1] << 16); lw.y = lo[2] | (lo[3] << 16); lw.z = lo[4] | (lo[5] << 16); lw.w = lo[6] | (lo[7] << 16);
                *(v4u*)(H2 + (size_t)row * D_MODEL + k0) = hw;
                const bf16x8 ahi = __builtin_bit_cast(bf16x8, hw), alo = __builtin_bit_cast(bf16x8, lw);
#pragma unroll
                for (int nt = 0; nt < 3; ++nt) {
                    acc[mt][nt] = __builtin_amdgcn_mfma_f32_16x16x32_bf16(ahi, bhq[nt], acc[mt][nt], 0, 0, 0);
                    acc[mt][nt] = __builtin_amdgcn_mfma_f32_16x16x32_bf16(ahi, blq[nt], acc[mt][nt], 0, 0, 0);
                    acc[mt][nt] = __builtin_amdgcn_mfma_f32_16x16x32_bf16(alo, bhq[nt], acc[mt][nt], 0, 0, 0);
                }
            }
        }
#undef P5_LOAD
        __syncthreads();
#pragma unroll
        for (int mt = 0; mt < 4; ++mt) {
            float s_ = ssq[mt]; s_ += __shfl_xor(s_, 16); s_ += __shfl_xor(s_, 32);
#pragma unroll
            for (int nt = 0; nt < 3; ++nt)
#pragma unroll
                for (int rg = 0; rg < 4; ++rg) PL[(wave * 64 + 16 * mt + 4 * kq + rg) * 49 + nt * 16 + r16] = acc[mt][nt][rg];
            if (kq == 0) PS[wave * 64 + 16 * mt + r16] = s_;
        }
        __syncthreads();
        { const int tk = tid >> 3, c0 = (tid & 7) * 6;
#pragma unroll
          for (int c = 0; c < 6; ++c) { float s = 0.f;
#pragma unroll
              for (int w = 0; w < 8; ++w) s += PL[(w * 64 + tk) * 49 + c0 + c];
              LG[tk * 49 + c0 + c] = s; }
          if ((tid & 7) == 0) { float s = 0.f;
#pragma unroll
              for (int w = 0; w < 8; ++w) s += PS[w * 64 + tk];
              SQ[tk] = s; } }
        __syncthreads();
        if (tid < 64) {
            const int tl = tid, tok = 64 * wgi + tl;
            const float rinv = 1.0f / sqrtf(SQ[tl] * (1.0f / D_MODEL) + RMS_EPS);
            const LAS float* p0 = LG + tl * 49;
            float gl[NEG]; float gm = -INFINITY; int gs = 0;
#pragma unroll
            for (int i = 0; i < NEG; ++i) { gl[i] = rinv * p0[i] + a->in[IN_BRG][i]; if (gl[i] > gm) { gm = gl[i]; gs = i; } }
            float gsum = 0.f;
#pragma unroll
            for (int i = 0; i < NEG; ++i) gsum += expf(gl[i] - gm);
            const float pg = 1.0f / gsum;
            float el[EPG]; float em = -INFINITY;
#pragma unroll
            for (int i = 0; i < EPG; ++i) { const int c = 4 + gs * EPG + i; el[i] = rinv * p0[c] + a->in[IN_BRE][gs * EPG + i]; em = fmaxf(em, el[i]); }
            float esum = 0.f;
#pragma unroll
            for (int i = 0; i < EPG; ++i) esum += expf(el[i] - em);
            int i0 = 0;
#pragma unroll
            for (int i = 1; i < EPG; ++i) if (el[i] > el[i0]) i0 = i;
            int i1 = (i0 == 0) ? 1 : 0;
#pragma unroll
            for (int i = 0; i < EPG; ++i) if (i != i0 && el[i] > el[i1]) i1 = i;
            float e0v = 0.f, e1v = 0.f;
#pragma unroll
            for (int i = 0; i < EPG; ++i) { if (i == i0) e0v = el[i]; if (i == i1) e1v = el[i]; }
            const int ea = gs * EPG + i0, eb = gs * EPG + i1;
            EID[tok * 2] = ea; EID[tok * 2 + 1] = eb;
            GATE[tok * 2] = pg * expf(e0v - em) / esum; GATE[tok * 2 + 1] = pg * expf(e1v - em) / esum;
            RINV[tok] = rinv;
            EL[tl * 2] = ea; EL[tl * 2 + 1] = eb;
        }
        __syncthreads();
        if (tid < 128) { const int e = EL[tid]; int rk = 0; for (int j = 0; j < tid; ++j) rk += (EL[j] == e) ? 1 : 0; LRANK[wgi * 128 + tid] = rk; }
        else if (tid < 160) { const int e = tid - 128; int c = 0; for (int j = 0; j < 128; ++j) c += (EL[j] == e) ? 1 : 0; CNT[wgi * 32 + e] = c; }
    }
    __syncthreads();
}

__device__ __forceinline__ void phase6(KArgs a, LAS unsigned char* lds, int, int, int, int vcu, int G) {
    int tid_ = threadIdx.x; asm volatile("" : "+v"(tid_)); const int lane = tid_ & 63, wave = __builtin_amdgcn_readfirstlane(tid_ >> 6); const int tid = tid_;
    unsigned char* ws = a->ws;
    const bf16_t* H2 = (const bf16_t*)(ws + WS_R1); bf16_t* ROWS = (bf16_t*)(ws + WS_ROWS);
    const float* RINV = (const float*)(ws + WS_SMALL + SM_RINV); const int* EID = (const int*)(ws + WS_SMALL + SM_EID); const float* GATE = (const float*)(ws + WS_SMALL + SM_GATE);
    const int* LRANK = (const int*)(ws + WS_SMALL + SM_LRANK); const int* CNT = (const int*)(ws + WS_SMALL + SM_CNT);
    int* DEST = (int*)(ws + WS_SMALL + SM_DEST); int* TOKROW = (int*)(ws + WS_SMALL + SM_TOKROW); float* ROWSC = (float*)(ws + WS_SMALL + SM_ROWSC); float* ROWGT = (float*)(ws + WS_SMALL + SM_ROWGT);
    int* TILEE = (int*)(ws + WS_SMALL + SM_TILEE); int* META = (int*)(ws + WS_SMALL + SM_META);
    LAS int* totS = (LAS int*)lds; LAS int* preS = totS + 32; LAS int* pstS = preS + 32; LAS int* dstS = pstS + 32;
    for (int wgi = vcu; wgi < T_TOK / 64; wgi += G) {
        __syncthreads();
        if (tid < 32) { int tot = 0, pre = 0; for (int w = 0; w < T_TOK / 64; ++w) { const int c = CNT[w * 32 + tid]; tot += c; pre += (w < wgi) ? c : 0; } totS[tid] = tot; preS[tid] = pre; }
        __syncthreads();
        if (tid == 0) { int run = 0; for (int e = 0; e < NE; ++e) { pstS[e] = run; run += ((totS[e] + 255) >> 8) << 8; }
            if (wgi == 0) { META[0] = run >> 8; for (int e = 0; e < NE; ++e) { const int t0 = pstS[e] >> 8, nt = (totS[e] + 255) >> 8; for (int j = 0; j < nt; ++j) TILEE[t0 + j] = e; } } }
        __syncthreads();
        if (tid < 128) { const int tok = 64 * wgi + (tid >> 1); const int e = EID[wgi * 128 + tid]; const int dest = pstS[e] + preS[e] + LRANK[wgi * 128 + tid];
            TOKROW[dest] = tok; ROWSC[dest] = RINV[tok]; ROWGT[dest] = GATE[wgi * 128 + tid]; DEST[wgi * 128 + tid] = dest; dstS[tid] = dest; }
        if (wgi == 0) { for (int e = 0; e < NE; ++e) { const int lo = pstS[e] + totS[e], hi = pstS[e] + (((totS[e] + 255) >> 8) << 8); for (int r = lo + tid; r < hi; r += 512) { TOKROW[r] = -1; ROWSC[r] = 0.f; ROWGT[r] = 0.f; } } }
        __syncthreads();
#pragma unroll 4
        for (int as = wave; as < 128; as += 8) { const int tok = 64 * wgi + (as >> 1), dest = dstS[as];
            const GAS v4u* src = (const GAS v4u*)(H2 + (size_t)tok * D_MODEL) + lane; GAS v4u* dst = (GAS v4u*)(ROWS + (size_t)dest * D_MODEL) + lane;
            const v4u r0 = src[0], r1 = src[64]; dst[0] = r0; dst[64] = r1; }
    }
    __syncthreads();
}

__device__ __forceinline__ void phase9(KArgs a, int, int, int vcu, int G) {
    int tid_ = threadIdx.x; asm volatile("" : "+v"(tid_)); const int lane = tid_ & 63, wave = __builtin_amdgcn_readfirstlane(tid_ >> 6);
    unsigned char* ws = a->ws; float* out = a->out; const float* gf = a->in[IN_NORM_FINAL];
    const bf16_t* Y = (const bf16_t*)(ws + WS_ROWS); const int* DEST = (const int*)(ws + WS_SMALL + SM_DEST);
    const int gw = vcu * 8 + wave, NGW = G * 8;
    f32x4 gv[4];
#pragma unroll
    for (int j = 0; j < 4; ++j) gv[j] = *(const f32x4*)(gf + 4 * lane + 256 * j);
    for (int m0 = gw * 4; m0 < T_TOK; m0 += NGW * 4) {
        int d0[4], d1[4];
#pragma unroll
        for (int j = 0; j < 4; ++j) { d0[j] = DEST[(m0 + j) * 2]; d1[j] = DEST[(m0 + j) * 2 + 1]; }
        f32x4 v[4][4]; v2u p[4][4], q[4][4];
#pragma unroll
        for (int j = 0; j < 4; ++j) {
            const GAS f32x4* xr = (const GAS f32x4*)(out + (size_t)(m0 + j) * D_MODEL) + lane;
            const GAS v2u* y0 = (const GAS v2u*)(Y + (size_t)d0[j] * D_MODEL) + lane; const GAS v2u* y1 = (const GAS v2u*)(Y + (size_t)d1[j] * D_MODEL) + lane;
#pragma unroll
            for (int i = 0; i < 4; ++i) { v[j][i] = xr[64 * i]; p[j][i] = y0[64 * i]; q[j][i] = y1[64 * i]; }
        }
#pragma unroll
        for (int j = 0; j < 4; ++j) {
            float s = 0.f;
#pragma unroll
            for (int i = 0; i < 4; ++i) { f32x4& w = v[j][i]; const v2u pp = p[j][i], qq = q[j][i];
                w.x += pg8::bf_lo(pp.x) + pg8::bf_lo(qq.x); w.y += pg8::bf_hi(pp.x) + pg8::bf_hi(qq.x); w.z += pg8::bf_lo(pp.y) + pg8::bf_lo(qq.y); w.w += pg8::bf_hi(pp.y) + pg8::bf_hi(qq.y);
                s += (w.x * w.x + w.y * w.y) + (w.z * w.z + w.w * w.w); }
            const float rstd = 1.f / sqrtf(wave_sum(s) * (1.f / D_MODEL) + RMS_EPS);
            GAS f32x4* xo = (GAS f32x4*)(out + (size_t)(m0 + j) * D_MODEL) + lane;
#pragma unroll
            for (int i = 0; i < 4; ++i) xo[64 * i] = v[j][i] * rstd * gv[i];
        }
    }
}


namespace att {
typedef float f32x16 __attribute__((ext_vector_type(16)));
typedef short s16x4 __attribute__((ext_vector_type(4)));
typedef short v4i16_t __attribute__((ext_vector_type(4)));
constexpr int KBUF = 8192, VBUF = 16384, SLOT = KBUF + VBUF, OST = 2 * SLOT, WSF = OST + 8 * 8192, ATT_LDS = WSF + 8 * 256;
constexpr float THR = 8.0f;
__device__ __forceinline__ int crow(int r, int hi) { return (r & 3) + 8 * (r >> 2) + 4 * hi; }
__device__ __forceinline__ unsigned cvtpk(float lo, float hi) { typedef float f2 __attribute__((ext_vector_type(2))); typedef __bf16 b2 __attribute__((ext_vector_type(2))); f2 v = {lo, hi}; b2 b = __builtin_convertvector(v, b2); return __builtin_bit_cast(unsigned, b); }
__device__ __forceinline__ s16x4 vtr(const LAS unsigned char* p) { return __builtin_bit_cast(s16x4, __builtin_amdgcn_ds_read_tr16_b64_v4i16((LAS v4i16_t*)p)); }
#define MX3(a, b, c) __builtin_fmaxf(__builtin_fmaxf((a), (b)), (c))
__device__ __forceinline__ float rowmax(const f32x16& p0, const f32x16& p1) {
    float a = MX3(p0[0], p0[1], p1[0]), b = MX3(p0[2], p0[3], p1[1]); a = MX3(a, p1[2], p1[3]);
#pragma unroll
    for (int r = 4; r < 16; r += 4) { a = MX3(a, p0[r], p0[r + 1]); b = MX3(b, p0[r + 2], p0[r + 3]); a = MX3(a, p1[r], p1[r + 1]); b = MX3(b, p1[r + 2], p1[r + 3]); }
    float m = __builtin_fmaxf(a, b); auto rr = __builtin_amdgcn_permlane32_swap(__float_as_uint(m), __float_as_uint(m), false, false);
    return __builtin_fmaxf(__uint_as_float(rr[0]), __uint_as_float(rr[1]));
}
#undef MX3

__device__ __forceinline__ void attn_part(int b, int h, int mp, int qb, int t_lo, int t_hi, const bf16_t* __restrict__ Q, const bf16_t* __restrict__ K, const bf16_t* __restrict__ V,
                                          bf16_t* __restrict__ PBs, float* __restrict__ MLs, LAS unsigned char* lds) {
    int tid_ = threadIdx.x; asm volatile("" : "+v"(tid_));
    const int lane = tid_ & 63, wid = __builtin_amdgcn_readfirstlane(tid_ >> 6);
    const int r32 = lane & 31, hi = lane >> 5;
    const int rowbase = b * SEQ, q0 = qb * 256, NT = t_hi - t_lo;
    const int qabs = q0 + wid * 32 + r32;
    const float slope2 = exp2f(-2.0f * (float)(h + 1)) * LOG2E;
    const bf16_t* Qw = Q + (size_t)(rowbase + q0 + wid * 32) * 512 + h * 128 + mp * 64;
    bf16x8 qr[4];
#pragma unroll
    for (int d0 = 0; d0 < 4; ++d0) qr[d0] = *(const bf16x8*)(Qw + (size_t)r32 * 512 + d0 * 16 + hi * 8);
    const bf16_t* ksrc = K + (size_t)(rowbase + lane) * 512 + h * 128 + mp * 64 + wid * 8;
    const int p0i = 2 * wid, p1i = 2 * wid + 1;
    const bf16_t* vsrc0 = V + (size_t)(rowbase + 16 * (p0i & 3) + (lane >> 2)) * 512 + h * 128 + (p0i >> 2) * 32 + (lane & 3) * 8;
    const bf16_t* vsrc1 = V + (size_t)(rowbase + 16 * (p1i & 3) + (lane >> 2)) * 512 + h * 128 + (p1i >> 2) * 32 + (lane & 3) * 8;
#define ATT_DMA(t, kso, vso) do { const size_t go_ = (size_t)(t) * 64 * 512; \
        __builtin_amdgcn_global_load_lds((const unsigned*)(ksrc + go_), (LAS unsigned*)(lds + (kso) + wid * 1024), 16, 0, 0); \
        __builtin_amdgcn_global_load_lds((const unsigned*)(vsrc0 + go_), (LAS unsigned*)(lds + (vso) + p0i * 1024), 16, 0, 0); \
        __builtin_amdgcn_global_load_lds((const unsigned*)(vsrc1 + go_), (LAS unsigned*)(lds + (vso) + p1i * 1024), 16, 0, 0); } while (0)
    LAS float* wsf = (LAS float*)(lds + 65536 + wid * 8192);
    float mref = 0.f, l_reg = 0.f; bool started = false;
    f32x16 o[4];
#pragma unroll
    for (int d = 0; d < 4; ++d) o[d] = (f32x16){};
    const int voff_lane = ((lane >> 4) & 1) * 32 + (lane & 3) * 8 + (4 * hi + ((lane & 15) >> 2)) * 64;
    s16x4 va[8], vb[8];
#define VLOAD(dst, vp, d) do { _Pragma("unroll") for (int ks_ = 0; ks_ < 4; ++ks_) { dst[2 * ks_] = vtr((vp) + (d) * 4096 + ks_ * 1024); dst[2 * ks_ + 1] = vtr((vp) + (d) * 4096 + ks_ * 1024 + 512); } } while (0)
#define VMMA(src, pw_, d) do { _Pragma("unroll") for (int ks_ = 0; ks_ < 4; ++ks_) { const bf16x8 vf_ = (bf16x8){src[2 * ks_][0], src[2 * ks_][1], src[2 * ks_][2], src[2 * ks_][3], src[2 * ks_ + 1][0], src[2 * ks_ + 1][1], src[2 * ks_ + 1][2], src[2 * ks_ + 1][3]}; \
        o[d] = __builtin_amdgcn_mfma_f32_32x32x16_bf16(__builtin_bit_cast(bf16x8, pw_[ks_]), vf_, o[d], 0, 0, 0); } } while (0)
#define QKT(t, kso) do { const float tb_ = slope2 * (float)(64 * (t) + 4 * hi - qabs) - (started ? mref : 0.f), tb1_ = tb_ + 32.0f * slope2; \
        _Pragma("unroll") for (int r = 0; r < 16; ++r) { const float kr_ = (float)((r & 3) + 8 * (r >> 2)); c0[r] = __builtin_fmaf(slope2, kr_, tb_); c1[r] = __builtin_fmaf(slope2, kr_, tb1_); } \
        const LAS unsigned char* kp_ = lds + (kso) + hi * 1024 + r32 * 16; bf16x8 kf_[8]; \
        _Pragma("unroll") for (int d0 = 0; d0 < 4; ++d0) { kf_[2 * d0] = *(const LAS bf16x8*)(kp_ + d0 * 2048); kf_[2 * d0 + 1] = *(const LAS bf16x8*)(kp_ + d0 * 2048 + 512); } \
        __builtin_amdgcn_sched_barrier(0); \
        _Pragma("unroll") for (int d0 = 0; d0 < 4; ++d0) { c0 = __builtin_amdgcn_mfma_f32_32x32x16_bf16(kf_[2 * d0], qr[d0], c0, 0, 0, 0); c1 = __builtin_amdgcn_mfma_f32_32x32x16_bf16(kf_[2 * d0 + 1], qr[d0], c1, 0, 0, 0); } } while (0)
#define DECIDE(resc_) do { const float rm_ = rowmax(c0, c1); resc_ = false; \
        if (!started) { mref = rm_; _Pragma("unroll") for (int r = 0; r < 16; ++r) { c0[r] -= rm_; c1[r] -= rm_; } started = true; } \
        else if (__any(rm_ > THR)) { const float dl_ = __builtin_fmaxf(rm_, 0.f); mref += dl_; _Pragma("unroll") for (int r = 0; r < 16; ++r) { c0[r] -= dl_; c1[r] -= dl_; } \
            const float f_ = __builtin_amdgcn_exp2f(-dl_); l_reg *= f_; if (hi == 0) wsf[r32] = f_; resc_ = true; } } while (0)
#define ORESC() do { float fr_[16]; _Pragma("unroll") for (int r = 0; r < 16; ++r) fr_[r] = wsf[crow(r, hi)]; \
        _Pragma("unroll") for (int d = 0; d < 4; ++d) _Pragma("unroll") for (int r = 0; r < 16; ++r) o[d][r] *= fr_[r]; } while (0)
#define EXPPACK(cc, base, pwout) do { float s_ = 0.f; _Pragma("unroll") for (int r = 0; r < 8; ++r) { cc[(base) + r] = __builtin_amdgcn_exp2f(cc[(base) + r]); s_ += cc[(base) + r]; } l_reg += s_; \
        _Pragma("unroll") for (int i_ = 0; i_ < 4; ++i_) pwout[i_] = cvtpk(cc[(base) + 2 * i_], cc[(base) + 2 * i_ + 1]); } while (0)
    int kso_c = 0, vso_c = 16384;
    ATT_DMA(t_hi - 1, kso_c, vso_c);
    VM_WAIT();
    __syncthreads();
    const int n_simple = (t_hi == 4 * qb + 4) ? (NT < 4 ? NT : 4) : 1;
    int it = 0;
    for (; it < n_simple; ++it) {
        const int t = t_hi - 1 - it;
        const int kso_n = kso_c ^ 8192, vso_n = (vso_c == 16384 + 2 * 16384) ? 16384 : vso_c + 16384;
        if (it + 1 < NT) ATT_DMA(t - 1, kso_n, vso_n);
        const bool active = (64 * t <= q0 + 32 * wid + 31);
        if (active) {
            f32x16 c0, c1;
            QKT(t, kso_c);
            const LAS unsigned char* vp = lds + vso_c + voff_lane;
            __builtin_amdgcn_sched_barrier(0);
            VLOAD(va, vp, 0); VLOAD(vb, vp, 1);
            __builtin_amdgcn_sched_barrier(0);
            if (64 * t + 63 > q0 + 32 * wid) {
#pragma unroll
                for (int r = 0; r < 16; ++r) { const int kv = 64 * t + crow(r, hi); if (kv > qabs) c0[r] = -INFINITY; if (kv + 32 > qabs) c1[r] = -INFINITY; }
            }
            bool resc; DECIDE(resc); if (resc) ORESC();
            v4u pw[4];
            EXPPACK(c0, 0, pw[0]); EXPPACK(c0, 8, pw[1]); EXPPACK(c1, 0, pw[2]); EXPPACK(c1, 8, pw[3]);
            VMMA(va, pw, 0); __builtin_amdgcn_sched_barrier(0);
            VLOAD(va, vp, 2); __builtin_amdgcn_sched_barrier(0);
            VMMA(vb, pw, 1); __builtin_amdgcn_sched_barrier(0);
            VLOAD(vb, vp, 3); __builtin_amdgcn_sched_barrier(0);
            VMMA(va, pw, 2); VMMA(vb, pw, 3);
        }
        VM_WAIT();
        __syncthreads();
        kso_c = kso_n; vso_c = vso_n;
    }
    if (it < NT) {
        v4u pwp[4];
        int vso_p;
        {
            const int t = t_hi - 1 - it;
            const int kso_n = kso_c ^ 8192, vso_n = (vso_c == 16384 + 2 * 16384) ? 16384 : vso_c + 16384;
            if (it + 1 < NT) ATT_DMA(t - 1, kso_n, vso_n);
            f32x16 c0, c1;
            QKT(t, kso_c);
            bool resc; DECIDE(resc); if (resc) ORESC();
            EXPPACK(c0, 0, pwp[0]); EXPPACK(c0, 8, pwp[1]); EXPPACK(c1, 0, pwp[2]); EXPPACK(c1, 8, pwp[3]);
            VM_WAIT();
            __syncthreads();
            vso_p = vso_c; kso_c = kso_n; vso_c = vso_n; ++it;
        }
        for (; it < NT; ++it) {
            const int t = t_hi - 1 - it;
            const int kso_n = kso_c ^ 8192, vso_n = (vso_c == 16384 + 2 * 16384) ? 16384 : vso_c + 16384;
            if (it + 1 < NT) ATT_DMA(t - 1, kso_n, vso_n);
            f32x16 c0, c1;
            QKT(t, kso_c);
            const LAS unsigned char* vp = lds + vso_p + voff_lane;
            __builtin_amdgcn_sched_barrier(0);
            VLOAD(va, vp, 0); VLOAD(vb, vp, 1);
            __builtin_amdgcn_sched_barrier(0);
            bool resc; DECIDE(resc);
            __builtin_amdgcn_sched_barrier(0);
            v4u pwc[4];
            VMMA(va, pwp, 0); EXPPACK(c0, 0, pwc[0]); __builtin_amdgcn_sched_barrier(0);
            VLOAD(va, vp, 2); VMMA(vb, pwp, 1); EXPPACK(c0, 8, pwc[1]); __builtin_amdgcn_sched_barrier(0);
            VLOAD(vb, vp, 3); VMMA(va, pwp, 2); EXPPACK(c1, 0, pwc[2]); __builtin_amdgcn_sched_barrier(0);
            VMMA(vb, pwp, 3); EXPPACK(c1, 8, pwc[3]); __builtin_amdgcn_sched_barrier(0);
            if (resc) ORESC();
#pragma unroll
            for (int k_ = 0; k_ < 4; ++k_) pwp[k_] = pwc[k_];
            VM_WAIT();
            __syncthreads();
            vso_p = vso_c; kso_c = kso_n; vso_c = vso_n;
        }
        {
            const LAS unsigned char* vp = lds + vso_p + voff_lane;
            VLOAD(va, vp, 0); VLOAD(vb, vp, 1);
            VMMA(va, pwp, 0); __builtin_amdgcn_sched_barrier(0);
            VLOAD(va, vp, 2); __builtin_amdgcn_sched_barrier(0);
            VMMA(vb, pwp, 1); __builtin_amdgcn_sched_barrier(0);
            VLOAD(vb, vp, 3); __builtin_amdgcn_sched_barrier(0);
            VMMA(va, pwp, 2); VMMA(vb, pwp, 3);
        }
        __syncthreads();
    }
#undef ATT_DMA
#undef VLOAD
#undef VMMA
#undef QKT
#undef DECIDE
#undef ORESC
#undef EXPPACK
    { auto rr = __builtin_amdgcn_permlane32_swap(__float_as_uint(l_reg), __float_as_uint(l_reg), false, false); l_reg = __uint_as_float(rr[0]) + __uint_as_float(rr[1]); }
    if (hi == 0) { typedef float f2v __attribute__((ext_vector_type(2))); *(f2v*)(MLs + (size_t)(wid * 32 + r32) * 2) = (f2v){started ? mref : -1e30f, l_reg}; }
    LAS bf16_t* stg = (LAS bf16_t*)(lds + 65536 + wid * 8192);
#pragma unroll
    for (int r = 0; r < 16; ++r)
#pragma unroll
        for (int d = 0; d < 4; d += 1) stg[crow(r, hi) * 128 + d * 32 + r32] = (bf16_t)f2bf(o[d][r]);
    bf16_t* Ow = PBs + (size_t)(wid * 32) * 128;
#pragma unroll
    for (int i = 0; i < 8; ++i) { const int row = 4 * i + (lane >> 4), ch = lane & 15; const v4u v = *(const LAS v4u*)(stg + row * 128 + ch * 8); *(v4u*)(Ow + (size_t)row * 128 + ch * 8) = v; }
    __syncthreads();
}
}

namespace s5 {
typedef float f32x16 __attribute__((ext_vector_type(16)));
typedef short s16x4 __attribute__((ext_vector_type(4)));
typedef short v4i16_t __attribute__((ext_vector_type(4)));
constexpr int ES_OFF = 132096, KAP_OFF = ES_OFF + 4096;
__device__ __forceinline__ s16x4 vtr(const LAS unsigned char* p) { return __builtin_bit_cast(s16x4, __builtin_amdgcn_ds_read_tr16_b64_v4i16((LAS v4i16_t*)p)); }
__device__ __forceinline__ void s5_unit(int b, int g, KArgs a, LAS unsigned char* lds) {
    int tid_ = threadIdx.x; asm volatile("" : "+v"(tid_));
    const int lane = tid_ & 63, wid = __builtin_amdgcn_readfirstlane(tid_ >> 6);
    const bf16_t* U = (const bf16_t*)(a->ws + WS_U); bf16_t* Yg = (bf16_t*)(a->ws + WS_YG);
    const int n = lane, r32 = lane & 31, hi = lane >> 5, r16 = lane & 15, kq = lane >> 4;
    LAS unsigned char* wl = lds + wid * 16384;
    LAS float* es = (LAS float*)(lds + ES_OFF);
    LAS float* kap = (LAS float*)(lds + KAP_OFF) + wid * 128;
    LAS unsigned char* us = lds + 140288 + wid * 1024;
    const double dt = exp((double)a->in[IN_LOG_DT][g]);
    const double lr = a->in[IN_LAM_RE][g * NS + n], li = a->in[IN_LAM_IM][g * NS + n];
    const double mag = exp(lr * dt);
    const double ar_d = mag * cos(li * dt), ai_d = mag * sin(li * dt);
    const double nr = ar_d - 1.0, ni = ai_d, den = lr * lr + li * li;
    const float ar = (float)ar_d, ai = (float)ai_d;
    kap[n] = (float)((nr * lr + ni * li) / den); kap[64 + n] = (float)((ni * lr - nr * li) / den);
    const double magL = exp(lr * dt * 1024.0);
    const float pr = (float)(magL * cos(li * dt * 1024.0)), pim = (float)(magL * sin(li * dt * 1024.0));
    bf16x8 bfrag[4];
#pragma unroll
    for (int nb = 0; nb < 4; ++nb) {
        const int n2 = 32 * (nb & 1) + r32; const float kr2 = kap[n2], ki2 = kap[64 + n2];
        const float* pre = a->in[IN_B_RE] + (size_t)(g * NS + n2) * GC + 8 * hi; const float* pim_ = a->in[IN_B_IM] + (size_t)(g * NS + n2) * GC + 8 * hi;
        float v[8];
#pragma unroll
        for (int j = 0; j < 8; ++j) v[j] = (nb < 2) ? (kr2 * pre[j] - ki2 * pim_[j]) : (kr2 * pim_[j] + ki2 * pre[j]);
        v4u w; w.x = pk2(v[0], v[1]); w.y = pk2(v[2], v[3]); w.z = pk2(v[4], v[5]); w.w = pk2(v[6], v[7]);
        bfrag[nb] = __builtin_bit_cast(bf16x8, w);
    }
    bf16x8 cfrag[4];
#pragma unroll
    for (int ks = 0; ks < 4; ++ks) {
        const int k0 = 32 * (ks & 1) + 8 * kq; const float* src = a->in[ks < 2 ? IN_C_RE : IN_C_IM] + (size_t)(g * GC + r16) * NS + k0; const float sg = ks < 2 ? 1.f : -1.f;
        v4u w; w.x = pk2(sg * src[0], sg * src[1]); w.y = pk2(sg * src[2], sg * src[3]); w.z = pk2(sg * src[4], sg * src[5]); w.w = pk2(sg * src[6], sg * src[7]);
        cfrag[ks] = __builtin_bit_cast(bf16x8, w);
    }
    const float dsk = a->in[IN_SSM_D][g * GC + r16];
    const int tokbase = b * SEQ + wid * 1024;
    const int sw = n & 7;
    float cr_ = 0.f, ci_ = 0.f;
    for (int pass = 0; pass < 2; ++pass) {
        float xr = cr_, xi = ci_;
        bf16x8 unext = *(const bf16x8*)(U + (size_t)(tokbase + r32) * SSM_W + g * GC + 8 * hi);
        for (int ch = 0; ch < 32; ++ch) {
            const int t0 = tokbase + 32 * ch;
            const bf16x8 ufrag = unext;
            if (ch < 31) unext = *(const bf16x8*)(U + (size_t)(t0 + 32 + r32) * SSM_W + g * GC + 8 * hi);
            *(LAS bf16x8*)(us + r32 * 32 + hi * 16) = ufrag;
#pragma unroll
            for (int nb = 0; nb < 4; ++nb) {
                const f32x16 acc = __builtin_amdgcn_mfma_f32_32x32x16_bf16(ufrag, bfrag[nb], (f32x16){}, 0, 0, 0);
                const int col = 32 * nb + r32;
#pragma unroll
                for (int rr = 0; rr < 4; ++rr) *(LAS f32x4*)(wl + col * 128 + (((2 * rr + hi) ^ (col & 7)) * 16)) = (f32x4){acc[4 * rr], acc[4 * rr + 1], acc[4 * rr + 2], acc[4 * rr + 3]};
            }
            f32x4 bur[8], bui[8];
#pragma unroll
            for (int s = 0; s < 8; ++s) { bur[s] = *(const LAS f32x4*)(wl + n * 128 + ((s ^ sw) * 16)); bui[s] = *(const LAS f32x4*)(wl + (64 + n) * 128 + ((s ^ sw) * 16)); }
            unsigned xrp[16], xip[16];
#pragma unroll
            for (int s = 0; s < 8; ++s) {
                float xa[4], xb[4];
#pragma unroll
                for (int i = 0; i < 4; ++i) { const float nxr = ar * xr - ai * xi + bur[s][i], nxi = ar * xi + ai * xr + bui[s][i]; xr = nxr; xi = nxi; xa[i] = xr; xb[i] = xi; }
                xrp[2 * s] = att::cvtpk(xa[0], xa[1]); xrp[2 * s + 1] = att::cvtpk(xa[2], xa[3]); xip[2 * s] = att::cvtpk(xb[0], xb[1]); xip[2 * s + 1] = att::cvtpk(xb[2], xb[3]);
            }
            if (pass == 1) {
#pragma unroll
                for (int s2 = 0; s2 < 4; ++s2) {
                    *(LAS v4u*)(wl + n * 128 + ((s2 ^ (n & 3)) * 16)) = (v4u){xrp[4 * s2], xrp[4 * s2 + 1], xrp[4 * s2 + 2], xrp[4 * s2 + 3]};
                    *(LAS v4u*)(wl + (64 + n) * 128 + ((s2 ^ (n & 3)) * 16)) = (v4u){xip[4 * s2], xip[4 * s2 + 1], xip[4 * s2 + 2], xip[4 * s2 + 3]};
                }
                const int q = r16 >> 2, p = r16 & 3;
#pragma unroll
                for (int tt = 0; tt < 2; ++tt) {
                    f32x4 acc4 = (f32x4){0.f, 0.f, 0.f, 0.f};
                    const int s2 = 2 * tt + (p >> 1);
#pragma unroll
                    for (int ks = 0; ks < 4; ++ks) {
                        const LAS unsigned char* ad = wl + (32 * ks + 8 * kq + q) * 128 + ((s2 ^ q) * 16) + (p & 1) * 8;
                        const s16x4 lo = vtr(ad), hh = vtr(ad + 4 * 128);
                        const bf16x8 af = (bf16x8){lo[0], lo[1], lo[2], lo[3], hh[0], hh[1], hh[2], hh[3]};
                        acc4 = __builtin_amdgcn_mfma_f32_16x16x32_bf16(af, cfrag[ks], acc4, 0, 0, 0);
                    }
#pragma unroll
                    for (int rg = 0; rg < 4; ++rg) {
                        const size_t tk = (size_t)(t0 + 16 * tt + 4 * kq + rg);
                        const float y = acc4[rg] + dsk * bf2f(*(const LAS unsigned short*)(us + (16 * tt + 4 * kq + rg) * 32 + r16 * 2));
                        const float z = 0.7978845608028654f * (y + 0.044715f * y * y * y);
                        Yg[tk * SSM_W + g * GC + r16] = (bf16_t)f2bf(y * pg8::sigmoid_f(2.0f * z));
                    }
                }
            }
        }
        if (pass == 0) {
            es[(wid * 64 + n) * 2] = xr; es[(wid * 64 + n) * 2 + 1] = xi;
            __syncthreads();
            float c_r = 0.f, c_i = 0.f;
            for (int v = 0; v < wid; ++v) { const float er = es[(v * 64 + n) * 2], ei = es[(v * 64 + n) * 2 + 1]; const float t_r = pr * c_r - pim * c_i + er, t_i = pr * c_i + pim * c_r + ei; c_r = t_r; c_i = t_i; }
            cr_ = c_r; ci_ = c_i;
        }
    }
    __syncthreads();
}
}

constexpr int CW_WQ = 2048, CW_NORMS = 2560;
constexpr int TAB_OFF = 149760;
constexpr int MAXSLOTS = 1024;
constexpr size_t SM_UT = 1608 * KiB;
#ifndef ATT_WINDOW
#define ATT_WINDOW 0
#endif
constexpr float T2_SKIP = 40.0f;
__device__ __forceinline__ void unit_decode(int u, int& b, int& h, int& mp, int& qb) { h = 3 - (u >> 7); qb = 31 - ((u & 127) >> 2); b = (u >> 1) & 1; mp = u & 1; }
__device__ __forceinline__ int build_part_table(KArgs a, LAS unsigned char* lds, int tid, int lane, int wave, bool writer) {
    LAS unsigned short* tab = (LAS unsigned short*)(lds + TAB_OFF); LAS unsigned short* u_tl = tab + 2048; LAS unsigned short* u_st = u_tl + 512; LAS unsigned char* u_P = (LAS unsigned char*)(u_st + 512);
    LAS int* scn = (LAS int*)(lds + TAB_OFF + 4096 + 1024 + 1024 + 512);
    int b, h, mp, qb; unit_decode(tid, b, h, mp, qb);
    int t_lo = 0;
#if ATT_WINDOW
    { const unsigned* nq = (const unsigned*)(a->ws + WS_CTL) + CW_NORMS + b * 16 + h * 4 + mp * 2; const unsigned* nk = nq + 32;
      const float bound = __uint_as_float(__hip_atomic_load(nq, __ATOMIC_RELAXED, __HIP_MEMORY_SCOPE_AGENT)) * __uint_as_float(__hip_atomic_load(nk, __ATOMIC_RELAXED, __HIP_MEMORY_SCOPE_AGENT))
                        + __uint_as_float(__hip_atomic_load(nq + 1, __ATOMIC_RELAXED, __HIP_MEMORY_SCOPE_AGENT)) * __uint_as_float(__hip_atomic_load(nk + 1, __ATOMIC_RELAXED, __HIP_MEMORY_SCOPE_AGENT));
      const float slope2 = exp2f(-2.0f * (float)(h + 1)) * LOG2E;
      const float W = fminf((T2_SKIP + 2.0f * bound) / slope2 + 2.0f, 1.0e6f);
      const int kmin = qb * 256 - (int)W; t_lo = kmin <= 0 ? 0 : (kmin >> 6); }
#endif
    const int NT = 4 * qb + 4 - t_lo;
    const int P32 = (NT + 31) / 32, P48 = (NT + 47) / 48;
    int P = P32, tot = 0, incl = 0;
    for (int attempt = 0; attempt < 2; ++attempt) {
        incl = P;
#pragma unroll
        for (int o = 1; o < 64; o <<= 1) { const int v = __shfl_up(incl, o); if (lane >= o) incl += v; }
        __syncthreads();
        if (lane == 63) scn[wave] = incl;
        __syncthreads();
        int base = 0; tot = 0;
        for (int w = 0; w < 8; ++w) { const int c = scn[w]; if (w < wave) base += c; tot += c; }
        incl += base;
        if (tot <= MAXSLOTS) break;
        P = P48;
    }
    const int start = incl - P;
    u_tl[tid] = (unsigned short)t_lo; u_st[tid] = (unsigned short)start; u_P[tid] = (unsigned char)P;
    for (int p = 0; p < P; ++p) tab[start + p] = (unsigned short)(tid | (p << 9));
    if (writer) { int* UT = (int*)(a->ws + WS_SMALL + SM_UT); UT[tid * 2] = start; UT[tid * 2 + 1] = P; }
    __syncthreads();
    return tot;
}
__device__ __forceinline__ void phase2_mixer(KArgs a, LAS unsigned char* lds, int tid, int lane, int wave, int vcu, int G) {
    unsigned char* ws = a->ws;
    unsigned* wq = (unsigned*)(ws + WS_CTL) + CW_WQ + a->bar_region;
    const int NP = build_part_table(a, lds, tid, lane, wave, vcu == 0);
    LAS unsigned short* tab = (LAS unsigned short*)(lds + TAB_OFF); LAS unsigned short* u_tl = tab + 2048; LAS unsigned char* u_P = (LAS unsigned char*)(tab + 2048 + 1024);
    LAS int* nxt = (LAS int*)(lds + TAB_OFF + 4096 + 1024 + 1024 + 512) + 12;
    const int NITEMS = BATCH * NG + NCONV + NP;
    for (;;) {
        { int t0_ = threadIdx.x; asm volatile("" : "+v"(t0_)); if (t0_ == 0) *nxt = (int)__hip_atomic_fetch_add(wq, 1u, __ATOMIC_RELAXED, __HIP_MEMORY_SCOPE_AGENT); }
        __syncthreads();
        const int idx = __builtin_amdgcn_readfirstlane(*nxt);
        __syncthreads();
        if (idx >= NITEMS) break;
        KArgs kb = a; asm volatile("" : "+s"(kb));
        if (idx < BATCH * NG) { s5::s5_unit(idx / NG, idx % NG, kb, lds); continue; }
        const int j_ = idx - BATCH * NG;
        if (j_ < 3 * NCONV && (j_ % 3) == 2) { conv_moe_item(kb, j_ / 3, lds); continue; }
        const int slot = (j_ < 3 * NCONV) ? j_ - j_ / 3 : j_ - NCONV; const int e = __builtin_amdgcn_readfirstlane((int)tab[slot]); const int u = e & 511, p = e >> 9;
        int b, h, mp, qb; unit_decode(u, b, h, mp, qb);
        const int tl = __builtin_amdgcn_readfirstlane((int)u_tl[u]), P = __builtin_amdgcn_readfirstlane((int)u_P[u]), NT = 4 * qb + 4 - tl;
        unsigned char* wsb = kb->ws;
        att::attn_part(b, h, mp, qb, tl + (NT * p) / P, tl + (NT * (p + 1)) / P, (const bf16_t*)(wsb + WS_Q), (const bf16_t*)(wsb + WS_K), (const bf16_t*)(wsb + WS_V),
                       (bf16_t*)kb->out + (size_t)slot * 256 * 128, (float*)(wsb + WS_O1) + (size_t)slot * 512, lds);
    }
}
__device__ __forceinline__ void attn_finish(KArgs a, int, int, int vcu, int G) {
    int tid_ = threadIdx.x; asm volatile("" : "+v"(tid_)); const int lane = tid_ & 63, wave = __builtin_amdgcn_readfirstlane(tid_ >> 6);
    unsigned char* ws = a->ws;
    const bf16_t* PB = (const bf16_t*)a->out; const float* ML = (const float*)(ws + WS_O1); const int* UT = (const int*)(ws + WS_SMALL + SM_UT); bf16_t* CC = (bf16_t*)(ws + WS_R1);
    float s1 = a->in[IN_LQ1][lane] * a->in[IN_LK1][lane], s2 = a->in[IN_LQ2][lane] * a->in[IN_LK2][lane];
    s1 = wave_sum(s1); s2 = wave_sum(s2);
    const float lam = expf(s1) - expf(s2) + LAM_INIT;
    const int h = lane >> 4, dcol = 8 * (lane & 15);
    float gn[8];
#pragma unroll
    for (int i = 0; i < 8; ++i) gn[i] = a->in[IN_SUBLN][dcol + i] * (1.0f - LAM_INIT);
    const int gw = vcu * 8 + wave, NGW = G * 8;
    typedef float f2v __attribute__((ext_vector_type(2)));
    for (int blk = gw; blk < T_TOK / 4; blk += NGW) {
        const int tok0 = blk * 4, b = tok0 >> 13, pos0 = tok0 & (SEQ - 1), qb = pos0 >> 8, row0 = pos0 & 255;
        int st[2], Pn[2];
#pragma unroll
        for (int mp = 0; mp < 2; ++mp) { const int u = ((3 - h) << 7) | ((31 - qb) << 2) | (b << 1) | mp; st[mp] = UT[u * 2]; Pn[mp] = UT[u * 2 + 1]; }
        float om[2][4][8];
#pragma unroll
        for (int mp = 0; mp < 2; ++mp) {
            f2v ml[4][4];
#pragma unroll
            for (int p = 0; p < 4; ++p)
#pragma unroll
                for (int j = 0; j < 4; ++j) { const int sp = st[mp] + (p < Pn[mp] ? p : 0); f2v t = *(const f2v*)(ML + ((size_t)sp * 256 + row0 + j) * 2); if (p >= Pn[mp]) t = (f2v){-1e30f, 0.f}; ml[p][j] = t; }
            v4u xv[4][4];
#pragma unroll
            for (int p = 0; p < 4; ++p)
#pragma unroll
                for (int j = 0; j < 4; ++j) { const int sp = st[mp] + (p < Pn[mp] ? p : 0); xv[p][j] = *(const v4u*)(PB + ((size_t)sp * 256 + row0 + j) * 128 + dcol); }
#pragma unroll
            for (int j = 0; j < 4; ++j) {
                const float M = fmaxf(fmaxf(ml[0][j].x, ml[1][j].x), fmaxf(ml[2][j].x, ml[3][j].x));
                float L = 0.f, acc[8] = {0.f, 0.f, 0.f, 0.f, 0.f, 0.f, 0.f, 0.f};
#pragma unroll
                for (int p = 0; p < 4; ++p) { const float w = __builtin_amdgcn_exp2f(ml[p][j].x - M); L += w * ml[p][j].y; const v4u x = xv[p][j];
                    acc[0] += w * pg8::bf_lo(x.x); acc[1] += w * pg8::bf_hi(x.x); acc[2] += w * pg8::bf_lo(x.y); acc[3] += w * pg8::bf_hi(x.y);
                    acc[4] += w * pg8::bf_lo(x.z); acc[5] += w * pg8::bf_hi(x.z); acc[6] += w * pg8::bf_lo(x.w); acc[7] += w * pg8::bf_hi(x.w); }
                const float rl = 1.0f / L;
#pragma unroll
                for (int i = 0; i < 8; ++i) om[mp][j][i] = acc[i] * rl;
            }
        }
#pragma unroll
        for (int j = 0; j < 4; ++j) {
            float v[8]; float ss = 0.f;
#pragma unroll
            for (int i = 0; i < 8; ++i) { v[i] = om[0][j][i] - lam * om[1][j][i]; ss += v[i] * v[i]; }
            ss += __shfl_xor(ss, 1); ss += __shfl_xor(ss, 2); ss += __shfl_xor(ss, 4); ss += __shfl_xor(ss, 8);
            const float r = 1.0f / sqrtf(ss * (1.0f / DV) + RMS_EPS);
            v4u w; w.x = pk2(v[0] * r * gn[0], v[1] * r * gn[1]); w.y = pk2(v[2] * r * gn[2], v[3] * r * gn[3]); w.z = pk2(v[4] * r * gn[4], v[5] * r * gn[5]); w.w = pk2(v[6] * r * gn[6], v[7] * r * gn[7]);
            *(v4u*)(CC + (size_t)(tok0 + j) * D_MODEL + 512 + 8 * lane) = w;
        }
    }
}

__global__ void __launch_bounds__(512, 2) mk_fwd(Args args) {
    extern __shared__ __attribute__((aligned(16))) unsigned char lds_raw[];
    LAS unsigned char* lds = (LAS unsigned char*)lds_raw;
    const int tid = threadIdx.x, lane = tid & 63, wave = __builtin_amdgcn_readfirstlane(tid >> 6);
    const int G = gridDim.x; const int bx = blockIdx.x; const int vcu = (G % 8 == 0) ? (bx % 8) * (G / 8) + bx / 8 : bx;
    unsigned char* ws = args.ws;
    const KArgs ka = (KArgs)__builtin_amdgcn_kernarg_segment_ptr();
    volatile LAS unsigned* MISC = (volatile LAS unsigned*)(lds + MISC_OFF);
    for (int u = tid; u < (LDS_BYTES - LDSCTL_OFF) / 4; u += 512) ((LAS unsigned*)(lds + LDSCTL_OFF))[u] = 0u;
    __syncthreads();
    const int lo = args.ph_lo, hi = args.ph_hi;
    unsigned* barw = (unsigned*)(ws + WS_CTL) + CW_BAR + args.bar_region * XCD_BAR_WORDS;
    XcdBarrier bar; bar.bar = barw; bar.x = 0; bar.st = nullptr;
    if (hi - lo > 1) bar = xcd_barrier_post(barw, MISC + 8);
#define IN(k) (lo <= (k) && (k) < hi)
#define SEAM(k) do { if (IN(k) && IN((k) + 1)) xcd_barrier(bar); } while (0)
    if (IN(0)) { phase0(ka, lds, lane, wave, vcu, G); } SEAM(0);
    if (IN(1)) { pg8::Gemm g{(const bf16_t*)(ws + WS_R1), (const bf16_t*)(ws + WS_WTIN), T_TOK, IN_COLS, D_MODEL}; pg8::StaticOrder S; S.init(T_TOK, IN_COLS, G, bx);
        pg8::EpiInProj E{(bf16_t*)(ws + WS_Q), (unsigned*)(ws + WS_CTL) + CW_NORMS};
        pg8::gemm_phase<pg8::EpiInProj, pg8::StaticOrder, true, true>(lds, g, S, E); } SEAM(1);
    if (IN(2)) { phase2_mixer(ka, lds, tid, lane, wave, vcu, G); } SEAM(2);
    if (IN(3)) { pg8::Gemm g{(const bf16_t*)(ws + WS_YG), (const bf16_t*)(ws + WS_WTGLU), T_TOK, SSM_W, SSM_W}; pg8::StaticOrder S; S.init(T_TOK, SSM_W, G, bx);
        pg8::EpiGlu E{(const bf16_t*)(ws + WS_YG), args.in[IN_B_GLU], (bf16_t*)(ws + WS_R1), (float*)(ws + WS_SMALL + SM_SSQP)};
        pg8::gemm_phase<pg8::EpiGlu, pg8::StaticOrder, true, true>(lds, g, S, E); attn_finish(ka, lane, wave, vcu, G); } SEAM(3);
    if (IN(4)) { pg8::Gemm g{(const bf16_t*)(ws + WS_R1), (const bf16_t*)(ws + WS_WTOUT), T_TOK, D_MODEL, D_MODEL}; pg8::StaticOrder S; S.init(T_TOK, D_MODEL, G, bx);
        pg8::EpiOut E{args.in[IN_X], args.out, (const float*)(ws + WS_SMALL + SM_SSQP)};
        pg8::gemm_phase<pg8::EpiOut, pg8::StaticOrder, true, true>(lds, g, S, E); } SEAM(4);
    if (IN(5)) { phase5(ka, lds, tid, lane, wave, vcu, G); } SEAM(5);
    if (IN(6)) { phase6(ka, lds, tid, lane, wave, vcu, G); } SEAM(6);
    if (IN(7)) { const int ntiles = __builtin_amdgcn_readfirstlane(((const int*)(ws + WS_SMALL + SM_META))[0]);
        pg8::Gemm g{(const bf16_t*)(ws + WS_ROWS), (const bf16_t*)(ws + WS_WTGU), ntiles * 256, NE * 1024, D_MODEL}; pg8::MoeOrder S{(const int*)(ws + WS_SMALL + SM_TILEE), ntiles, G, vcu};
        pg8::EpiMoeUp E{(bf16_t*)(ws + WS_HID), (const float*)(ws + WS_SMALL + SM_ROWSC)};
        pg8::gemm_phase<pg8::EpiMoeUp, pg8::MoeOrder, true, true>(lds, g, S, E); } SEAM(7);
    if (IN(8)) { const int ntiles = __builtin_amdgcn_readfirstlane(((const int*)(ws + WS_SMALL + SM_META))[0]);
        pg8::Gemm g{(const bf16_t*)(ws + WS_HID), (const bf16_t*)(ws + WS_WTD), ntiles * 256, NE * 1024, FF}; pg8::MoeOrder S{(const int*)(ws + WS_SMALL + SM_TILEE), ntiles, G, vcu};
        pg8::EpiMoeDown E{(bf16_t*)(ws + WS_ROWS), (const float*)(ws + WS_SMALL + SM_ROWGT)};
        pg8::gemm_phase<pg8::EpiMoeDown, pg8::MoeOrder, true, true>(lds, g, S, E); } SEAM(8);
    if (IN(9)) { phase9(ka, lane, wave, vcu, G); }
#undef IN
#undef SEAM
}

extern "C" void kernel_launch(void* const* d_in, const int* in_sizes, int n_in, void* d_out, int out_size, void* d_ws, size_t ws_size, hipStream_t stream) {
    static int grid = 0;
    if (grid == 0) {
        if (n_in != 29 || out_size != T_TOK * D_MODEL || ws_size < WS_END) { fprintf(stderr, "kernel_launch: unexpected shapes (n_in %d, out %d, ws %zu < %zu)\n", n_in, out_size, ws_size, (size_t)WS_END); grid = -1; return; }
        int dev = 0, cus = 0;
        if (hipGetDevice(&dev) != hipSuccess || hipDeviceGetAttribute(&cus, hipDeviceAttributeMultiprocessorCount, dev) != hipSuccess) { grid = -1; return; }
        if (hipFuncSetAttribute((const void*)mk_fwd, hipFuncAttributeMaxDynamicSharedMemorySize, LDS_BYTES) != hipSuccess) { fprintf(stderr, "kernel_launch: hipFuncSetAttribute failed\n"); grid = -1; return; }
        grid = cus;
    }
    if (grid < 0) return;
    (void)hipMemsetAsync((char*)d_ws + WS_CTL, 0, CTL_ZERO_BYTES, stream);
    Args a{};
    for (int i = 0; i < 29; ++i) a.in[i] = (const float*)d_in[i];
    a.out = (float*)d_out; a.ws = (unsigned char*)d_ws;
    unsigned char* ws = (unsigned char*)d_ws;
#ifndef LAUNCH_PLAN
#define LAUNCH_PLAN {0, 10}
#endif
    static const int plan[] = LAUNCH_PLAN;
    for (int i = 0; i + 1 < (int)(sizeof(plan) / sizeof(int)); i += 2) { a.ph_lo = plan[i]; a.ph_hi = plan[i + 1]; a.bar_region = i / 2;
        hipLaunchKernelGGL(mk_fwd, dim3(grid), dim3(512), LDS_BYTES, stream, a); }
}
```
